# Optimizing an MI355X kernel written in HIP

```python
import math
import jax, jax.numpy as jnp
from jax import lax
import numpy as np

D_MODEL = 1024
BATCH = 4
SEQ = 8192
DEPTH = 2
DEC_BATCH = 8
DEC_SEQ = 16
PAST_LEN = 1024

CHUNK = 64
Q_BLOCK = 128
H_A = 4
HD_A = 128
DV_A = 2 * HD_A
W_A = H_A * DV_A
H_B = 8
HD_B = 128
W_B = H_B * HD_B
CONV_W = 4
H_C = 8
HD_C = 128
W_C = H_C * HD_C
D_FF = 4 * D_MODEL
ROPE_THETA = 10000.0
EPS = 1e-6
IN_SIZES = (2 * H_A * HD_A, 2 * H_A * HD_A, H_A * DV_A, 3 * W_B, H_B, H_B, W_B, W_C, W_C, W_C, 3 * D_MODEL)
N_IN = 2 * H_A * HD_A + 2 * H_A * HD_A + H_A * DV_A + 3 * W_B + 2 * H_B + W_B + 3 * W_C + 3 * D_MODEL

kernel_name = 'hybrid_diff_gdn_stickbreak_stream_step'


def _split_points():
    pts, acc = [], 0
    for s in IN_SIZES[:-1]:
        acc += s
        pts.append(acc)
    return pts


def rmsnorm(x, w):
    xf = x.astype(jnp.float32)
    y = xf * lax.rsqrt(jnp.mean(xf * xf, axis=-1, keepdims=True) + EPS)
    return (y * w.astype(jnp.float32)).astype(x.dtype)


def l2norm(x):
    xf = x.astype(jnp.float32)
    return xf * lax.rsqrt(jnp.sum(xf * xf, axis=-1, keepdims=True) + EPS)


def rope(x, pos):
    half = x.shape[-1] // 2
    inv = ROPE_THETA ** (-jnp.arange(half, dtype=jnp.float32) / half)
    ang = pos.astype(jnp.float32)[:, None] * inv[None, :]
    cos = jnp.cos(ang)[None, :, None, :]
    sin = jnp.sin(ang)[None, :, None, :]
    xf = x.astype(jnp.float32)
    x1, x2 = xf[..., :half], xf[..., half:]
    return jnp.concatenate([x1 * cos - x2 * sin, x2 * cos + x1 * sin], axis=-1).astype(x.dtype)


def sweep_query_blocks(fn, q, qpos):
    B, L = q.shape[0], q.shape[1]
    nb = L // Q_BLOCK
    qb = jnp.moveaxis(q.reshape((B, nb, Q_BLOCK) + q.shape[2:]), 1, 0)
    pb = qpos.reshape(nb, Q_BLOCK)
    out = lax.map(lambda a: fn(a[0], a[1]), (qb, pb))
    out = jnp.moveaxis(out, 0, 1)
    return out.reshape((B, L) + out.shape[3:])


def diff_attn_block(q, k, v, qpos, kpos, lam):
    B, Lq = q.shape[0], q.shape[1]
    qh = q.reshape(B, Lq, H_A, 2, HD_A)
    kh = k.reshape(B, k.shape[1], H_A, 2, HD_A)
    s = jnp.einsum('bqhcd,bkhcd->bhcqk', qh, kh).astype(jnp.float32) * (HD_A ** -0.5)
    mask = (kpos[None, :] // CHUNK) <= (qpos[:, None] // CHUNK)
    s = jnp.where(mask, s, -jnp.inf)
    p = jax.nn.softmax(s, axis=-1)
    a = p[:, :, 0] - lam * p[:, :, 1]
    o = jnp.einsum('bhqk,bkhe->bqhe', a, v.astype(jnp.float32))
    return o.astype(v.dtype)


def stick_breaking_block(q, k, v, qpos, kpos):
    z = jnp.einsum('bqhd,bkhd->bhqk', q, k).astype(jnp.float32) * (HD_C ** -0.5)
    mask = kpos[None, :] < qpos[:, None]
    log_beta = jax.nn.log_sigmoid(z)
    log_1m = jnp.where(mask, jax.nn.log_sigmoid(-z), 0.0)
    tail = lax.cumsum(log_1m, axis=3, reverse=True) - log_1m
    a = jnp.where(mask, jnp.exp(log_beta + tail), 0.0)
    o = jnp.einsum('bhqk,bkhd->bqhd', a, v.astype(jnp.float32))
    return o.astype(v.dtype)


def gated_delta_chunk(S, q, k, v, g, beta):
    f32 = jnp.float32
    S = S.astype(f32)
    q, k, v = (jnp.swapaxes(t.astype(f32), 1, 2) for t in (q, k, v))
    g, beta = (jnp.swapaxes(t.astype(f32), 1, 2) for t in (g, beta))
    L = q.shape[2]
    gc = jnp.cumsum(g, axis=-1)
    tri = jnp.tril(jnp.ones((L, L), dtype=bool))
    strict = jnp.tril(jnp.ones((L, L), dtype=bool), -1)
    decay = jnp.exp(jnp.where(tri, gc[..., :, None] - gc[..., None, :], -jnp.inf))
    kb = k * beta[..., None]
    M = jnp.where(strict, jnp.einsum('bhid,bhjd->bhij', kb, k) * decay, 0.0)
    eye = jnp.eye(L, dtype=f32)
    T = lax.linalg.triangular_solve(eye + M, jnp.broadcast_to(eye, M.shape),
                                    left_side=True, lower=True, unit_diagonal=True)
    u0 = jnp.einsum('bhij,bhje->bhie', T, v * beta[..., None])
    w = jnp.einsum('bhij,bhjd->bhid', T, kb * jnp.exp(gc)[..., None])
    u = u0 - jnp.einsum('bhld,bhde->bhle', w, S)
    o = (jnp.einsum('bhld,bhde->bhle', q * jnp.exp(gc)[..., None], S)
         + jnp.einsum('bhij,bhje->bhie', jnp.einsum('bhid,bhjd->bhij', q, k) * decay, u))
    gL = gc[..., -1]
    S_new = (S * jnp.exp(gL)[..., None, None]
             + jnp.einsum('bhjd,bhje->bhde', k * jnp.exp(gL[..., None] - gc)[..., None], u))
    return S_new, jnp.swapaxes(o, 1, 2)


def gated_delta_scan(S0, q, k, v, g, beta):
    B, L = q.shape[0], q.shape[1]
    nc = L // CHUNK

    def resh(t):
        return jnp.moveaxis(t.reshape((B, nc, CHUNK) + t.shape[2:]), 1, 0)

    def step(S, xs):
        return gated_delta_chunk(S, *xs)

    S, o = lax.scan(step, S0, (resh(q), resh(k), resh(v), resh(g), resh(beta)))
    o = jnp.moveaxis(o, 0, 1)
    return S, o.reshape((B, L) + o.shape[3:])


def hybrid_layer(x, pos, past_ak, past_av, past_ck, past_cv, conv_hist, s0,
                 norm1_w, w_in, lam_q1, lam_k1, lam_q2, lam_k2, subln_w,
                 conv_w, a_log, dt_bias, gdn_norm_w, w_out, norm2_w, w_up, w_down,
                 layer_idx, prompt):
    B, L, _ = x.shape
    h = rmsnorm(x, norm1_w)
    proj = jnp.einsum('bld,dn->bln', h, w_in)
    aq, ak, av, bqkv, ba, bb, bz, cq, ck, cv, gates = jnp.split(proj, _split_points(), axis=-1)

    aq = rope(aq.reshape(B, L, 2 * H_A, HD_A), pos)
    ak = rope(ak.reshape(B, L, 2 * H_A, HD_A), pos)
    av = av.reshape(B, L, H_A, DV_A)
    if prompt:
        ak_all, av_all = ak, av
    else:
        ak_all = jnp.concatenate([past_ak.astype(ak.dtype), ak], axis=1)
        av_all = jnp.concatenate([past_av.astype(av.dtype), av], axis=1)
    kpos_a = jnp.arange(ak_all.shape[1])
    lam_init = 0.8 - 0.6 * math.exp(-0.3 * layer_idx)
    lam = (jnp.exp(jnp.sum(lam_q1.astype(jnp.float32) * lam_k1.astype(jnp.float32)))
           - jnp.exp(jnp.sum(lam_q2.astype(jnp.float32) * lam_k2.astype(jnp.float32))) + lam_init)
    fa = lambda qb, qp: diff_attn_block(qb, ak_all, av_all, qp, kpos_a, lam)
    oa = sweep_query_blocks(fa, aq, pos) if prompt else fa(aq, pos)
    oa = (rmsnorm(oa, subln_w) * (1.0 - lam_init)).reshape(B, L, W_A)

    hist = jnp.zeros((B, CONV_W - 1, 3 * W_B), bqkv.dtype) if prompt else conv_hist.astype(bqkv.dtype)
    xpad = jnp.concatenate([hist, bqkv], axis=1)
    conv = xpad[:, 0:L] * conv_w[0]
    for i in range(1, CONV_W):
        conv = conv + xpad[:, i:i + L] * conv_w[i]
    new_conv = xpad[:, L:]
    qkv = jax.nn.silu(conv)
    bq, bk, bv = jnp.split(qkv, [W_B, 2 * W_B], axis=-1)
    bq = l2norm(bq.reshape(B, L, H_B, HD_B)) * (HD_B ** -0.5)
    bk = l2norm(bk.reshape(B, L, H_B, HD_B))
    bv = bv.reshape(B, L, H_B, HD_B)
    g = -jnp.exp(a_log.astype(jnp.float32)) * jax.nn.softplus(ba.astype(jnp.float32) + dt_bias.astype(jnp.float32))
    beta = jax.nn.sigmoid(bb.astype(jnp.float32))
    if prompt:
        S_init = jnp.zeros((B, H_B, HD_B, HD_B), jnp.float32)
        s_new, ob = gated_delta_scan(S_init, bq, bk, bv, g, beta)
    else:
        s_new, ob = gated_delta_chunk(s0, bq, bk, bv, g, beta)
    ob = rmsnorm(ob.astype(x.dtype), gdn_norm_w) * jax.nn.silu(bz.reshape(B, L, H_B, HD_B))
    ob = ob.reshape(B, L, W_B)

    cq = cq.reshape(B, L, H_C, HD_C)
    ck = ck.reshape(B, L, H_C, HD_C)
    cv = cv.reshape(B, L, H_C, HD_C)
    if prompt:
        ck_all, cv_all = ck, cv
    else:
        ck_all = jnp.concatenate([past_ck.astype(ck.dtype), ck], axis=1)
        cv_all = jnp.concatenate([past_cv.astype(cv.dtype), cv], axis=1)
    kpos_c = jnp.arange(ck_all.shape[1])
    fc = lambda qb, qp: stick_breaking_block(qb, ck_all, cv_all, qp, kpos_c)
    oc = sweep_query_blocks(fc, cq, pos) if prompt else fc(cq, pos)
    oc = oc.reshape(B, L, W_C)

    gs = jax.nn.sigmoid(gates.reshape(B, L, 3, D_MODEL))
    merged = gs[:, :, 0] * oa + gs[:, :, 1] * ob + gs[:, :, 2] * oc
    x = x + jnp.einsum('bld,de->ble', merged, w_out)

    h2 = rmsnorm(x, norm2_w)
    up = jnp.square(jax.nn.relu(jnp.einsum('bld,df->blf', h2, w_up)))
    x = x + jnp.einsum('blf,fd->bld', up, w_down)
    return x, ak, av, ck, cv, new_conv, s_new


def setup_inputs(seed: int = 0) -> dict:
    key = jax.random.key(seed)
    ks = jax.random.split(key, 32)
    f32 = jnp.float32

    def nrm(k, shape, scale=1.0):
        return jax.random.normal(k, shape, f32) * scale

    def gain(k, shape):
        return 1.0 + 0.01 * jax.random.normal(k, shape, f32)

    dt = jnp.exp(jax.random.uniform(ks[20], (DEPTH, H_B), f32, math.log(1e-3), math.log(1e-1)))
    return {
        'x_prompt': nrm(ks[0], (BATCH, SEQ, D_MODEL)),
        'x_sample': nrm(ks[1], (DEC_BATCH, DEC_SEQ, D_MODEL)),
        'cache_a_k': nrm(ks[2], (DEPTH, DEC_BATCH, PAST_LEN, 2 * H_A, HD_A)),
        'cache_a_v': nrm(ks[3], (DEPTH, DEC_BATCH, PAST_LEN, H_A, DV_A)),
        'cache_c_k': nrm(ks[4], (DEPTH, DEC_BATCH, PAST_LEN, H_C, HD_C)),
        'cache_c_v': nrm(ks[5], (DEPTH, DEC_BATCH, PAST_LEN, H_C, HD_C)),
        'state_b_conv': nrm(ks[6], (DEPTH, DEC_BATCH, CONV_W - 1, 3 * W_B)),
        'state_b_ssm': nrm(ks[7], (DEPTH, DEC_BATCH, H_B, HD_B, HD_B), 0.1),
        'norm1_w': gain(ks[8], (DEPTH, D_MODEL)),
        'w_in': nrm(ks[9], (DEPTH, D_MODEL, N_IN), D_MODEL ** -0.5),
        'lam_q1': nrm(ks[10], (DEPTH, HD_A), 0.1),
        'lam_k1': nrm(ks[11], (DEPTH, HD_A), 0.1),
        'lam_q2': nrm(ks[12], (DEPTH, HD_A), 0.1),
        'lam_k2': nrm(ks[13], (DEPTH, HD_A), 0.1),
        'subln_w': gain(ks[14], (DEPTH, DV_A)),
        'conv_w': nrm(ks[15], (DEPTH, CONV_W, 3 * W_B), CONV_W ** -0.5),
        'a_log': jnp.log(jax.random.uniform(ks[16], (DEPTH, H_B), f32, 1.0, 16.0)),
        'dt_bias': dt + jnp.log(-jnp.expm1(-dt)),
        'gdn_norm_w': gain(ks[17], (DEPTH, HD_B)),
        'w_out': nrm(ks[18], (DEPTH, D_MODEL, D_MODEL), D_MODEL ** -0.5),
        'norm2_w': gain(ks[19], (DEPTH, D_MODEL)),
        'w_up': nrm(ks[21], (DEPTH, D_MODEL, D_FF), D_MODEL ** -0.5),
        'w_down': nrm(ks[22], (DEPTH, D_FF, D_MODEL), D_FF ** -0.5),
        'final_norm_w': gain(ks[23], (D_MODEL,)),
    }


def reference(x_prompt, x_sample, cache_a_k, cache_a_v, cache_c_k, cache_c_v, state_b_conv, state_b_ssm,
              norm1_w, w_in, lam_q1, lam_k1, lam_q2, lam_k2, subln_w, conv_w, a_log, dt_bias,
              gdn_norm_w, w_out, norm2_w, w_up, w_down, final_norm_w):
    pos_p = jnp.arange(x_prompt.shape[1])
    past = cache_a_k.shape[2]
    pos_s = past + jnp.arange(x_sample.shape[1])
    xp, xs = x_prompt, x_sample
    pa_k, pa_v, pc_k, pc_v, pb_conv, pb_ssm = [], [], [], [], [], []
    sa_k, sa_v, sc_k, sc_v, sb_conv, sb_ssm = [], [], [], [], [], []
    for l in range(DEPTH):
        w = (norm1_w[l], w_in[l], lam_q1[l], lam_k1[l], lam_q2[l], lam_k2[l], subln_w[l],
             conv_w[l], a_log[l], dt_bias[l], gdn_norm_w[l], w_out[l], norm2_w[l], w_up[l], w_down[l])
        xp, ak, av, ck, cv, cb, sb = hybrid_layer(xp, pos_p, None, None, None, None, None, None,
                                                  *w, layer_idx=l, prompt=True)
        pa_k.append(ak); pa_v.append(av); pc_k.append(ck); pc_v.append(cv); pb_conv.append(cb); pb_ssm.append(sb)
        xs, ak, av, ck, cv, cb, sb = hybrid_layer(xs, pos_s, cache_a_k[l], cache_a_v[l], cache_c_k[l], cache_c_v[l],
                                                  state_b_conv[l], state_b_ssm[l],
                                                  *w, layer_idx=l, prompt=False)
        sa_k.append(ak); sa_v.append(av); sc_k.append(ck); sc_v.append(cv); sb_conv.append(cb); sb_ssm.append(sb)
    y_prompt = rmsnorm(xp, final_norm_w)
    y_sample = rmsnorm(xs, final_norm_w)
    return (y_prompt, y_sample,
            jnp.stack(pa_k), jnp.stack(pa_v), jnp.stack(pc_k), jnp.stack(pc_v), jnp.stack(pb_conv), jnp.stack(pb_ssm),
            jnp.stack(sa_k), jnp.stack(sa_v), jnp.stack(sc_k), jnp.stack(sc_v), jnp.stack(sb_conv), jnp.stack(sb_ssm))
```

```cpp
#ifdef EMU
#include "emu.h"
#define LAS
#define ASM_WAIT_VM0() ((void)0)
#define ASM_WAIT_VM(n) ((void)0)
#define ASM_WAIT_LGKM(n) ((void)0)
#define ASM_WAIT_ALL0() ((void)0)
#define COMPILER_FENCE() ((void)0)
#define GLDS16(gptr, ldsptr) emu_global_load_lds16((gptr), (ldsptr))
#define MY_XCC_ID() (blockIdx.x & 7u)
#define WAVE_LDS_FENCE() ((void)__all(1))
#define OPAQUE(x) ((void)0)
#define OPAQUE_S(x) ((void)0)
#else
#include <hip/hip_runtime.h>
#include <cstdio>
#include <cstring>
#define LAS __attribute__((address_space(3)))
#define ASM_WAIT_VM0() asm volatile("s_waitcnt vmcnt(0)" ::: "memory")
#define ASM_WAIT_VM(n) asm volatile("s_waitcnt vmcnt(" #n ")" ::: "memory")
#define ASM_WAIT_LGKM(n) asm volatile("s_waitcnt lgkmcnt(" #n ")" ::: "memory")
#define ASM_WAIT_ALL0() asm volatile("s_waitcnt vmcnt(0) lgkmcnt(0)" ::: "memory")
#define COMPILER_FENCE() asm volatile("" ::: "memory")
#define GLDS16(gptr, ldsptr) __builtin_amdgcn_global_load_lds((const unsigned*)(gptr), (LAS unsigned*)(ldsptr), 16, 0, 0)
#define MY_XCC_ID() ((unsigned)__builtin_amdgcn_s_getreg((3 << 11) | 20) & 0xFu)
#define WAVE_LDS_FENCE() asm volatile("s_waitcnt lgkmcnt(0)" ::: "memory")
#define OPAQUE(x) asm volatile("" : "+v"(x))
#define OPAQUE_S(x) asm volatile("" : "+s"(x))
#endif
#define DI __device__ __forceinline__

#ifndef CFG_D
#define CFG_D 1024
#define CFG_BATCH 4
#define CFG_SEQ 8192
#define CFG_DB 8
#define CFG_PAST 1024
#endif
constexpr int D = CFG_D, NB = CFG_BATCH, SEQ = CFG_SEQ, DEPTH = 2, DB = CFG_DB, DSEQ = 16, PAST = CFG_PAST;
constexpr int HA = D / 256, HB = D / 128, HC = D / 128, DFF = 4 * D, CHUNK = 64, CONVW = 4;
constexpr int MP = NB * SEQ;
constexpr int MS = DB * DSEQ;
constexpr int MSP = (MS + 255) / 256 * 256;
constexpr int MALL = MP + MSP;
constexpr int NIN_ORIG = 13 * D + 2 * HB;
constexpr int NP = 13 * D + 256;
constexpr int TD = D / 256;
constexpr int NPART = 4 * TD;
constexpr int ROPE_N = (SEQ > PAST + DSEQ) ? SEQ : (PAST + DSEQ);
constexpr int NCH = SEQ / CHUNK;
constexpr int NUNIT_B = NB * NCH * HB + DB * HB;
constexpr int MB = MP + DB * 64;
constexpr float EPS = 1e-6f;
static_assert(MP % 256 == 0 && D % 256 == 0 && SEQ % 128 == 0 && PAST % 64 == 0 && 2 * HB <= 16, "shape assumptions");

typedef unsigned short bf16_t;
typedef short bf16x8 __attribute__((ext_vector_type(8)));
typedef short s16x4 __attribute__((ext_vector_type(4)));
typedef float f32x4 __attribute__((ext_vector_type(4)));
typedef float f32x2 __attribute__((ext_vector_type(2)));
typedef float f32x16 __attribute__((ext_vector_type(16)));
typedef unsigned u32x4 __attribute__((ext_vector_type(4)));
typedef unsigned u32x2 __attribute__((ext_vector_type(2)));

DI unsigned cvt_pk_bf16(float lo, float hi) {
#ifdef EMU
    unsigned a = __float_as_uint(lo), b = __float_as_uint(hi);
    a += 0x7fffu + ((a >> 16) & 1u); b += 0x7fffu + ((b >> 16) & 1u);
    return (a >> 16) | (b & 0xffff0000u);
#else
    typedef __bf16 bf16x2_t __attribute__((ext_vector_type(2)));
    const f32x2 v = {lo, hi}; return __builtin_bit_cast(unsigned, __builtin_convertvector(v, bf16x2_t));
#endif
}
DI float bf_lo(unsigned u) { return __uint_as_float(u << 16); }
DI float bf_hi(unsigned u) { return __uint_as_float(u & 0xffff0000u); }
DI float bf2f(bf16_t b) { return __uint_as_float(((unsigned)b) << 16); }
DI bf16_t f2bf(float f) { return (bf16_t)(cvt_pk_bf16(f, 0.f) & 0xffffu); }
DI float fast_exp2(float x) { return __builtin_amdgcn_exp2f(x); }
DI float fast_exp(float x) { return __builtin_amdgcn_exp2f(x * 1.44269504089f); }
DI float fast_rcp(float x) { return __builtin_amdgcn_rcpf(x); }
DI float sigmoidf_(float x) { return fast_rcp(1.0f + fast_exp(-x)); }
DI s16x4 ds_read_tr16(const LAS unsigned char* p) {
#ifdef EMU
    return emu_ds_read_b64_tr_b16(p);
#else
    return __builtin_amdgcn_ds_read_tr16_b64_v4i16((LAS s16x4*)p);
#endif
}

constexpr size_t al256(size_t x) { return (x + 255) & ~(size_t)255; }
constexpr size_t WS_BAR = 0;
constexpr size_t WS_WIN = 65536;
constexpr size_t WS_WOUT = WS_WIN + al256((size_t)DEPTH * NP * D * 2);
constexpr size_t WS_WUP = WS_WOUT + al256((size_t)DEPTH * D * D * 2);
constexpr size_t WS_WDN = WS_WUP + al256((size_t)DEPTH * DFF * D * 2);
constexpr size_t WS_ROPE = WS_WDN + al256((size_t)DEPTH * D * DFF * 2);
constexpr size_t WS_XB = WS_ROPE + al256((size_t)ROPE_N * 64 * 4 * 2);
constexpr size_t WS_SSP = WS_XB + al256((size_t)MALL * D * 2);
constexpr size_t WS_QA = WS_SSP + al256((size_t)2 * MALL * NPART * 4);
constexpr size_t WS_KA = WS_QA + al256((size_t)MALL * D * 2);
constexpr size_t WS_VA = WS_KA + al256((size_t)MALL * D * 2);
constexpr size_t WS_BRAW = WS_VA + al256((size_t)MALL * D * 2);
constexpr size_t WS_BZ = WS_BRAW + al256((size_t)MALL * 3 * D * 2);
constexpr size_t WS_QC = WS_BZ + al256((size_t)MALL * D * 2);
constexpr size_t WS_KC = WS_QC + al256((size_t)MALL * D * 2);
constexpr size_t WS_VC = WS_KC + al256((size_t)MALL * D * 2);
constexpr size_t WS_GATES = WS_VC + al256((size_t)MALL * D * 2);
constexpr size_t WS_BAB = WS_GATES + al256((size_t)MALL * 3 * D * 2);
constexpr size_t WS_BQ = WS_BAB + al256((size_t)MALL * 16 * 4);
constexpr size_t WS_BK = WS_BQ + al256((size_t)MB * D * 2);
constexpr size_t WS_BV = WS_BK + al256((size_t)MB * D * 2);
constexpr size_t WS_GB = WS_BV + al256((size_t)MB * D * 2);
constexpr size_t WS_TT = WS_GB + al256((size_t)MB * 16 * 4);
constexpr size_t WS_AQK = WS_TT + al256((size_t)NUNIT_B * 4096 * 2);
constexpr size_t WS_CV = WS_AQK + al256((size_t)NUNIT_B * 4096 * 2);
constexpr size_t WS_OBUF = WS_CV + al256((size_t)NUNIT_B * 256 * 4);
constexpr size_t WS_OA = WS_OBUF + al256((size_t)MB * D * 2);
constexpr size_t WS_OC = WS_OA + al256((size_t)MALL * D * 2);
constexpr size_t WS_HID = WS_OC + al256((size_t)MALL * D * 2);
constexpr size_t WS_XB2 = WS_HID + al256((size_t)MALL * DFF * 2);
constexpr size_t WS_END = WS_XB2 + al256((size_t)MALL * D * 2);

struct Params {
    const float* in[24];
    float* out; unsigned char* ws;
    int ph_lo, ph_hi;
};
enum { I_XP = 0, I_XS, I_CAK, I_CAV, I_CCK, I_CCV, I_SCONV, I_SSSM, I_N1W, I_WIN, I_LQ1, I_LK1, I_LQ2, I_LK2, I_SUBLN, I_CONVW, I_ALOG, I_DTB, I_GDNW, I_WOUT, I_N2W, I_WUP, I_WDN, I_FNW };
constexpr size_t O_YP = 0;
constexpr size_t O_YS = O_YP + (size_t)NB * SEQ * D;
constexpr size_t O_PAK = O_YS + (size_t)DB * DSEQ * D;
constexpr size_t O_PAV = O_PAK + (size_t)DEPTH * NB * SEQ * D;
constexpr size_t O_PCK = O_PAV + (size_t)DEPTH * NB * SEQ * D;
constexpr size_t O_PCV = O_PCK + (size_t)DEPTH * NB * SEQ * D;
constexpr size_t O_PBC = O_PCV + (size_t)DEPTH * NB * SEQ * D;
constexpr size_t O_PBS = O_PBC + (size_t)DEPTH * NB * 3 * 3 * D;
constexpr size_t O_SAK = O_PBS + (size_t)DEPTH * NB * HB * 128 * 128;
constexpr size_t O_SAV = O_SAK + (size_t)DEPTH * DB * DSEQ * D;
constexpr size_t O_SCK = O_SAV + (size_t)DEPTH * DB * DSEQ * D;
constexpr size_t O_SCV = O_SCK + (size_t)DEPTH * DB * DSEQ * D;
constexpr size_t O_SBC = O_SCV + (size_t)DEPTH * DB * DSEQ * D;
constexpr size_t O_SBS = O_SBC + (size_t)DEPTH * DB * 3 * 3 * D;
constexpr size_t O_END = O_SBS + (size_t)DEPTH * DB * HB * 128 * 128;

DI int win_orig_col(int n) {
    if (n < 2 * D) { const int base = (n / D) * D, w = n % D, head = w >> 7, g = w & 127, G = g >> 3, j = g & 7;
        const int d = (j < 4) ? 4 * G + j : 64 + 4 * G + (j - 4); return base + head * 128 + d; }
    if (n < 6 * D) return n;
    if (n < 13 * D) return n + 2 * HB;
    const int c = n - 13 * D; return c < 2 * HB ? 6 * D + c : -1;
}
#define XB_TMO      128
#define XB_XCNT(j)  (256  + 64 * (j))
#define XB_XSUB(j)  (1280 + 64 * (j))
#define XB_XGEN(j)  (2304 + 64 * (j))
#define XB_TOP      3328
#define XB_TOPGEN   3392
#define XCD_BAR_WORDS 3456
#define XB_SPIN_CAP (1u << 22)
DI unsigned xb_ld(unsigned* p)              { return __hip_atomic_load(p, __ATOMIC_RELAXED, __HIP_MEMORY_SCOPE_AGENT); }
DI unsigned xb_add(unsigned* p, unsigned v) { return __hip_atomic_fetch_add(p, v, __ATOMIC_RELAXED, __HIP_MEMORY_SCOPE_AGENT); }
#define XB_SPIN(cond, bar) do { unsigned _sp = 0; while (cond) { __builtin_amdgcn_s_sleep(1); \
    if ((++_sp & 255u) == 0u) { if (xb_ld(&(bar)[XB_TMO])) break; if (_sp > XB_SPIN_CAP) { atomicAdd(&(bar)[XB_TMO], 1u); break; } } } } while (0)
struct XcdBarrier { unsigned* bar; unsigned x; volatile LAS unsigned* st; };
DI XcdBarrier xcd_barrier_post(unsigned* bar, volatile LAS unsigned* st) {
    XcdBarrier b; b.bar = bar; b.x = MY_XCC_ID(); b.st = st;
    if (threadIdx.x == 0) (void)xb_add(&bar[XB_XCNT(b.x)], 1u);
    return b;
}
DI void xcd_barrier_complete(unsigned* bar, unsigned x, unsigned& nloc, unsigned& nx) {
    const unsigned G = gridDim.x;
    unsigned sum, cnt, mine, sp = 0u;
    for (;;) {
        sum = 0u; cnt = 0u; mine = 0u;
#pragma unroll
        for (unsigned j = 0; j < 16; ++j) { const unsigned c = xb_ld(&bar[XB_XCNT(j)]); sum += c; cnt += (c > 0u) ? 1u : 0u; mine = (j == x) ? c : mine; }
        if (sum == G) break;
        __builtin_amdgcn_s_sleep(1);
        if ((++sp & 255u) == 0u) { if (xb_ld(&bar[XB_TMO])) break; if (sp > XB_SPIN_CAP) { atomicAdd(&bar[XB_TMO], 1u); break; } }
    }
    nloc = mine > 0u ? mine : 1u; nx = cnt > 0u ? cnt : 1u;
}
DI void xcd_barrier(const XcdBarrier& b) {
    ASM_WAIT_VM0();
    __syncthreads();
    if (threadIdx.x == 0) {
        unsigned* bar = b.bar;
        __builtin_amdgcn_s_waitcnt(0);
        unsigned nloc = b.st[0], nx = b.st[1];
        if (nloc == 0u) { xcd_barrier_complete(bar, b.x, nloc, nx); b.st[0] = nloc; b.st[1] = nx; }
        const unsigned old = xb_add(&bar[XB_XSUB(b.x)], 1u);
        const unsigned gen = old / nloc;
        if (old + 1u == (gen + 1u) * nloc) {
            __builtin_amdgcn_fence(__ATOMIC_RELEASE, "agent");
            ASM_WAIT_VM0();
            const unsigned og = xb_add(&bar[XB_TOP], 1u);
            const unsigned tg = og / nx;
            if (og + 1u == (tg + 1u) * nx) xb_add(&bar[XB_TOPGEN], 1u);
            else XB_SPIN(xb_ld(&bar[XB_TOPGEN]) == tg, bar);
            __builtin_amdgcn_fence(__ATOMIC_ACQUIRE, "agent");
            xb_add(&bar[XB_XGEN(b.x)], 1u);
            ASM_WAIT_VM0();
        } else {
            XB_SPIN(xb_ld(&bar[XB_XGEN(b.x)]) == gen, bar);
            __builtin_amdgcn_fence(__ATOMIC_ACQUIRE, "agent");
            ASM_WAIT_VM0();
        }
    }
    __syncthreads();
}

namespace pg8 {
constexpr int BM = 256, BK = 64, HALF = 128, HTB = HALF * BK * 2, STAGE_BYTES = 8 * HTB, NXCD = 8, WGM = 8;
DI int lds_byte(int r, int c) { const int st = (r >> 4) * 2 + (c >> 5), rr = r & 15, cc = c & 31, ob = rr * 64 + cc * 2; return st * 1024 + (ob ^ (((ob >> 9) & 1) << 5)); }
DI void stage_rc(int b, int& R, int& C) { const int st = b / 1024, sb = b % 1024, swz = sb ^ (((sb >> 9) & 1) << 5); R = (st >> 1) * 16 + swz / 64; C = (st & 1) * 32 + (swz % 64) / 2; }
DI int perm32(int rho) { const int n = rho >> 4, i = rho & 15; return 8 * (i >> 2) + 4 * n + (i & 3); }
struct Unit { int pm, pn; };
struct Gemm { const bf16_t* A; const bf16_t* Bt; int M, N, K; };
struct StaticOrder {
    int nM, nN, nwg, G, c;
    DI void init(int M, int N, int G_, int c_) { nM = M / BM; nN = N / BM; nwg = nM * nN; G = G_; c = c_; }
    DI bool next(int i, Unit& u) const {
        const long L = (long)i * G + c; if (L >= nwg) return false;
        int wgid = (int)L; { const int q = nwg / NXCD, r = nwg % NXCD, xcd = wgid % NXCD, off = wgid / NXCD; wgid = (xcd < r ? xcd * (q + 1) : r * (q + 1) + (xcd - r) * q) + off; }
        const int nig = WGM * nN, gid = wgid / nig, fm = gid * WGM, gsz = (nM - fm) < WGM ? (nM - fm) : WGM;
        u.pm = fm + ((wgid % nig) % gsz); u.pn = (wgid % nig) / gsz; return true;
    }
    DI void a_ready(const Unit&) const {}
    DI void done(const Unit&) const {}
};
template <class Epi, class Sched>
DI void gemm_phase(LAS unsigned char* lds, const Gemm g, const Sched& S, const Epi& E) {
    int tid = threadIdx.x; OPAQUE(tid);
    const int wid = __builtin_amdgcn_readfirstlane(tid >> 6), lane = tid & 63, wr = wid >> 2, wc = wid & 3, fr = lane & 15, fq = lane >> 4;
    const int K = g.K, nt = K / BK;
    unsigned voffA[2], voffB[2];
#pragma unroll
    for (int i = 0; i < 2; ++i) { int R, C; stage_rc(tid * 16 + i * 8192, R, C); const int Rb = Epi::PERM ? ((R & ~31) + perm32(R & 31)) : R;
        voffA[i] = (unsigned)(R * K + C) * 2u; voffB[i] = (unsigned)(Rb * K + C) * 2u; }
    const size_t kstep = (size_t)(BK * 2);
    const size_t hstep = (size_t)HALF * K * 2;
    const size_t tstep = 2 * hstep;
    const unsigned ldsw = (unsigned)wid * 1024u;
    const int aoff = lds_byte(wr * 64 + fr, fq * 8), boff = lds_byte(wc * 32 + fr, fq * 8);
#define PG8_SA(b, h) (((b) * 2 + (h)) * HTB)
#define PG8_SB(b, h) ((4 + (b) * 2 + (h)) * HTB)
#define PG8_STAGE(bufoff, gbase, voff) do { _Pragma("unroll") for (int _i = 0; _i < 2; ++_i) \
        GLDS16((const char*)(gbase) + (voff)[_i], lds + (bufoff) + ldsw + _i * 8192); } while (0)
#define PG8_LDA(dst, b, h) do { _Pragma("unroll") for (int m = 0; m < 4; ++m) _Pragma("unroll") for (int k = 0; k < 2; ++k) dst[m][k] = *(const LAS bf16x8*)(lds + PG8_SA(b, h) + aoff + m * 2048 + k * 1024); } while (0)
#define PG8_LDB(dst, b, h) do { _Pragma("unroll") for (int n = 0; n < 2; ++n) _Pragma("unroll") for (int k = 0; k < 2; ++k) dst[n][k] = *(const LAS bf16x8*)(lds + PG8_SB(b, h) + boff + n * 2048 + k * 1024); } while (0)
#define PG8_MMA(ai, bj, At, Bt) do { __builtin_amdgcn_s_setprio(1); _Pragma("unroll") for (int m = 0; m < 4; ++m) _Pragma("unroll") for (int n = 0; n < 2; ++n) _Pragma("unroll") for (int k = 0; k < 2; ++k) \
        acc[ai][bj][m][n] = __builtin_amdgcn_mfma_f32_16x16x32_bf16(Bt[n][k], At[m][k], acc[ai][bj][m][n], 0, 0, 0); __builtin_amdgcn_s_setprio(0); } while (0)
#define PG8_WAIT_V(n) ASM_WAIT_VM(n)
#define PG8_WAIT_L(n) ASM_WAIT_LGKM(n)
#define PG8_BAR __builtin_amdgcn_s_barrier()
#define PG8_SCHED __builtin_amdgcn_sched_barrier(0)
    Unit cur, nxt; int ui = 0;
    if (!S.next(0, cur)) return;
    f32x4 acc[2][2][4][2];
#pragma unroll
    for (int a = 0; a < 2; ++a)
#pragma unroll
        for (int b = 0; b < 2; ++b)
#pragma unroll
            for (int m = 0; m < 4; ++m)
#pragma unroll
                for (int n = 0; n < 2; ++n) acc[a][b][m][n] = (f32x4){0.f, 0.f, 0.f, 0.f};
    bf16x8 At[4][2], B0[2][2], B1[2][2];
    const char* cA = (const char*)g.A + (size_t)cur.pm * tstep; const char* cB = (const char*)g.Bt + (size_t)cur.pn * tstep;
    S.a_ready(cur);
    PG8_STAGE(PG8_SB(0, 0), cB, voffB); PG8_STAGE(PG8_SA(0, 0), cA, voffA); PG8_STAGE(PG8_SB(0, 1), cB + hstep, voffB); PG8_STAGE(PG8_SA(0, 1), cA + hstep, voffA);
    if (wr == 1) PG8_BAR;
    PG8_WAIT_V(4); PG8_BAR;
    PG8_STAGE(PG8_SB(1, 0), cB + kstep, voffB); PG8_STAGE(PG8_SA(1, 0), cA + kstep, voffA); PG8_STAGE(PG8_SB(1, 1), cB + hstep + kstep, voffB);
    PG8_WAIT_V(6); PG8_BAR;
    for (;;) {
        const bool has_next = S.next(ui + 1, nxt);
        const char* nA = has_next ? (const char*)g.A + (size_t)nxt.pm * tstep : cA; const char* nB = has_next ? (const char*)g.Bt + (size_t)nxt.pn * tstep : cB;
        for (int t = 0; t < nt; t += 2) {
            const bool last = (t == nt - 2);
            const char* a1 = cA + (size_t)(t + 1) * kstep;
            const char* a2 = last ? nA : cA + (size_t)(t + 2) * kstep; const char* b2 = last ? nB : cB + (size_t)(t + 2) * kstep;
            const char* a3 = a2 + kstep; const char* b3 = b2 + kstep;
            if (last && has_next) S.a_ready(nxt);
            PG8_LDB(B0, 0, 0); PG8_SCHED; PG8_LDA(At, 0, 0); PG8_STAGE(PG8_SA(1, 1), a1 + hstep, voffA);
            PG8_WAIT_L(8); PG8_BAR; PG8_WAIT_L(0); PG8_MMA(0, 0, At, B0); PG8_BAR; PG8_SCHED;
            PG8_LDB(B1, 0, 1); PG8_STAGE(PG8_SB(0, 0), b2, voffB);
            PG8_BAR; PG8_WAIT_L(0); PG8_MMA(0, 1, At, B1); PG8_BAR;
            PG8_LDA(At, 0, 1); PG8_STAGE(PG8_SA(0, 0), a2, voffA);
            PG8_BAR; PG8_WAIT_L(0); PG8_MMA(1, 0, At, B0); PG8_BAR; PG8_SCHED;
            PG8_STAGE(PG8_SB(0, 1), b2 + hstep, voffB);
            PG8_WAIT_V(6); PG8_BAR; PG8_MMA(1, 1, At, B1); PG8_BAR;
            PG8_LDB(B0, 1, 0); PG8_SCHED; PG8_LDA(At, 1, 0); PG8_STAGE(PG8_SA(0, 1), a2 + hstep, voffA);
            PG8_WAIT_L(8); PG8_BAR; PG8_WAIT_L(0); PG8_MMA(0, 0, At, B0); PG8_BAR; PG8_SCHED;
            PG8_LDB(B1, 1, 1); PG8_STAGE(PG8_SB(1, 0), b3, voffB);
            PG8_BAR; PG8_WAIT_L(0); PG8_MMA(0, 1, At, B1); PG8_BAR;
            PG8_LDA(At, 1, 1); PG8_STAGE(PG8_SA(1, 0), a3, voffA);
            PG8_BAR; PG8_WAIT_L(0); PG8_MMA(1, 0, At, B0); PG8_BAR; PG8_SCHED;
            PG8_STAGE(PG8_SB(1, 1), b3 + hstep, voffB);
            PG8_WAIT_V(6); PG8_BAR; PG8_MMA(1, 1, At, B1); PG8_BAR;
        }
        E(acc, cur, wr, wc, fr, fq); S.done(cur);
        if (!has_next) break;
#pragma unroll
        for (int a = 0; a < 2; ++a)
#pragma unroll
            for (int b = 0; b < 2; ++b)
#pragma unroll
                for (int m = 0; m < 4; ++m)
#pragma unroll
                    for (int n = 0; n < 2; ++n) acc[a][b][m][n] = (f32x4){0.f, 0.f, 0.f, 0.f};
        cur = nxt; cA = nA; cB = nB; ++ui;
    }
    PG8_WAIT_V(0);
    if (wr == 0) PG8_BAR;
    PG8_BAR;
#undef PG8_SA
#undef PG8_SB
#undef PG8_STAGE
#undef PG8_LDA
#undef PG8_LDB
#undef PG8_MMA
#undef PG8_WAIT_V
#undef PG8_WAIT_L
#undef PG8_BAR
#undef PG8_SCHED
}
}
template <class ColMap>
DI void xpose_tile(LAS float* tile, const float* src, int lds_, bf16_t* dst, int ldd, const float* scale, int k0, int n0, const ColMap& cm) {
    int t = threadIdx.x; OPAQUE(t);
    __syncthreads();
#pragma unroll
    for (int i = 0; i < 8; ++i) { const int kk = (t >> 6) + 8 * i, nn = t & 63; const int c = cm(n0 + nn);
        float v = (c >= 0) ? src[(size_t)(k0 + kk) * lds_ + c] : 0.f; if (scale) v *= scale[k0 + kk]; tile[kk * 65 + nn] = v; }
    __syncthreads();
    { const int nn = t >> 3, kk = (t & 7) * 8; u32x4 w;
      w.x = cvt_pk_bf16(tile[(kk + 0) * 65 + nn], tile[(kk + 1) * 65 + nn]); w.y = cvt_pk_bf16(tile[(kk + 2) * 65 + nn], tile[(kk + 3) * 65 + nn]);
      w.z = cvt_pk_bf16(tile[(kk + 4) * 65 + nn], tile[(kk + 5) * 65 + nn]); w.w = cvt_pk_bf16(tile[(kk + 6) * 65 + nn], tile[(kk + 7) * 65 + nn]);
      *(u32x4*)(dst + (size_t)(n0 + nn) * ldd + k0 + kk) = w; }
}
struct CmIdent { DI int operator()(int n) const { return n; } };
struct CmWin { DI int operator()(int n) const { return win_orig_col(n); } };

DI void row_prep(const float* xrow, bf16_t* xbrow, float* ssprow, int lane) {
    for (int c0 = 0; c0 < D; c0 += 256) {
        f32x4 v = xrow ? *(const f32x4*)(xrow + c0 + lane * 4) : (f32x4){0.f, 0.f, 0.f, 0.f};
        u32x2 w; w.x = cvt_pk_bf16(v[0], v[1]); w.y = cvt_pk_bf16(v[2], v[3]);
        *(u32x2*)(xbrow + c0 + lane * 4) = w;
        float s = v[0] * v[0] + v[1] * v[1] + v[2] * v[2] + v[3] * v[3];
        s += __shfl_xor(s, 1); s += __shfl_xor(s, 2); s += __shfl_xor(s, 4); s += __shfl_xor(s, 8);
        if ((lane & 15) == 0) ssprow[(c0 >> 6) + (lane >> 4)] = s;
    }
}

DI void phase_prologue(const Params& p, LAS unsigned char* lds) {
    int tid = threadIdx.x; OPAQUE(tid);
    const int lane = tid & 63, wid = tid >> 6;
    unsigned char* ws = p.ws;
    LAS float* tile = (LAS float*)lds;
    const int T_WIN = (NP / 64) * (D / 64), T_WOUT = (D / 64) * (D / 64), T_WUP = (DFF / 64) * (D / 64), T_WDN = (D / 64) * (DFF / 64);
    const int T_LAYER = T_WIN + T_WOUT + T_WUP + T_WDN;
    for (int u = blockIdx.x; u < DEPTH * T_LAYER; u += gridDim.x) {
        const int l = u / T_LAYER; int r = u % T_LAYER;
        if (r < T_WIN) { const int nt = r / (D / 64), kt = r % (D / 64);
            xpose_tile(tile, p.in[I_WIN] + (size_t)l * D * NIN_ORIG, NIN_ORIG, (bf16_t*)(ws + WS_WIN) + (size_t)l * NP * D, D, p.in[I_N1W] + l * D, kt * 64, nt * 64, CmWin()); continue; }
        r -= T_WIN;
        if (r < T_WOUT) { const int nt = r / (D / 64), kt = r % (D / 64);
            xpose_tile(tile, p.in[I_WOUT] + (size_t)l * D * D, D, (bf16_t*)(ws + WS_WOUT) + (size_t)l * D * D, D, nullptr, kt * 64, nt * 64, CmIdent()); continue; }
        r -= T_WOUT;
        if (r < T_WUP) { const int nt = r / (D / 64), kt = r % (D / 64);
            xpose_tile(tile, p.in[I_WUP] + (size_t)l * D * DFF, DFF, (bf16_t*)(ws + WS_WUP) + (size_t)l * DFF * D, D, p.in[I_N2W] + l * D, kt * 64, nt * 64, CmIdent()); continue; }
        r -= T_WUP;
        { const int nt = r / (DFF / 64), kt = r % (DFF / 64);
            xpose_tile(tile, p.in[I_WDN] + (size_t)l * DFF * D, D, (bf16_t*)(ws + WS_WDN) + (size_t)l * D * DFF, DFF, nullptr, kt * 64, nt * 64, CmIdent()); }
    }
    { float* rc = (float*)(ws + WS_ROPE); float* rs = rc + (size_t)ROPE_N * 64;
      for (int i = blockIdx.x * 512 + tid; i < ROPE_N * 64; i += gridDim.x * 512) { const int pos = i >> 6, f = i & 63;
          const float inv = (float)pow(10000.0, -(double)f / 64.0); const float ang = (float)pos * inv;
          rc[i] = (float)cos((double)ang); rs[i] = (float)sin((double)ang); } }
    { bf16_t* xb = (bf16_t*)(ws + WS_XB); float* ssp = (float*)(ws + WS_SSP);
      for (int row = blockIdx.x * 8 + wid; row < MALL; row += gridDim.x * 8) {
          const float* xr = row < MP ? p.in[I_XP] + (size_t)row * D : (row - MP < MS ? p.in[I_XS] + (size_t)(row - MP) * D : nullptr);
          row_prep(xr, xb + (size_t)row * D, ssp + (size_t)row * NPART, lane); } }
}

struct EpiInProj {
    static constexpr bool PERM = true;
    int layer; unsigned char* ws; float* out;
    DI void st8(bf16_t* dst, const f32x4& a, const f32x4& b) const { u32x4 w; w.x = cvt_pk_bf16(a[0], a[1]); w.y = cvt_pk_bf16(a[2], a[3]); w.z = cvt_pk_bf16(b[0], b[1]); w.w = cvt_pk_bf16(b[2], b[3]); *(u32x4*)dst = w; }
    DI void st4(bf16_t* dst, const f32x4& a) const { u32x2 w; w.x = cvt_pk_bf16(a[0], a[1]); w.y = cvt_pk_bf16(a[2], a[3]); *(u32x2*)dst = w; }
    DI void operator()(const f32x4 (&acc)[2][2][4][2], const pg8::Unit& u, int wr, int wc, int fr, int fq) const {
        const bool sample = u.pm >= MP / 256;
        const int pn = u.pn;
        const float* ssp = (const float*)(ws + WS_SSP); const float* ropec = (const float*)(ws + WS_ROPE); const float* ropes = ropec + (size_t)ROPE_N * 64;
        bf16_t* qa = (bf16_t*)(ws + WS_QA); bf16_t* ka = (bf16_t*)(ws + WS_KA); bf16_t* va = (bf16_t*)(ws + WS_VA); bf16_t* braw = (bf16_t*)(ws + WS_BRAW); bf16_t* bz = (bf16_t*)(ws + WS_BZ);
        bf16_t* qc = (bf16_t*)(ws + WS_QC); bf16_t* kc = (bf16_t*)(ws + WS_KC); bf16_t* vc = (bf16_t*)(ws + WS_VC); bf16_t* gates = (bf16_t*)(ws + WS_GATES); float* bab = (float*)(ws + WS_BAB);
        int kind, segt;
        if (pn < TD) { kind = 0; segt = 0; } else if (pn < 2 * TD) { kind = 1; segt = TD; } else if (pn < 3 * TD) { kind = 2; segt = 2 * TD; }
        else if (pn < 6 * TD) { kind = 3; segt = 3 * TD; } else if (pn < 7 * TD) { kind = 4; segt = 6 * TD; } else if (pn < 8 * TD) { kind = 5; segt = 7 * TD; }
        else if (pn < 9 * TD) { kind = 6; segt = 8 * TD; } else if (pn < 10 * TD) { kind = 7; segt = 9 * TD; } else if (pn < 13 * TD) { kind = 8; segt = 10 * TD; }
        else { kind = 9; segt = 13 * TD; }
        const int cb = (pn - segt) * 256 + wc * 32 + fq * 8;
#pragma unroll
        for (int ai = 0; ai < 2; ++ai)
#pragma unroll
            for (int m = 0; m < 4; ++m) {
                const int row = u.pm * 256 + ai * 128 + wr * 64 + m * 16 + fr;
                int b, t, L; bool valid = true;
                if (!sample) { b = row / SEQ; t = row % SEQ; L = SEQ; } else { const int sr = row - MP; valid = sr < MS; b = sr / DSEQ; t = sr % DSEQ; L = DSEQ; }
                if (!valid) continue;
                const int pos = sample ? PAST + t : t;
                float ss = 0.f;
#pragma unroll
                for (int j = 0; j < NPART; j += 4) { const f32x4 q = *(const f32x4*)(ssp + (size_t)row * NPART + j); ss += (q[0] + q[1]) + (q[2] + q[3]); }
                const float rs = 1.0f / sqrtf(ss * (1.0f / D) + EPS);
                const size_t orow = ((size_t)(layer * (sample ? DB : NB) + b) * L + t) * D;
#pragma unroll
                for (int bj = 0; bj < 2; ++bj) {
                    const f32x4 v0 = acc[ai][bj][m][0] * rs, v1 = acc[ai][bj][m][1] * rs;
                    const int c = cb + bj * 128;
                    if (kind <= 1) {
                        const int head = c >> 7, d0 = ((c & 127) >> 3) * 4;
                        const f32x4 cs = *(const f32x4*)(ropec + (size_t)pos * 64 + d0), sn = *(const f32x4*)(ropes + (size_t)pos * 64 + d0);
                        const f32x4 o1 = v0 * cs - v1 * sn, o2 = v1 * cs + v0 * sn;
                        const int tc = head * 128 + d0;
                        bf16_t* dst = (kind == 0 ? qa : ka) + (size_t)row * D + tc;
                        st4(dst, o1); st4(dst + 64, o2);
                        if (kind == 1) { float* o = out + (sample ? O_SAK : O_PAK) + orow + tc; *(f32x4*)o = o1; *(f32x4*)(o + 64) = o2; }
                    } else if (kind == 2) { st8(va + (size_t)row * D + c, v0, v1); float* o = out + (sample ? O_SAV : O_PAV) + orow + c; *(f32x4*)o = v0; *(f32x4*)(o + 4) = v1; }
                    else if (kind == 3) { st8(braw + (size_t)row * 3 * D + c, v0, v1);
                        if (t >= L - 3) { float* o = out + (sample ? O_SBC : O_PBC) + ((size_t)(layer * (sample ? DB : NB) + b) * 3 + (t - (L - 3))) * 3 * D + c; *(f32x4*)o = v0; *(f32x4*)(o + 4) = v1; } }
                    else if (kind == 4) st8(bz + (size_t)row * D + c, v0, v1);
                    else if (kind == 5) st8(qc + (size_t)row * D + c, v0, v1);
                    else if (kind == 6) { st8(kc + (size_t)row * D + c, v0, v1); float* o = out + (sample ? O_SCK : O_PCK) + orow + c; *(f32x4*)o = v0; *(f32x4*)(o + 4) = v1; }
                    else if (kind == 7) { st8(vc + (size_t)row * D + c, v0, v1); float* o = out + (sample ? O_SCV : O_PCV) + orow + c; *(f32x4*)o = v0; *(f32x4*)(o + 4) = v1; }
                    else if (kind == 8) { f32x4 g0, g1;
#pragma unroll
                        for (int e = 0; e < 4; ++e) { g0[e] = sigmoidf_(v0[e]); g1[e] = sigmoidf_(v1[e]); }
                        st8(gates + (size_t)row * 3 * D + c, g0, g1); }
                    else { if (c < 16) { float* o = bab + (size_t)row * 16 + c; *(f32x4*)o = v0; *(f32x4*)(o + 4) = v1; } }
                }
                COMPILER_FENCE();
            }
    }
};

DI void phase_conv(const Params& p, int l, LAS unsigned char* lds) {
    int tid = threadIdx.x; OPAQUE(tid);
    unsigned char* ws = p.ws;
    const bf16_t* braw = (const bf16_t*)(ws + WS_BRAW);
    bf16_t* bqkv[3] = {(bf16_t*)(ws + WS_BQ), (bf16_t*)(ws + WS_BK), (bf16_t*)(ws + WS_BV)};
    const float* bab = (const float*)(ws + WS_BAB); float* gb = (float*)(ws + WS_GB);
    const float* convw = p.in[I_CONVW] + (size_t)l * CONVW * 3 * D;
    const float* alog = p.in[I_ALOG] + l * HB; const float* dtb = p.in[I_DTB] + l * HB;
    constexpr int NTH = 3 * D / 8;
    constexpr int NU_P = MP / 32, NU = NU_P + DB;
    const int col8 = tid * 8, seg = col8 / D, cseg = col8 % D;
    float cw[4][8];
    if (tid < NTH) {
#pragma unroll
        for (int k = 0; k < 4; ++k) { const f32x4 a = *(const f32x4*)(convw + (size_t)k * 3 * D + col8), b = *(const f32x4*)(convw + (size_t)k * 3 * D + col8 + 4);
#pragma unroll
            for (int e = 0; e < 4; ++e) { cw[k][e] = a[e]; cw[k][4 + e] = b[e]; } }
    }
    for (int u = blockIdx.x; u < NU; u += gridDim.x) {
        const bool sample = u >= NU_P;
        const int b = sample ? u - NU_P : (u * 32) / SEQ, t0 = sample ? 0 : (u * 32) % SEQ, nrow = sample ? 64 : 32, nreal = sample ? DSEQ : 32;
        const size_t rawrow0 = sample ? (size_t)MP + (size_t)b * DSEQ : (size_t)b * SEQ + t0;
        const size_t dstrow0 = sample ? (size_t)MP + (size_t)b * 64 : (size_t)b * SEQ + t0;
        if (tid < NTH) {
            float w3[8], w2[8], w1[8];
#pragma unroll
            for (int e = 0; e < 8; ++e) { w3[e] = 0.f; w2[e] = 0.f; w1[e] = 0.f; }
            if (sample) { const float* hs = p.in[I_SCONV] + ((size_t)(l * DB + b) * 3) * 3 * D + col8;
#pragma unroll
                for (int e = 0; e < 8; ++e) { w3[e] = hs[e]; w2[e] = hs[3 * D + e]; w1[e] = hs[6 * D + e]; } }
            else if (t0 >= 3) {
                const u32x4 a = *(const u32x4*)(braw + (rawrow0 - 3) * 3 * D + col8), bb = *(const u32x4*)(braw + (rawrow0 - 2) * 3 * D + col8), c = *(const u32x4*)(braw + (rawrow0 - 1) * 3 * D + col8);
#pragma unroll
                for (int e = 0; e < 4; ++e) { w3[2 * e] = bf_lo(a[e]); w3[2 * e + 1] = bf_hi(a[e]); w2[2 * e] = bf_lo(bb[e]); w2[2 * e + 1] = bf_hi(bb[e]); w1[2 * e] = bf_lo(c[e]); w1[2 * e + 1] = bf_hi(c[e]); }
            }
            for (int t = 0; t < nrow; ++t) {
                float o[8];
                if (t < nreal) {
                    const u32x4 a = *(const u32x4*)(braw + (rawrow0 + t) * 3 * D + col8);
                    float w0[8];
#pragma unroll
                    for (int e = 0; e < 4; ++e) { w0[2 * e] = bf_lo(a[e]); w0[2 * e + 1] = bf_hi(a[e]); }
                    float ss = 0.f;
#pragma unroll
                    for (int e = 0; e < 8; ++e) { const float c = w3[e] * cw[0][e] + w2[e] * cw[1][e] + w1[e] * cw[2][e] + w0[e] * cw[3][e];
                        const float s = c * sigmoidf_(c); o[e] = s; ss += s * s; w3[e] = w2[e]; w2[e] = w1[e]; w1[e] = w0[e]; }
                    if (seg < 2) { ss += __shfl_xor(ss, 1); ss += __shfl_xor(ss, 2); ss += __shfl_xor(ss, 4); ss += __shfl_xor(ss, 8);
                        const float sc = (1.0f / sqrtf(ss + EPS)) * (seg == 0 ? 0.08838834764831845f : 1.0f);
#pragma unroll
                        for (int e = 0; e < 8; ++e) o[e] *= sc; }
                } else {
#pragma unroll
                    for (int e = 0; e < 8; ++e) o[e] = 0.f;
                }
                u32x4 w; w.x = cvt_pk_bf16(o[0], o[1]); w.y = cvt_pk_bf16(o[2], o[3]); w.z = cvt_pk_bf16(o[4], o[5]); w.w = cvt_pk_bf16(o[6], o[7]);
                *(u32x4*)(bqkv[seg] + (dstrow0 + t) * D + cseg) = w;
            }
        }
        for (int i = tid; i < nrow * HB; i += 512) { const int t = i / HB, h = i % HB; float g = 0.f, be = 0.f;
            if (t < nreal) { const float ba = bab[(rawrow0 + t) * 16 + h], bbv = bab[(rawrow0 + t) * 16 + HB + h];
                const float x = ba + dtb[h]; const float sp = fmaxf(x, 0.f) + log1pf(expf(-fabsf(x)));
                g = -expf(alog[h]) * sp; be = 1.0f / (1.0f + expf(-bbv)); }
            gb[(dstrow0 + t) * 16 + h] = g; gb[(dstrow0 + t) * 16 + 8 + h] = be; }
    }
}

DI int crow32(int reg, int h) { return (reg & 3) + 8 * (reg >> 2) + 4 * h; }
DI bf16x8 pack8(const f32x16& x, int s) {
    u32x4 w; w.x = cvt_pk_bf16(x[8 * s + 0], x[8 * s + 1]); w.y = cvt_pk_bf16(x[8 * s + 2], x[8 * s + 3]); w.z = cvt_pk_bf16(x[8 * s + 4], x[8 * s + 5]); w.w = cvt_pk_bf16(x[8 * s + 6], x[8 * s + 7]);
    return __builtin_bit_cast(bf16x8, w);
}
#define MFMA32(a, b, c) __builtin_amdgcn_mfma_f32_32x32x16_bf16((a), (b), (c), 0, 0, 0)
DI f32x16 zero16() { f32x16 z;
#pragma unroll
    for (int i = 0; i < 16; ++i) z[i] = 0.f; return z; }

DI void unit_rows_b(int u, int& row0, int& h) {
    if (u < NB * NCH * HB) { h = u % HB; const int bc = u / HB; row0 = (bc / NCH) * SEQ + (bc % NCH) * 64; }
    else { const int s = u - NB * NCH * HB; h = s % HB; row0 = MP + (s / HB) * 64; }
}

DI void phase_gdn_pre(const Params& p, LAS unsigned char* lds) {
    int tid = threadIdx.x; OPAQUE(tid);
    const int lane_ = tid & 63, wid = tid >> 6;
    unsigned char* ws = p.ws;
    const bf16_t* bq = (const bf16_t*)(ws + WS_BQ); const bf16_t* bk = (const bf16_t*)(ws + WS_BK);
    const float* gb = (const float*)(ws + WS_GB);
    bf16_t* TT = (bf16_t*)(ws + WS_TT); bf16_t* AQ = (bf16_t*)(ws + WS_AQK); float* CV = (float*)(ws + WS_CV);
    LAS float* Mm = (LAS float*)(lds + wid * 16896);
    LAS float* gcs = Mm + 4096;
    for (int u = blockIdx.x * 8 + wid; u < NUNIT_B; u += gridDim.x * 8) {
        int lane = lane_; OPAQUE(lane);
        const int r = lane & 31, hh = lane >> 5;
        int row0, h; unit_rows_b(u, row0, h);
        const float g = gb[(size_t)(row0 + lane) * 16 + h], be = gb[(size_t)(row0 + lane) * 16 + 8 + h];
        float gc = g;
#pragma unroll
        for (int d = 1; d < 64; d <<= 1) { const float o = __shfl_up(gc, d); if (lane >= d) gc += o; }
        const float gL = __shfl(gc, 63);
        gcs[lane] = gc; gcs[64 + lane] = be;
        { float* cv = CV + (size_t)u * 256; const float eg = expf(gc); cv[lane] = be; cv[64 + lane] = be * eg; cv[128 + lane] = eg; cv[192 + lane] = expf(gL - gc); }
        WAVE_LDS_FENCE();
#pragma unroll
        for (int bi = 0; bi < 2; ++bi)
#pragma unroll
            for (int bj = 0; bj < 2; ++bj) {
                f32x16 kk = zero16(), qk = zero16();
                if (bj <= bi) {
                    const bf16_t* ki = bk + (size_t)(row0 + 32 * bi + r) * D + h * 128 + 8 * hh; const bf16_t* kj = bk + (size_t)(row0 + 32 * bj + r) * D + h * 128 + 8 * hh;
                    const bf16_t* qi = bq + (size_t)(row0 + 32 * bi + r) * D + h * 128 + 8 * hh;
#pragma unroll 2
                    for (int s = 0; s < 8; ++s) { const bf16x8 fki = *(const bf16x8*)(ki + 16 * s), fkj = *(const bf16x8*)(kj + 16 * s), fqi = *(const bf16x8*)(qi + 16 * s);
                        kk = MFMA32(fki, fkj, kk); qk = MFMA32(fqi, fkj, qk); }
                }
                __builtin_amdgcn_sched_barrier(0);
                const int j = 32 * bj + r; const float gcj = gcs[j];
#pragma unroll
                for (int i16 = 0; i16 < 16; ++i16) { const int i = 32 * bi + crow32(i16, hh); const float gci = gcs[i], bei = gcs[64 + i];
                    const float dec = (j <= i) ? expf(gci - gcj) : 0.f;
                    if (bj <= bi) Mm[i * 64 + j] = (j < i) ? bei * kk[i16] * dec : 0.f;
                    AQ[(size_t)u * 4096 + i * 64 + j] = f2bf((bj <= bi) ? qk[i16] * dec : 0.f); }
                __builtin_amdgcn_sched_barrier(0);
            }
        WAVE_LDS_FENCE();
        float tcol[64];
#pragma unroll
        for (int i = 0; i < 64; ++i) {
            float a = (i == lane) ? 1.f : 0.f;
#pragma unroll
            for (int j4 = 0; j4 < (i + 3) / 4; ++j4) { const f32x4 mv = *(const LAS f32x4*)(Mm + i * 64 + 4 * j4);
#pragma unroll
                for (int e = 0; e < 4; ++e) if (4 * j4 + e < i) a -= mv[e] * tcol[4 * j4 + e]; }
            tcol[i] = a;
            TT[(size_t)u * 4096 + i * 64 + lane] = f2bf(a);
            __builtin_amdgcn_sched_barrier(0);
        }
        WAVE_LDS_FENCE();
    }
}

DI unsigned img_b(unsigned row, unsigned ch) { return 256u * row + 16u * (ch ^ (((row & 3u) << 2) | ((row >> 2) & 3u))); }
DI bf16x8 ld2x8(const LAS unsigned char* p0, const LAS unsigned char* p1) {
    const u32x2 a = *(const LAS u32x2*)p0, b = *(const LAS u32x2*)p1; u32x4 w; w.x = a.x; w.y = a.y; w.z = b.x; w.w = b.y; return __builtin_bit_cast(bf16x8, w);
}
constexpr int SC_KI = 0, SC_QI = 16384, SC_VI = 32768, SC_TI = 49152, SC_AI = 57344, SC_CV = 65536, SC_END = 66560;

DI void phase_gdn_scan(const Params& p, int l, LAS unsigned char* lds) {
    int tid = threadIdx.x; OPAQUE(tid);
    const int lane_ = tid & 63, wid = tid >> 6;
    unsigned char* ws = p.ws;
    const bf16_t* bq = (const bf16_t*)(ws + WS_BQ); const bf16_t* bk = (const bf16_t*)(ws + WS_BK); const bf16_t* bv = (const bf16_t*)(ws + WS_BV);
    const bf16_t* TT = (const bf16_t*)(ws + WS_TT); const bf16_t* AQ = (const bf16_t*)(ws + WS_AQK); const float* CV = (const float*)(ws + WS_CV);
    bf16_t* ob = (bf16_t*)(ws + WS_OBUF);
    constexpr int NCHAIN = NB * HB + DB * HB;
    for (int ch = blockIdx.x; ch < NCHAIN; ch += gridDim.x) {
        int lane = lane_; OPAQUE(lane);
        const int r = lane & 31, hh = lane >> 5;
        unsigned sa[8], ta[2][4];
        { const int blk = (lane >> 4) & 1, q4 = (lane & 15) >> 2, p4 = lane & 3;
    #pragma unroll
          for (int s = 0; s < 8; ++s) sa[s] = img_b(r, 2 * s) + 8 * hh;
    #pragma unroll
          for (int t = 0; t < 2; ++t)
    #pragma unroll
              for (int cb = 0; cb < 4; ++cb) ta[t][cb] = img_b(4 * hh + q4 + 8 * t, 4 * cb + 2 * blk + (p4 >> 1)) + 8 * (p4 & 1); }

        const bool sample = ch >= NB * HB;
        const int b = sample ? (ch - NB * HB) / HB : ch / HB, h = ch % HB, nchunk = sample ? 1 : NCH;
        const int dv0 = 32 * wid;
        f32x16 S[4];
        if (wid < 4) {
#pragma unroll
            for (int kb = 0; kb < 4; ++kb) { S[kb] = zero16();
                if (sample) { const float* s0 = p.in[I_SSSM] + ((size_t)(l * DB + b) * HB + h) * 128 * 128;
#pragma unroll
                    for (int i = 0; i < 16; ++i) S[kb][i] = s0[(size_t)(32 * kb + crow32(i, hh)) * 128 + dv0 + r]; } }
        }
        for (int c = 0; c < nchunk; ++c) {
            const int u = sample ? NB * NCH * HB + b * HB + h : (b * NCH + c) * HB + h;
            const int row0 = sample ? MP + b * 64 : b * SEQ + c * 64;
            __syncthreads();
            int tidv = tid; OPAQUE(tidv);
#pragma unroll
            for (int i = 0; i < 2; ++i) { const int idx = tidv + 512 * i, row = idx >> 4, chn = idx & 15; const size_t go = (size_t)(row0 + row) * D + h * 128 + chn * 8; const unsigned lo = img_b(row, chn);
                *(LAS u32x4*)(lds + SC_KI + lo) = *(const u32x4*)(bk + go); *(LAS u32x4*)(lds + SC_QI + lo) = *(const u32x4*)(bq + go); *(LAS u32x4*)(lds + SC_VI + row * 256 + chn * 16) = *(const u32x4*)(bv + go); }
            { *(LAS u32x4*)(lds + SC_TI + tidv * 16) = *(const u32x4*)(TT + (size_t)u * 4096 + tidv * 8); *(LAS u32x4*)(lds + SC_AI + tidv * 16) = *(const u32x4*)(AQ + (size_t)u * 4096 + tidv * 8); }
            if (tidv < 256) *(LAS float*)(lds + SC_CV + tidv * 4) = CV[(size_t)u * 256 + tidv];
            __syncthreads();
            if (wid < 4) {
                const LAS float* cv = (const LAS float*)(lds + SC_CV);
                f32x16 ks[2], qs[2];
                ks[0] = zero16(); ks[1] = zero16(); qs[0] = zero16(); qs[1] = zero16();
#pragma unroll
                for (int s = 0; s < 8; ++s) { const bf16x8 sb = pack8(S[s >> 1], s & 1); const unsigned o0 = sa[s], o1 = sa[s] ^ 16u;
                    ks[0] = MFMA32(ld2x8(lds + SC_KI + o0, lds + SC_KI + o1), sb, ks[0]);
                    ks[1] = MFMA32(ld2x8(lds + SC_KI + 8192 + o0, lds + SC_KI + 8192 + o1), sb, ks[1]);
                    qs[0] = MFMA32(ld2x8(lds + SC_QI + o0, lds + SC_QI + o1), sb, qs[0]);
                    qs[1] = MFMA32(ld2x8(lds + SC_QI + 8192 + o0, lds + SC_QI + 8192 + o1), sb, qs[1]);
                    __builtin_amdgcn_sched_barrier(0); }
                __builtin_amdgcn_sched_barrier(0);
                f32x16 rr[2];
#pragma unroll
                for (int tb = 0; tb < 2; ++tb)
#pragma unroll
                    for (int i = 0; i < 16; ++i) { const int tok = 32 * tb + crow32(i, hh); const int dv = dv0 + r;
                        const float v = bf2f(*(const LAS bf16_t*)(lds + SC_VI + tok * 256 + 2 * dv));
                        rr[tb][i] = cv[tok] * v - cv[64 + tok] * ks[tb][i]; }
                __builtin_amdgcn_sched_barrier(0);
                bf16x8 Rb[4];
#pragma unroll
                for (int s2 = 0; s2 < 4; ++s2) Rb[s2] = pack8(rr[s2 >> 1], s2 & 1);
                f32x16 uu[2];
#pragma unroll
                for (int tb = 0; tb < 2; ++tb) { uu[tb] = zero16();
#pragma unroll
                    for (int s2 = 0; s2 < 2 * tb + 2; ++s2) { const LAS unsigned char* base = lds + SC_TI + (32 * tb + r) * 128 + 32 * s2 + 8 * hh;
                        uu[tb] = MFMA32(ld2x8(base, base + 16), Rb[s2], uu[tb]); } }
#ifdef EMU
                if (getenv("EMU_TRACE") && lane == 0 && wid == 0 && c == 0) { printf("ch %d: ks0 %g ks1 %g qs1 %g rr0 %g rr1 %g uu0 %g uu1 %g cv %g %g %g %g\n", ch, ks[0][0], ks[1][0], qs[1][0], rr[0][0], rr[1][0], uu[0][0], uu[1][0], cv[32], cv[96], cv[160], cv[224]); }
#endif
                bf16x8 Ub[4], Ud[4];
                f32x16 ud[2];
#pragma unroll
                for (int tb = 0; tb < 2; ++tb)
#pragma unroll
                    for (int i = 0; i < 16; ++i) ud[tb][i] = uu[tb][i] * cv[192 + 32 * tb + crow32(i, hh)];
#pragma unroll
                for (int s2 = 0; s2 < 4; ++s2) { Ub[s2] = pack8(uu[s2 >> 1], s2 & 1); Ud[s2] = pack8(ud[s2 >> 1], s2 & 1); }
                __builtin_amdgcn_sched_barrier(0);
#pragma unroll
                for (int tb = 0; tb < 2; ++tb) { f32x16 o;
#pragma unroll
                    for (int i = 0; i < 16; ++i) o[i] = qs[tb][i] * cv[128 + 32 * tb + crow32(i, hh)];
#pragma unroll
                    for (int s2 = 0; s2 < 2 * tb + 2; ++s2) { const LAS unsigned char* base = lds + SC_AI + (32 * tb + r) * 128 + 32 * s2 + 8 * hh;
                        o = MFMA32(ld2x8(base, base + 16), Ub[s2], o); }
#pragma unroll
                    for (int i = 0; i < 16; ++i) ob[(size_t)(row0 + 32 * tb + crow32(i, hh)) * D + h * 128 + dv0 + r] = f2bf(o[i]); }
                __builtin_amdgcn_sched_barrier(0);
                const float egL = cv[128 + 63];
#pragma unroll
                for (int kb = 0; kb < 4; ++kb) {
#pragma unroll
                    for (int i = 0; i < 16; ++i) S[kb][i] *= egL;
#pragma unroll
                    for (int s2 = 0; s2 < 4; ++s2) {
                        const s16x4 lo = ds_read_tr16(lds + SC_KI + s2 * 4096 + ta[0][kb]);
                        const s16x4 hi = ds_read_tr16(lds + SC_KI + s2 * 4096 + ta[1][kb]);
                        const bf16x8 a = __builtin_shufflevector(lo, hi, 0, 1, 2, 3, 4, 5, 6, 7);
                        S[kb] = MFMA32(a, Ud[s2], S[kb]); __builtin_amdgcn_sched_barrier(0);
#ifdef EMU
                        if (getenv("EMU_TRACE") && lane == 0 && wid == 0 && c == 0 && ch == 0) printf("  kb %d s2 %d: a0 %g a4 %g ud %g S %g egL %g\n", kb, s2, bf2f((bf16_t)a[0]), bf2f((bf16_t)a[4]), bf2f((bf16_t)Ud[s2][0]), S[kb][0], egL);
#endif
                        }
                }
            }
        }
        if (wid < 4) { int cl = dv0 + r + 512 * hh; OPAQUE(cl);
            float* so = p.out + (sample ? O_SBS : O_PBS) + ((size_t)(l * (sample ? DB : NB) + b) * HB + h) * 128 * 128 + cl;
#pragma unroll
            for (int kb = 0; kb < 4; ++kb)
#pragma unroll
                for (int i = 0; i < 16; ++i) so[(32 * kb + (i & 3) + 8 * (i >> 2)) * 128] = S[kb][i]; }
    }
}
constexpr int AT_K = 0, AT_V = 32768, AT_Q = 65536, AT_FLAG = 131072, AT_X = 0  ;

template <bool SRC32>
DI void stage_rows(LAS unsigned char* img, const void* src, size_t row_pitch_elems, int nrows, int nvalid) {
    int tid = threadIdx.x; OPAQUE(tid);
    for (int idx = tid; idx < nrows * 16; idx += 512) { const int row = idx >> 4, chn = idx & 15; u32x4 w = (u32x4){0u, 0u, 0u, 0u};
        if (row < nvalid) {
            if (SRC32) { const float* s = (const float*)src + (size_t)row * row_pitch_elems + chn * 8; const f32x4 a = *(const f32x4*)s, b = *(const f32x4*)(s + 4);
                w.x = cvt_pk_bf16(a[0], a[1]); w.y = cvt_pk_bf16(a[2], a[3]); w.z = cvt_pk_bf16(b[0], b[1]); w.w = cvt_pk_bf16(b[2], b[3]); }
            else w = *(const u32x4*)((const bf16_t*)src + (size_t)row * row_pitch_elems + chn * 8);
        }
        *(LAS u32x4*)(img + img_b(row, chn)) = w; }
}
struct LaneOffs { unsigned ra[8]; unsigned ta[2][4]; };
DI LaneOffs make_lane_offs(int lane) {
    LaneOffs L; const int r = lane & 31, hh = lane >> 5, blk = (lane >> 4) & 1, q4 = (lane & 15) >> 2, p4 = lane & 3;
#pragma unroll
    for (int ks = 0; ks < 8; ++ks) L.ra[ks] = img_b(r, 2 * ks + hh);
#pragma unroll
    for (int t = 0; t < 2; ++t)
#pragma unroll
        for (int cb = 0; cb < 4; ++cb) L.ta[t][cb] = img_b(4 * hh + q4 + 8 * t, 4 * cb + 2 * blk + (p4 >> 1)) + 8 * (p4 & 1);
    return L;
}
DI bf16x8 lds_frag_row(const LAS unsigned char* img, const LaneOffs& L, int ks) { return *(const LAS bf16x8*)(img + L.ra[ks]); }
DI bf16x8 lds_frag_tr(const LAS unsigned char* img, const LaneOffs& L, int s2, int cb) {
    const s16x4 lo = ds_read_tr16(img + s2 * 4096 + L.ta[0][cb]);
    const s16x4 hi = ds_read_tr16(img + s2 * 4096 + L.ta[1][cb]);
    return __builtin_shufflevector(lo, hi, 0, 1, 2, 3, 4, 5, 6, 7);
}

DI void phase_attn_a(const Params& p, int l, LAS unsigned char* lds) {
    int tid = threadIdx.x; OPAQUE(tid);
    const int lane_ = tid & 63, wid = tid >> 6, c = wid >> 2, rg = wid & 3;
    unsigned char* ws = p.ws;
    const bf16_t* QA = (const bf16_t*)(ws + WS_QA); const bf16_t* KA = (const bf16_t*)(ws + WS_KA); const bf16_t* VA = (const bf16_t*)(ws + WS_VA);
    bf16_t* OA = (bf16_t*)(ws + WS_OA);
    const float lam_init = 0.8f - 0.6f * expf(-0.3f * (float)l);
    float lam;
    { float d1 = 0.f, d2 = 0.f; const float* q1 = p.in[I_LQ1] + l * 128; const float* k1 = p.in[I_LK1] + l * 128; const float* q2 = p.in[I_LQ2] + l * 128; const float* k2 = p.in[I_LK2] + l * 128;
      for (int i = 0; i < 128; ++i) { d1 += q1[i] * k1[i]; d2 += q2[i] * k2[i]; } lam = expf(d1) - expf(d2) + lam_init; }
    const float* subw = p.in[I_SUBLN] + l * 256;
    constexpr int NQB = SEQ / 128, NU_P = NB * HA * NQB, NU = NU_P + DB * HA;
    const float sc = 0.08838834764831845f * 1.44269504089f;
    for (int u = blockIdx.x; u < NU; u += gridDim.x) {
        int lane = lane_; OPAQUE(lane);
        const int r = lane & 31, hh = lane >> 5;
        const LaneOffs LO = make_lane_offs(lane);
        const bool sample = u >= NU_P;
        int b, h, qb, ntile; size_t qrow0;
        if (!sample) { qb = NQB - 1 - (u % NQB); const int bh = u / NQB; h = bh % HA; b = bh / HA; ntile = 2 * qb + 2; qrow0 = (size_t)b * SEQ + qb * 128; }
        else { const int s = u - NU_P; h = s % HA; b = s / HA; qb = 0; ntile = PAST / 64 + 1; qrow0 = (size_t)MP + (size_t)b * DSEQ; }
        const int nq = sample ? 32 : 128;
        __syncthreads();
        stage_rows<false>(lds + AT_Q, QA + qrow0 * D + (2 * h) * 128, D, nq, nq);
        stage_rows<false>(lds + AT_Q + 32768, QA + qrow0 * D + (2 * h + 1) * 128, D, nq, nq);
        f32x16 O[8];
#pragma unroll
        for (int i = 0; i < 8; ++i) O[i] = zero16();
        float m = -1e30f, lsum = 0.f;
        const bool wave_on = sample ? (rg == 0) : true;
        for (int j = 0; j < ntile; ++j) {
            __syncthreads();
            int nvalid = 64;
            if (!sample) { const size_t kr = (size_t)b * SEQ + (size_t)j * 64;
                stage_rows<false>(lds + AT_K, KA + kr * D + (2 * h) * 128, D, 64, 64); stage_rows<false>(lds + AT_K + 16384, KA + kr * D + (2 * h + 1) * 128, D, 64, 64);
                stage_rows<false>(lds + AT_V, VA + kr * D + h * 256, D, 64, 64); stage_rows<false>(lds + AT_V + 16384, VA + kr * D + h * 256 + 128, D, 64, 64); }
            else if (j < PAST / 64) { const size_t kr = ((size_t)(l * DB + b) * PAST + (size_t)j * 64) * D;
                stage_rows<true>(lds + AT_K, p.in[I_CAK] + kr + (2 * h) * 128, D, 64, 64); stage_rows<true>(lds + AT_K + 16384, p.in[I_CAK] + kr + (2 * h + 1) * 128, D, 64, 64);
                stage_rows<true>(lds + AT_V, p.in[I_CAV] + kr + h * 256, D, 64, 64); stage_rows<true>(lds + AT_V + 16384, p.in[I_CAV] + kr + h * 256 + 128, D, 64, 64); }
            else { nvalid = DSEQ; const size_t kr = (size_t)MP + (size_t)b * DSEQ;
                stage_rows<false>(lds + AT_K, KA + kr * D + (2 * h) * 128, D, 64, DSEQ); stage_rows<false>(lds + AT_K + 16384, KA + kr * D + (2 * h + 1) * 128, D, 64, DSEQ);
                stage_rows<false>(lds + AT_V, VA + kr * D + h * 256, D, 64, DSEQ); stage_rows<false>(lds + AT_V + 16384, VA + kr * D + h * 256 + 128, D, 64, DSEQ); }
            __syncthreads();
            const bool vis = sample ? true : (j <= 2 * qb + (rg >> 1));
            if (wave_on && vis) {
                const LAS unsigned char* Ki = lds + AT_K + c * 16384; const LAS unsigned char* Qi = lds + AT_Q + c * 32768;
                f32x16 s[2]; s[0] = zero16(); s[1] = zero16();
#pragma unroll
                for (int ks = 0; ks < 8; ++ks) { const bf16x8 qf = lds_frag_row(Qi + rg * 8192, LO, ks);
                    s[0] = MFMA32(lds_frag_row(Ki, LO, ks), qf, s[0]); s[1] = MFMA32(lds_frag_row(Ki + 8192, LO, ks), qf, s[1]); if (ks & 1) __builtin_amdgcn_sched_barrier(0); }
                float mt = -1e30f;
#pragma unroll
                for (int kb = 0; kb < 2; ++kb)
#pragma unroll
                    for (int i = 0; i < 16; ++i) { const int key = 32 * kb + crow32(i, hh); float v = s[kb][i] * sc; if (key >= nvalid) v = -1e30f; s[kb][i] = v; mt = fmaxf(mt, v); }
                mt = fmaxf(mt, __shfl_xor(mt, 32));
                const float mn = fmaxf(m, mt), alpha = fast_exp2(m - mn); m = mn;
                float ps = 0.f;
#pragma unroll
                for (int kb = 0; kb < 2; ++kb)
#pragma unroll
                    for (int i = 0; i < 16; ++i) { const float e = fast_exp2(s[kb][i] - mn); s[kb][i] = e; ps += e; }
                lsum = lsum * alpha + ps;
#pragma unroll
                for (int d = 0; d < 8; ++d)
#pragma unroll
                    for (int i = 0; i < 16; ++i) O[d][i] *= alpha;
#pragma unroll
                for (int s2 = 0; s2 < 4; ++s2) { const bf16x8 pb = pack8(s[s2 >> 1], s2 & 1);
#pragma unroll
                    for (int d = 0; d < 8; ++d) { O[d] = MFMA32(lds_frag_tr(lds + AT_V + (d >> 2) * 16384, LO, s2, d & 3), pb, O[d]); if (d & 1) __builtin_amdgcn_sched_barrier(0); } }
            }
        }
        const float inv_l = 1.0f / (lsum + __shfl_xor(lsum, 32));
#pragma unroll
        for (int d = 0; d < 8; ++d)
#pragma unroll
            for (int i = 0; i < 16; ++i) O[d][i] *= inv_l;
        LAS float* X = (LAS float*)(lds + AT_X);
#pragma unroll
        for (int hv = 0; hv < 2; ++hv) {
            __syncthreads();
            if (c == 1) {
#pragma unroll
                for (int d = 0; d < 4; ++d)
#pragma unroll
                    for (int i = 0; i < 16; ++i) X[((rg * 64) + d * 16 + i) * 64 + lane] = O[4 * hv + d][i]; }
            __syncthreads();
            if (c == 0) {
#pragma unroll
                for (int d = 0; d < 4; ++d)
#pragma unroll
                    for (int i = 0; i < 16; ++i) O[4 * hv + d][i] -= lam * X[((rg * 64) + d * 16 + i) * 64 + lane]; }
        }
        if (c == 0 && wave_on) {
            float ss = 0.f;
#pragma unroll
            for (int d = 0; d < 8; ++d)
#pragma unroll
                for (int i = 0; i < 16; ++i) ss += O[d][i] * O[d][i];
            ss += __shfl_xor(ss, 32);
            const float rstd = (1.0f / sqrtf(ss * (1.0f / 256.0f) + EPS)) * (1.0f - lam_init);
            int qi = 32 * rg + r; OPAQUE(qi);
            if (!sample || qi < DSEQ) {
                bf16_t* dst = OA + (qrow0 + qi) * D + h * 256;
#pragma unroll
                for (int d = 0; d < 8; ++d)
#pragma unroll
                    for (int g4 = 0; g4 < 4; ++g4) { const int dv = 32 * d + 8 * g4 + 4 * hh; const f32x4 w = *(const f32x4*)(subw + dv);
                        u32x2 o; o.x = cvt_pk_bf16(O[d][4 * g4] * rstd * w[0], O[d][4 * g4 + 1] * rstd * w[1]); o.y = cvt_pk_bf16(O[d][4 * g4 + 2] * rstd * w[2], O[d][4 * g4 + 3] * rstd * w[3]);
                        *(u32x2*)(dst + dv) = o; }
            }
        }
    }
}

DI void phase_attn_c(const Params& p, int l, LAS unsigned char* lds) {
    int tid = threadIdx.x; OPAQUE(tid);
    const int lane_ = tid & 63, wid = tid >> 6, hsel = wid >> 2, rg = wid & 3;
    unsigned char* ws = p.ws;
    const bf16_t* QC = (const bf16_t*)(ws + WS_QC); const bf16_t* KC = (const bf16_t*)(ws + WS_KC); const bf16_t* VC = (const bf16_t*)(ws + WS_VC);
    bf16_t* OC = (bf16_t*)(ws + WS_OC);
    constexpr int NQB = SEQ / 128, NHP = HC / 2, NU_P = NB * NHP * NQB, NU = NU_P + DB * NHP;
    volatile LAS unsigned* flags = (volatile LAS unsigned*)(lds + AT_FLAG);
    for (int u = blockIdx.x; u < NU; u += gridDim.x) {
        int lane = lane_; OPAQUE(lane);
        const int r = lane & 31, hh = lane >> 5;
        const LaneOffs LO = make_lane_offs(lane);
        const bool sample = u >= NU_P;
        int b, hp, qb, jtop; size_t qrow0; int pos0;
        if (!sample) { qb = NQB - 1 - (u % NQB); const int bh = u / NQB; hp = bh % NHP; b = bh / NHP; jtop = 2 * qb + 1; qrow0 = (size_t)b * SEQ + qb * 128; pos0 = qb * 128; }
        else { const int s = u - NU_P; hp = s % NHP; b = s / NHP; qb = 0; jtop = PAST / 64; qrow0 = (size_t)MP + (size_t)b * DSEQ; pos0 = PAST; }
        const int h = 2 * hp + hsel;
        const int nq = sample ? 32 : 128;
        __syncthreads();
        stage_rows<false>(lds + AT_Q, QC + qrow0 * D + (2 * hp) * 128, D, nq, nq);
        stage_rows<false>(lds + AT_Q + 32768, QC + qrow0 * D + (2 * hp + 1) * 128, D, nq, nq);
        if (tid < 8) flags[tid] = 0u;
        f32x16 O[4];
#pragma unroll
        for (int i = 0; i < 4; ++i) O[i] = zero16();
        float run = 0.f;
        const bool wave_on = sample ? (rg == 0) : true;
        bool wdone = !wave_on;
        const int tq = pos0 + 32 * rg + r;
        for (int j = jtop; j >= 0; --j) {
            __syncthreads();
            { unsigned alld = 1u;
#pragma unroll
              for (int w = 0; w < 8; ++w) alld &= flags[w];
              if (alld) break; }
            int nvalid = 64; const int kpos0 = j * 64;
            if (!sample) { const size_t kr = (size_t)b * SEQ + (size_t)j * 64;
                stage_rows<false>(lds + AT_K, KC + kr * D + (2 * hp) * 128, D, 64, 64); stage_rows<false>(lds + AT_K + 16384, KC + kr * D + (2 * hp + 1) * 128, D, 64, 64);
                stage_rows<false>(lds + AT_V, VC + kr * D + (2 * hp) * 128, D, 64, 64); stage_rows<false>(lds + AT_V + 16384, VC + kr * D + (2 * hp + 1) * 128, D, 64, 64); }
            else if (j < PAST / 64) { const size_t kr = ((size_t)(l * DB + b) * PAST + (size_t)j * 64) * D;
                stage_rows<true>(lds + AT_K, p.in[I_CCK] + kr + (2 * hp) * 128, D, 64, 64); stage_rows<true>(lds + AT_K + 16384, p.in[I_CCK] + kr + (2 * hp + 1) * 128, D, 64, 64);
                stage_rows<true>(lds + AT_V, p.in[I_CCV] + kr + (2 * hp) * 128, D, 64, 64); stage_rows<true>(lds + AT_V + 16384, p.in[I_CCV] + kr + (2 * hp + 1) * 128, D, 64, 64); }
            else { nvalid = DSEQ; const size_t kr = (size_t)MP + (size_t)b * DSEQ;
                stage_rows<false>(lds + AT_K, KC + kr * D + (2 * hp) * 128, D, 64, DSEQ); stage_rows<false>(lds + AT_K + 16384, KC + kr * D + (2 * hp + 1) * 128, D, 64, DSEQ);
                stage_rows<false>(lds + AT_V, VC + kr * D + (2 * hp) * 128, D, 64, DSEQ); stage_rows<false>(lds + AT_V + 16384, VC + kr * D + (2 * hp + 1) * 128, D, 64, DSEQ); }
            __syncthreads();
            const bool need = kpos0 < pos0 + 32 * rg + 31;
            if (!wdone && need) {
                const LAS unsigned char* Ki = lds + AT_K + hsel * 16384; const LAS unsigned char* Qi = lds + AT_Q + hsel * 32768;
                f32x16 s[2]; s[0] = zero16(); s[1] = zero16();
#pragma unroll
                for (int ks = 0; ks < 8; ++ks) { const bf16x8 qf = lds_frag_row(Qi + rg * 8192, LO, ks);
                    s[0] = MFMA32(lds_frag_row(Ki, LO, ks), qf, s[0]); s[1] = MFMA32(lds_frag_row(Ki + 8192, LO, ks), qf, s[1]); if (ks & 1) __builtin_amdgcn_sched_barrier(0); }
                float gs[8];
#pragma unroll
                for (int kb = 0; kb < 2; ++kb)
#pragma unroll
                    for (int q2 = 0; q2 < 4; ++q2) { float lm[4], lb[4];
#pragma unroll
                        for (int e = 0; e < 4; ++e) { const int key = 32 * kb + 8 * q2 + 4 * hh + e; const float z = s[kb][4 * q2 + e] * 0.08838834764831845f;
                            const float sp = fmaxf(z, 0.f) + 0.69314718056f * __builtin_amdgcn_logf(1.0f + fast_exp(-fabsf(z)));
                            const bool ok = (kpos0 + key < tq) && (key < nvalid);
                            lm[e] = ok ? -sp : 0.f; lb[e] = ok ? z - sp : -1e30f; }
                        const float t3 = 0.f, t2 = lm[3], t1 = t2 + lm[2], t0 = t1 + lm[1];
                        gs[4 * kb + q2] = t0 + lm[0];
                        s[kb][4 * q2 + 0] = lb[0] + t0; s[kb][4 * q2 + 1] = lb[1] + t1; s[kb][4 * q2 + 2] = lb[2] + t2; s[kb][4 * q2 + 3] = lb[3] + t3; }
                float pg[8], T[8];
#pragma unroll
                for (int k = 0; k < 8; ++k) { pg[k] = __shfl_xor(gs[k], 32); T[k] = gs[k] + pg[k]; }
                float off[8]; float accp = run;
#pragma unroll
                for (int k = 7; k >= 0; --k) { off[k] = accp + (hh == 0 ? pg[k] : 0.f); accp += T[k]; }
                run = accp;
#pragma unroll
                for (int kb = 0; kb < 2; ++kb)
#pragma unroll
                    for (int i = 0; i < 16; ++i) s[kb][i] = fast_exp(s[kb][i] + off[4 * kb + (i >> 2)]);
#pragma unroll
                for (int s2 = 0; s2 < 4; ++s2) { const bf16x8 pb = pack8(s[s2 >> 1], s2 & 1);
#pragma unroll
                    for (int d = 0; d < 4; ++d) { O[d] = MFMA32(lds_frag_tr(lds + AT_V + hsel * 16384, LO, s2, d), pb, O[d]); if (d & 1) __builtin_amdgcn_sched_barrier(0); } }
                wdone = __all(run < -110.0f) != 0;
            }
            if (j == 0) wdone = true;
            if (lane == 0) flags[wid] = wdone ? 1u : 0u;
        }
        if (wave_on) { int qi = 32 * rg + r; OPAQUE(qi);
            if (!sample || qi < DSEQ) { bf16_t* dst = OC + (qrow0 + qi) * D + h * 128;
#pragma unroll
                for (int d = 0; d < 4; ++d)
#pragma unroll
                    for (int g4 = 0; g4 < 4; ++g4) { const int dv = 32 * d + 8 * g4 + 4 * hh;
                        u32x2 o; o.x = cvt_pk_bf16(O[d][4 * g4], O[d][4 * g4 + 1]); o.y = cvt_pk_bf16(O[d][4 * g4 + 2], O[d][4 * g4 + 3]); *(u32x2*)(dst + dv) = o; } } }
    }
}
DI void phase_merge(const Params& p, int l, LAS unsigned char* lds) {
    int tid = threadIdx.x; OPAQUE(tid);
    const int lane = tid & 63, wid = tid >> 6;
    unsigned char* ws = p.ws;
    const bf16_t* OA = (const bf16_t*)(ws + WS_OA); const bf16_t* OC = (const bf16_t*)(ws + WS_OC); const bf16_t* OBR = (const bf16_t*)(ws + WS_OBUF);
    const bf16_t* BZ = (const bf16_t*)(ws + WS_BZ); const bf16_t* GT = (const bf16_t*)(ws + WS_GATES); bf16_t* XB = (bf16_t*)(ws + WS_XB);
    const float* gw = p.in[I_GDNW] + l * 128;
    constexpr int NROW = MP + MS;
    for (int rr = blockIdx.x * 8 + wid; rr < NROW; rr += gridDim.x * 8) {
        const size_t row = rr;
        const size_t brow = rr < MP ? (size_t)rr : (size_t)MP + (size_t)((rr - MP) / DSEQ) * 64 + (rr - MP) % DSEQ;
        for (int c0 = 0; c0 < D; c0 += 512) {
            const int cu = c0 + lane * 8; const bool cok = cu < D; const int c = cok ? cu : 0;
            const u32x4 oa = *(const u32x4*)(OA + row * D + c), oc = *(const u32x4*)(OC + row * D + c), ob = *(const u32x4*)(OBR + brow * D + c), bz = *(const u32x4*)(BZ + row * D + c);
            const u32x4 g0 = *(const u32x4*)(GT + row * 3 * D + c), g1 = *(const u32x4*)(GT + row * 3 * D + D + c), g2 = *(const u32x4*)(GT + row * 3 * D + 2 * D + c);
            float o[8]; float ss = 0.f;
#pragma unroll
            for (int e = 0; e < 4; ++e) { o[2 * e] = bf_lo(ob[e]); o[2 * e + 1] = bf_hi(ob[e]); ss += o[2 * e] * o[2 * e] + o[2 * e + 1] * o[2 * e + 1]; }
            ss += __shfl_xor(ss, 1); ss += __shfl_xor(ss, 2); ss += __shfl_xor(ss, 4); ss += __shfl_xor(ss, 8);
            const float rstd = 1.0f / sqrtf(ss * (1.0f / 128.0f) + EPS);
            const f32x4 w0 = *(const f32x4*)(gw + (c & 127)), w1 = *(const f32x4*)(gw + (c & 127) + 4);
            float mg[8];
#pragma unroll
            for (int e = 0; e < 8; ++e) { const unsigned ua = oa[e >> 1], uc = oc[e >> 1], uz = bz[e >> 1], u0 = g0[e >> 1], u1 = g1[e >> 1], u2 = g2[e >> 1];
                const float a = (e & 1) ? bf_hi(ua) : bf_lo(ua), cc = (e & 1) ? bf_hi(uc) : bf_lo(uc), z = (e & 1) ? bf_hi(uz) : bf_lo(uz);
                const float ga = (e & 1) ? bf_hi(u0) : bf_lo(u0), gbv = (e & 1) ? bf_hi(u1) : bf_lo(u1), gc = (e & 1) ? bf_hi(u2) : bf_lo(u2);
                const float w = e < 4 ? w0[e] : w1[e - 4];
                const float obn = o[e] * rstd * w * (z * sigmoidf_(z));
                mg[e] = ga * a + gbv * obn + gc * cc; }
            u32x4 wv; wv.x = cvt_pk_bf16(mg[0], mg[1]); wv.y = cvt_pk_bf16(mg[2], mg[3]); wv.z = cvt_pk_bf16(mg[4], mg[5]); wv.w = cvt_pk_bf16(mg[6], mg[7]);
            if (cok) *(u32x4*)(XB + row * D + c) = wv;
        }
    }
}

struct EpiResid {
    static constexpr bool PERM = false;
    const float* xin_p; const float* xin_s; float* xout_p; float* xout_s; bf16_t* xb; float* ssp;
    DI void operator()(const f32x4 (&acc)[2][2][4][2], const pg8::Unit& u, int wr, int wc, int fr, int fq) const {
        const bool sample = u.pm >= MP / 256;
#pragma unroll
        for (int ai = 0; ai < 2; ++ai)
#pragma unroll
            for (int m = 0; m < 4; ++m) {
                const int row = u.pm * 256 + ai * 128 + wr * 64 + m * 16 + fr;
                const bool valid = !sample || (row - MP) < MS;
                const float* xi = sample ? xin_s + (size_t)(row - MP) * D : xin_p + (size_t)row * D;
                float* xo = sample ? xout_s + (size_t)(row - MP) * D : xout_p + (size_t)row * D;
                float ss = 0.f;
#pragma unroll
                for (int bj = 0; bj < 2; ++bj)
#pragma unroll
                    for (int n = 0; n < 2; ++n) { const int c = u.pn * 256 + bj * 128 + wc * 32 + n * 16 + fq * 4;
                        if (valid) { const f32x4 v = *(const f32x4*)(xi + c) + acc[ai][bj][m][n]; *(f32x4*)(xo + c) = v;
                            u32x2 w; w.x = cvt_pk_bf16(v[0], v[1]); w.y = cvt_pk_bf16(v[2], v[3]); *(u32x2*)(xb + (size_t)row * D + c) = w;
                            ss += (v[0] * v[0] + v[1] * v[1]) + (v[2] * v[2] + v[3] * v[3]); } }
                ss += __shfl_xor(ss, 16); ss += __shfl_xor(ss, 32);
                if (valid && fq == 0) ssp[(size_t)row * NPART + u.pn * 4 + wc] = ss;
                COMPILER_FENCE();
            }
    }
};
struct EpiUp {
    static constexpr bool PERM = true;
    const float* ssp; bf16_t* hid;
    DI void operator()(const f32x4 (&acc)[2][2][4][2], const pg8::Unit& u, int wr, int wc, int fr, int fq) const {
        const bool sample = u.pm >= MP / 256;
#pragma unroll
        for (int ai = 0; ai < 2; ++ai)
#pragma unroll
            for (int m = 0; m < 4; ++m) {
                const int row = u.pm * 256 + ai * 128 + wr * 64 + m * 16 + fr;
                if (sample && (row - MP) >= MS) continue;
                float ss = 0.f;
#pragma unroll
                for (int j = 0; j < NPART; j += 4) { const f32x4 q = *(const f32x4*)(ssp + (size_t)row * NPART + j); ss += (q[0] + q[1]) + (q[2] + q[3]); }
                const float rs = 1.0f / sqrtf(ss * (1.0f / D) + EPS);
#pragma unroll
                for (int bj = 0; bj < 2; ++bj) { f32x4 a = acc[ai][bj][m][0] * rs, b = acc[ai][bj][m][1] * rs;
#pragma unroll
                    for (int e = 0; e < 4; ++e) { const float x = fmaxf(a[e], 0.f), y = fmaxf(b[e], 0.f); a[e] = x * x; b[e] = y * y; }
                    u32x4 w; w.x = cvt_pk_bf16(a[0], a[1]); w.y = cvt_pk_bf16(a[2], a[3]); w.z = cvt_pk_bf16(b[0], b[1]); w.w = cvt_pk_bf16(b[2], b[3]);
                    *(u32x4*)(hid + (size_t)row * DFF + u.pn * 256 + bj * 128 + wc * 32 + fq * 8) = w; }
                COMPILER_FENCE();
            }
    }
};

DI void phase_final(const Params& p, LAS unsigned char* lds) {
    int tid = threadIdx.x; OPAQUE(tid);
    const int lane = tid & 63, wid = tid >> 6;
    const float* ssp = (const float*)(p.ws + WS_SSP); const float* fw = p.in[I_FNW];
    for (int rr = blockIdx.x * 8 + wid; rr < MP + MS; rr += gridDim.x * 8) {
        float* x = rr < MP ? p.out + O_YP + (size_t)rr * D : p.out + O_YS + (size_t)(rr - MP) * D;
        float ss = 0.f;
#pragma unroll
        for (int j = 0; j < NPART; ++j) ss += ssp[(size_t)rr * NPART + j];
        const float rs = 1.0f / sqrtf(ss * (1.0f / D) + EPS);
        for (int c = lane * 4; c < D; c += 256) { const f32x4 v = *(const f32x4*)(x + c), w = *(const f32x4*)(fw + c); *(f32x4*)(x + c) = v * rs * w; }
    }
}
constexpr int LDS_BYTES = 147456;
constexpr int LDS_MISC = 147456 - 256;
constexpr int PH_PER_LAYER = 10;
constexpr int N_PHASES = 1 + DEPTH * PH_PER_LAYER + 1;

__global__ void __launch_bounds__(512, 2) fwd_kernel(Params p) {
#ifdef EMU
    LAS unsigned char* lds = EMU_SMEM();
#else
    extern __shared__ __attribute__((aligned(16))) unsigned char lds_raw[];
    LAS unsigned char* lds = (LAS unsigned char*)lds_raw;
#endif
    volatile LAS unsigned* misc = (volatile LAS unsigned*)(lds + LDS_MISC);
    if (threadIdx.x < 16) misc[threadIdx.x] = 0u;
    __syncthreads();
    const int lo = p.ph_lo, hi = p.ph_hi;
    XcdBarrier bar; bar.bar = (unsigned*)(p.ws + WS_BAR); bar.x = 0; bar.st = misc;
    if (hi - lo > 1) bar = xcd_barrier_post((unsigned*)(p.ws + WS_BAR), misc);
#ifndef ONLY_KIND
#define ONLY_KIND -1
#endif
#define PHK(kind) (ONLY_KIND < 0 || ONLY_KIND == (kind))
#define IN(k) (lo <= (k) && (k) < hi)
#define SEAM(k) do { if (IN(k) && IN((k) + 1)) xcd_barrier(bar); } while (0)
    unsigned char* ws = p.ws;
    if (PHK(100) && IN(0)) { phase_prologue(p, lds); }
    SEAM(0);
    for (int l = 0; l < DEPTH; ++l) {
        const int pb = 1 + l * PH_PER_LAYER;
        int bid = blockIdx.x; OPAQUE_S(bid);
        if (PHK(0) && IN(pb + 0)) {
            pg8::Gemm g{(const bf16_t*)(ws + WS_XB), (const bf16_t*)(ws + WS_WIN) + (size_t)l * NP * D, MALL, NP, D};
            pg8::StaticOrder S; S.init(MALL, NP, gridDim.x, bid);
            EpiInProj E{l, ws, p.out};
            pg8::gemm_phase(lds, g, S, E);
        }
        SEAM(pb + 0);
        if (PHK(1) && IN(pb + 1)) phase_conv(p, l, lds);
        SEAM(pb + 1);
        if (PHK(2) && IN(pb + 2)) phase_gdn_pre(p, lds);
        SEAM(pb + 2);
        if (PHK(3) && IN(pb + 3)) phase_gdn_scan(p, l, lds);
        SEAM(pb + 3);
        if (PHK(4) && IN(pb + 4)) phase_attn_a(p, l, lds);
        SEAM(pb + 4);
        if (PHK(5) && IN(pb + 5)) phase_attn_c(p, l, lds);
        SEAM(pb + 5);
        if (PHK(6) && IN(pb + 6)) phase_merge(p, l, lds);
        SEAM(pb + 6);
        float* ssp_mid = (float*)(ws + WS_SSP) + (size_t)MALL * NPART;
        if (PHK(7) && IN(pb + 7)) {
            pg8::Gemm g{(const bf16_t*)(ws + WS_XB), (const bf16_t*)(ws + WS_WOUT) + (size_t)l * D * D, MALL, D, D};
            pg8::StaticOrder S; S.init(MALL, D, gridDim.x, bid);
            EpiResid E{l == 0 ? p.in[I_XP] : p.out + O_YP, l == 0 ? p.in[I_XS] : p.out + O_YS, p.out + O_YP, p.out + O_YS, (bf16_t*)(ws + WS_XB2), ssp_mid};
            pg8::gemm_phase(lds, g, S, E);
        }
        SEAM(pb + 7);
        if (PHK(8) && IN(pb + 8)) {
            pg8::Gemm g{(const bf16_t*)(ws + WS_XB2), (const bf16_t*)(ws + WS_WUP) + (size_t)l * DFF * D, MALL, DFF, D};
            pg8::StaticOrder S; S.init(MALL, DFF, gridDim.x, bid);
            EpiUp E{ssp_mid, (bf16_t*)(ws + WS_HID)};
            pg8::gemm_phase(lds, g, S, E);
        }
        SEAM(pb + 8);
        if (PHK(9) && IN(pb + 9)) {
            pg8::Gemm g{(const bf16_t*)(ws + WS_HID), (const bf16_t*)(ws + WS_WDN) + (size_t)l * D * DFF, MALL, D, DFF};
            pg8::StaticOrder S; S.init(MALL, D, gridDim.x, bid);
            EpiResid E{p.out + O_YP, p.out + O_YS, p.out + O_YP, p.out + O_YS, (bf16_t*)(ws + WS_XB), (float*)(ws + WS_SSP)};
            pg8::gemm_phase(lds, g, S, E);
        }
        SEAM(pb + 9);
    }
    if (PHK(101) && IN(1 + DEPTH * PH_PER_LAYER)) phase_final(p, lds);
#undef IN
#undef SEAM
}

extern "C" void kernel_launch(void* const* d_in, const int* in_sizes, int n_in, void* d_out, int out_size, void* d_ws, size_t ws_size, hipStream_t stream) {
    if (n_in != 24 || (size_t)out_size != O_END || ws_size < WS_END) { fprintf(stderr, "kernel_launch: unexpected shapes (n_in %d out %d ws %zu need %zu)\n", n_in, out_size, ws_size, (size_t)WS_END); return; }
    Params p{};
    for (int i = 0; i < 24; ++i) p.in[i] = (const float*)d_in[i];
    p.out = (float*)d_out; p.ws = (unsigned char*)d_ws;
    (void)hipMemsetAsync((char*)d_ws + WS_BAR, 0, XCD_BAR_WORDS * sizeof(unsigned), stream);
#ifdef EMU
    const int grid = EMU_GRID;
    const char* e = getenv("EMU_PHASES"); const int nph = e ? atoi(e) : N_PHASES;
    if (getenv("EMU_ONE")) { p.ph_lo = 0; p.ph_hi = nph; EMU_LAUNCH(fwd_kernel, grid, 512, LDS_BYTES, p); }
    else for (int k = 0; k < nph; ++k) { p.ph_lo = k; p.ph_hi = k + 1; EMU_LAUNCH(fwd_kernel, grid, 512, LDS_BYTES, p); }
#else
    static int grid = 0;
    if (grid == 0) {
        int dev = 0, cus = 0;
        if (hipGetDevice(&dev) != hipSuccess || hipDeviceGetAttribute(&cus, hipDeviceAttributeMultiprocessorCount, dev) != hipSuccess) { grid = -1; return; }
        if (hipFuncSetAttribute((const void*)fwd_kernel, hipFuncAttributeMaxDynamicSharedMemorySize, LDS_BYTES) != hipSuccess) { grid = -1; return; }
        grid = cus;
    }
    if (grid < 0) return;
#ifndef ONE_LAUNCH
#define ONE_LAUNCH 1
#endif
#if ONE_LAUNCH
    p.ph_lo = 0; p.ph_hi = N_PHASES;
    hipLaunchKernelGGL(fwd_kernel, dim3(grid), dim3(512), LDS_BYTES, stream, p);
#else
    for (int k = 0; k < N_PHASES; ++k) { p.ph_lo = k; p.ph_hi = k + 1; hipLaunchKernelGGL(fwd_kernel, dim3(grid), dim3(512), LDS_BYTES, stream, p); }
#endif
#endif
}

#ifdef EMU
void emu_compare(const char* name, const float* got, const float* ref, size_t n);
std::vector<float> emu_load_dbg(const char* name, size_t n);
static void dbg_bf16(const char* tag, const unsigned char* ws, size_t off, size_t row0, size_t nrows, const char* file) {
    std::vector<float> got(nrows * D); const bf16_t* b = (const bf16_t*)(ws + off) + row0 * D;
    for (size_t i = 0; i < nrows * D; ++i) got[i] = bf2f(b[i]);
    std::vector<float> ref = emu_load_dbg(file, nrows * D); emu_compare(tag, got.data(), ref.data(), nrows * D);
}
void emu_debug(unsigned char* ws, float* out) {
    printf("barrier timeout word = %u\n", ((unsigned*)(ws + WS_BAR))[XB_TMO]);
    if (const char* x = getenv("EMU_DBG_X")) { std::vector<float> ref = emu_load_dbg(x, (size_t)MP * D); emu_compare(x, out + O_YP, ref.data(), (size_t)MP * D); }
    if (getenv("EMU_DBG_M")) { dbg_bf16("merged(p)", ws, WS_XB, 0, MP, "p0_merged");
        std::vector<float> ref = emu_load_dbg("p0_merged", (size_t)MP * D); const bf16_t* b = (const bf16_t*)(ws + WS_XB); int shown = 0;
        for (int r = 0; r < MP && shown < 60; ++r) { int bad = 0, c0 = -1, c1 = -1; for (int c = 0; c < D; ++c) if (fabsf(bf2f(b[(size_t)r * D + c]) - ref[(size_t)r * D + c]) > 0.08f) { ++bad; if (c0 < 0) c0 = c; c1 = c; }
            if (bad) { printf("   row %d: %d bad cols [%d..%d]\n", r, bad, c0, c1); ++shown; } } }
    const char* e = getenv("EMU_DBG"); if (!e) return;
    const int l = atoi(e); char f[64];
    snprintf(f, 64, "p%d_obraw", l); dbg_bf16("obraw(p)", ws, WS_OBUF, 0, MP, f);
    snprintf(f, 64, "p%d_oa", l); dbg_bf16("oa(p)", ws, WS_OA, 0, MP, f);
    snprintf(f, 64, "s%d_oa", l); dbg_bf16("oa(s)", ws, WS_OA, MP, MS, f);
    snprintf(f, 64, "p%d_oc", l); dbg_bf16("oc(p)", ws, WS_OC, 0, MP, f);
    snprintf(f, 64, "s%d_oc", l); dbg_bf16("oc(s)", ws, WS_OC, MP, MS, f);
    for (int b = 0; b < DB; ++b) { snprintf(f, 64, "s%d_obraw", l); std::vector<float> ref = emu_load_dbg(f, (size_t)DB * DSEQ * D); std::vector<float> got(DSEQ * D);
        const bf16_t* bb = (const bf16_t*)(ws + WS_OBUF) + (size_t)(MP + b * 64) * D; for (int i = 0; i < DSEQ * D; ++i) got[i] = bf2f(bb[i]);
        emu_compare("obraw(s)", got.data(), ref.data() + (size_t)b * DSEQ * D, DSEQ * D); }
}
#endif
```

```cpp
#ifdef EMU
#include "emu.h"
#define LAS
#define ASM_WAIT_VM0() ((void)0)
#define ASM_WAIT_VM(n) ((void)0)
#define ASM_WAIT_LGKM(n) ((void)0)
#define ASM_WAIT_ALL0() ((void)0)
#define COMPILER_FENCE() ((void)0)
#define GLDS16(gptr, ldsptr) emu_global_load_lds16((gptr), (ldsptr))
#define MY_XCC_ID() (blockIdx.x & 7u)
#define WAVE_LDS_FENCE() ((void)__all(1))
#define OPAQUE(x) ((void)0)
#define OPAQUE_S(x) ((void)0)
#else
#include <hip/hip_runtime.h>
#include <cstdio>
#include <cstring>
#define LAS __attribute__((address_space(3)))
#define ASM_WAIT_VM0() asm volatile("s_waitcnt vmcnt(0)" ::: "memory")
#define ASM_WAIT_VM(n) asm volatile("s_waitcnt vmcnt(" #n ")" ::: "memory")
#define ASM_WAIT_LGKM(n) asm volatile("s_waitcnt lgkmcnt(" #n ")" ::: "memory")
#define ASM_WAIT_ALL0() asm volatile("s_waitcnt vmcnt(0) lgkmcnt(0)" ::: "memory")
#define COMPILER_FENCE() asm volatile("" ::: "memory")
#define GLDS16(gptr, ldsptr) __builtin_amdgcn_global_load_lds((const unsigned*)(gptr), (LAS unsigned*)(ldsptr), 16, 0, 0)
#define MY_XCC_ID() ((unsigned)__builtin_amdgcn_s_getreg((3 << 11) | 20) & 0xFu)
#define WAVE_LDS_FENCE() asm volatile("s_waitcnt lgkmcnt(0)" ::: "memory")
#define OPAQUE(x) asm volatile("" : "+v"(x))
#define OPAQUE_S(x) asm volatile("" : "+s"(x))
#endif
#define DI __device__ __forceinline__

#ifndef CFG_D
#define CFG_D 1024
#define CFG_BATCH 4
#define CFG_SEQ 8192
#define CFG_DB 8
#define CFG_PAST 1024
#endif
constexpr int D = CFG_D, NB = CFG_BATCH, SEQ = CFG_SEQ, DEPTH = 2, DB = CFG_DB, DSEQ = 16, PAST = CFG_PAST;
constexpr int HA = D / 256, HB = D / 128, HC = D / 128, DFF = 4 * D, CHUNK = 64, CONVW = 4;
constexpr int MP = NB * SEQ;
constexpr int MS = DB * DSEQ;
constexpr int MSP = (MS + 255) / 256 * 256;
constexpr int MALL = MP + MSP;
constexpr int NIN_ORIG = 13 * D + 2 * HB;
constexpr int NP = 13 * D + 256;
constexpr int TD = D / 256;
constexpr int NPART = 4 * TD;
constexpr int ROPE_N = (SEQ > PAST + DSEQ) ? SEQ : (PAST + DSEQ);
constexpr int NCH = SEQ / CHUNK;
constexpr int NUNIT_B = NB * NCH * HB + DB * HB;
constexpr int MB = MP + DB * 64;
constexpr float EPS = 1e-6f;
static_assert(MP % 256 == 0 && D % 256 == 0 && SEQ % 128 == 0 && PAST % 64 == 0 && 2 * HB <= 16, "shape assumptions");

typedef unsigned short bf16_t;
typedef short bf16x8 __attribute__((ext_vector_type(8)));
typedef short s16x4 __attribute__((ext_vector_type(4)));
typedef float f32x4 __attribute__((ext_vector_type(4)));
typedef float f32x2 __attribute__((ext_vector_type(2)));
typedef float f32x16 __attribute__((ext_vector_type(16)));
typedef unsigned u32x4 __attribute__((ext_vector_type(4)));
typedef unsigned u32x2 __attribute__((ext_vector_type(2)));

DI unsigned cvt_pk_bf16(float lo, float hi) {
#ifdef EMU
    unsigned a = __float_as_uint(lo), b = __float_as_uint(hi);
    a += 0x7fffu + ((a >> 16) & 1u); b += 0x7fffu + ((b >> 16) & 1u);
    return (a >> 16) | (b & 0xffff0000u);
#else
    typedef __bf16 bf16x2_t __attribute__((ext_vector_type(2)));
    const f32x2 v = {lo, hi}; return __builtin_bit_cast(unsigned, __builtin_convertvector(v, bf16x2_t));
#endif
}
DI float bf_lo(unsigned u) { return __uint_as_float(u << 16); }
DI float bf_hi(unsigned u) { return __uint_as_float(u & 0xffff0000u); }
DI float bf2f(bf16_t b) { return __uint_as_float(((unsigned)b) << 16); }
DI bf16_t f2bf(float f) { return (bf16_t)(cvt_pk_bf16(f, 0.f) & 0xffffu); }
DI float fast_exp2(float x) { return __builtin_amdgcn_exp2f(x); }
DI float fast_exp(float x) { return __builtin_amdgcn_exp2f(x * 1.44269504089f); }
DI float fast_rcp(float x) { return __builtin_amdgcn_rcpf(x); }
DI float sigmoidf_(float x) { return fast_rcp(1.0f + fast_exp(-x)); }
#ifdef EMU
#define TR_ISSUE(dst, base, addr, off) dst = emu_ds_read_b64_tr_b16((const unsigned char*)(base) + (addr) + (off))
#define TR_ISSUE_X32(dst, base, addr, off) dst = emu_ds_read_b64_tr_b16((const unsigned char*)(base) + ((addr) ^ 32u) + (off))
#define TR_WAIT2(n, a, b) ((void)0)
#define TR_WAIT1(n, a) ((void)0)
#else
#define TR_ISSUE(dst, base, addr, off) asm volatile("ds_read_b64_tr_b16 %0, %1 offset:%2" : "=v"(dst) : "v"((unsigned)(size_t)(base) + (addr)), "i"(off))
#define TR_ISSUE_X32(dst, base, addr, off) do { unsigned t_; asm volatile("v_xor_b32 %1, 32, %2\n\tds_read_b64_tr_b16 %0, %1 offset:%3" : "=&v"(dst), "=&v"(t_) : "v"((unsigned)(size_t)(base) + (addr)), "i"(off)); } while (0)
#define TR_WAIT2(n, a, b) asm volatile("s_waitcnt lgkmcnt(" #n ")" : "+v"(a), "+v"(b))
#define TR_WAIT1(n, a) asm volatile("s_waitcnt lgkmcnt(" #n ")" : "+v"(a))
#endif
DI s16x4 ds_read_tr16(const LAS unsigned char* p) {
#ifdef EMU
    return emu_ds_read_b64_tr_b16(p);
#else
    return __builtin_amdgcn_ds_read_tr16_b64_v4i16((LAS s16x4*)p);
#endif
}

constexpr size_t al256(size_t x) { return (x + 255) & ~(size_t)255; }
constexpr size_t WS_BAR = 0;
constexpr size_t WS_STAMP = 32768;
constexpr size_t WS_WIN = 65536;
constexpr size_t WS_WOUT = WS_WIN + al256((size_t)DEPTH * NP * D * 2);
constexpr size_t WS_WUP = WS_WOUT + al256((size_t)DEPTH * D * D * 2);
constexpr size_t WS_WDN = WS_WUP + al256((size_t)DEPTH * DFF * D * 2);
constexpr size_t WS_ROPE = WS_WDN + al256((size_t)DEPTH * D * DFF * 2);
constexpr size_t WS_XB = WS_ROPE + al256((size_t)ROPE_N * 64 * 4 * 2);
constexpr size_t WS_SSP = WS_XB + al256((size_t)MALL * D * 2);
constexpr size_t WS_QA = WS_SSP + al256((size_t)2 * MALL * NPART * 4);
constexpr size_t WS_KA = WS_QA + al256((size_t)MALL * D * 2);
constexpr size_t WS_VA = WS_KA + al256((size_t)MALL * D * 2);
constexpr size_t WS_BRAW = WS_VA + al256((size_t)MALL * D * 2);
constexpr size_t WS_BZ = WS_BRAW + al256((size_t)MALL * 3 * D * 2);
constexpr size_t WS_QC = WS_BZ + al256((size_t)MALL * D * 2);
constexpr size_t WS_KC = WS_QC + al256((size_t)MALL * D * 2);
constexpr size_t WS_VC = WS_KC + al256((size_t)MALL * D * 2);
constexpr size_t WS_GATES = WS_VC + al256((size_t)MALL * D * 2);
constexpr size_t WS_BAB = WS_GATES + al256((size_t)MALL * 3 * D * 2);
constexpr size_t WS_BQ = WS_BAB + al256((size_t)MALL * 16 * 4);
constexpr size_t WS_BK = WS_BQ + al256((size_t)MB * D * 2);
constexpr size_t WS_BV = WS_BK + al256((size_t)MB * D * 2);
constexpr size_t WS_GB = WS_BV + al256((size_t)MB * D * 2);
constexpr size_t WS_TT = WS_GB + al256((size_t)MB * 16 * 4);
constexpr size_t WS_AQK = WS_TT + al256((size_t)NUNIT_B * 4096 * 2);
constexpr size_t WS_CV = WS_AQK + al256((size_t)NUNIT_B * 4096 * 2);
constexpr size_t WS_OBUF = WS_CV + al256((size_t)NUNIT_B * 256 * 4);
constexpr size_t WS_OA = WS_OBUF + al256((size_t)MB * D * 2);
constexpr size_t WS_OC = WS_OA + al256((size_t)MALL * D * 2);
constexpr size_t WS_HID = WS_OC + al256((size_t)MALL * D * 2);
constexpr size_t WS_XB2 = WS_HID + al256((size_t)MALL * DFF * 2);
constexpr size_t WS_RSTD = WS_XB2 + al256((size_t)MALL * D * 2);
constexpr size_t WS_END = WS_RSTD + al256((size_t)2 * MALL * 4);
constexpr size_t WS_PART = WS_END;
constexpr size_t WS_TOTAL = WS_PART + (size_t)16 * 256 * D * 4;
constexpr size_t WS_DUMMY = WS_TOTAL;

struct Params {
    const float* in[24];
    float* out; unsigned char* ws;
    int ph_lo, ph_hi;
};
enum { I_XP = 0, I_XS, I_CAK, I_CAV, I_CCK, I_CCV, I_SCONV, I_SSSM, I_N1W, I_WIN, I_LQ1, I_LK1, I_LQ2, I_LK2, I_SUBLN, I_CONVW, I_ALOG, I_DTB, I_GDNW, I_WOUT, I_N2W, I_WUP, I_WDN, I_FNW };
constexpr size_t O_YP = 0;
constexpr size_t O_YS = O_YP + (size_t)NB * SEQ * D;
constexpr size_t O_PAK = O_YS + (size_t)DB * DSEQ * D;
constexpr size_t O_PAV = O_PAK + (size_t)DEPTH * NB * SEQ * D;
constexpr size_t O_PCK = O_PAV + (size_t)DEPTH * NB * SEQ * D;
constexpr size_t O_PCV = O_PCK + (size_t)DEPTH * NB * SEQ * D;
constexpr size_t O_PBC = O_PCV + (size_t)DEPTH * NB * SEQ * D;
constexpr size_t O_PBS = O_PBC + (size_t)DEPTH * NB * 3 * 3 * D;
constexpr size_t O_SAK = O_PBS + (size_t)DEPTH * NB * HB * 128 * 128;
constexpr size_t O_SAV = O_SAK + (size_t)DEPTH * DB * DSEQ * D;
constexpr size_t O_SCK = O_SAV + (size_t)DEPTH * DB * DSEQ * D;
constexpr size_t O_SCV = O_SCK + (size_t)DEPTH * DB * DSEQ * D;
constexpr size_t O_SBC = O_SCV + (size_t)DEPTH * DB * DSEQ * D;
constexpr size_t O_SBS = O_SBC + (size_t)DEPTH * DB * 3 * 3 * D;
constexpr size_t O_END = O_SBS + (size_t)DEPTH * DB * HB * 128 * 128;

DI int sigma256(int g) { return 64 * ((g >> 5) & 3) + 32 * (g >> 7) + (g & 31); }
DI int win_orig_col(int n) {
    if (n < 2 * D) { const int base = (n / D) * D, w = n % D, head = w >> 7, g = w & 127, G = g >> 3, j = g & 7;
        const int d = (j < 4) ? 4 * G + j : 64 + 4 * G + (j - 4); return base + head * 128 + d; }
    const int m = (n & ~255) + sigma256(n & 255);
    if (m < 6 * D) return m;
    if (m < 13 * D) return m + 2 * HB;
    const int c = m - 13 * D; return c < 2 * HB ? 6 * D + c : -1;
}
DI int sigma_col(int n) { return (n & ~255) + sigma256(n & 255); }
#define XB_TMO      128
#define XB_XCNT(j)  (256  + 64 * (j))
#define XB_XSUB(j)  (1280 + 64 * (j))
#define XB_XGEN(j)  (2304 + 64 * (j))
#define XB_TOP      3328
#define XB_TOPGEN   3392
#define XCD_BAR_WORDS 3456
#define XB_SPIN_CAP (1u << 22)
DI unsigned xb_ld(unsigned* p)              { return __hip_atomic_load(p, __ATOMIC_RELAXED, __HIP_MEMORY_SCOPE_AGENT); }
DI unsigned xb_add(unsigned* p, unsigned v) { return __hip_atomic_fetch_add(p, v, __ATOMIC_RELAXED, __HIP_MEMORY_SCOPE_AGENT); }
#define XB_SPIN(cond, bar) do { unsigned _sp = 0; while (cond) { __builtin_amdgcn_s_sleep(1); \
    if ((++_sp & 255u) == 0u) { if (xb_ld(&(bar)[XB_TMO])) break; if (_sp > XB_SPIN_CAP) { atomicAdd(&(bar)[XB_TMO], 1u); break; } } } } while (0)
struct XcdBarrier { unsigned* bar; unsigned x; volatile LAS unsigned* st; };
DI XcdBarrier xcd_barrier_post(unsigned* bar, volatile LAS unsigned* st) {
    XcdBarrier b; b.bar = bar; b.x = MY_XCC_ID(); b.st = st;
    if (threadIdx.x == 0) (void)xb_add(&bar[XB_XCNT(b.x)], 1u);
    return b;
}
DI void xcd_barrier_complete(unsigned* bar, unsigned x, unsigned& nloc, unsigned& nx) {
    const unsigned G = gridDim.x;
    unsigned sum, cnt, mine, sp = 0u;
    for (;;) {
        sum = 0u; cnt = 0u; mine = 0u;
#pragma unroll
        for (unsigned j = 0; j < 16; ++j) { const unsigned c = xb_ld(&bar[XB_XCNT(j)]); sum += c; cnt += (c > 0u) ? 1u : 0u; mine = (j == x) ? c : mine; }
        if (sum == G) break;
        __builtin_amdgcn_s_sleep(1);
        if ((++sp & 255u) == 0u) { if (xb_ld(&bar[XB_TMO])) break; if (sp > XB_SPIN_CAP) { atomicAdd(&bar[XB_TMO], 1u); break; } }
    }
    nloc = mine > 0u ? mine : 1u; nx = cnt > 0u ? cnt : 1u;
}
DI void xcd_barrier(const XcdBarrier& b) {
    ASM_WAIT_VM0();
    __syncthreads();
    if (threadIdx.x == 0) {
        unsigned* bar = b.bar;
        __builtin_amdgcn_s_waitcnt(0);
        unsigned nloc = b.st[0], nx = b.st[1];
        if (nloc == 0u) { xcd_barrier_complete(bar, b.x, nloc, nx); b.st[0] = nloc; b.st[1] = nx; }
        const unsigned old = xb_add(&bar[XB_XSUB(b.x)], 1u);
        const unsigned gen = old / nloc;
        if (old + 1u == (gen + 1u) * nloc) {
            __builtin_amdgcn_fence(__ATOMIC_RELEASE, "agent");
            ASM_WAIT_VM0();
            const unsigned og = xb_add(&bar[XB_TOP], 1u);
            const unsigned tg = og / nx;
            if (og + 1u == (tg + 1u) * nx) xb_add(&bar[XB_TOPGEN], 1u);
            else XB_SPIN(xb_ld(&bar[XB_TOPGEN]) == tg, bar);
            __builtin_amdgcn_fence(__ATOMIC_ACQUIRE, "agent");
            xb_add(&bar[XB_XGEN(b.x)], 1u);
            ASM_WAIT_VM0();
        } else {
            XB_SPIN(xb_ld(&bar[XB_XGEN(b.x)]) == gen, bar);
            __builtin_amdgcn_fence(__ATOMIC_ACQUIRE, "agent");
            ASM_WAIT_VM0();
        }
    }
    __syncthreads();
}

namespace pg8 {
constexpr int BM = 256, BK = 64, HALF = 128, HTB = HALF * BK * 2, STAGE_BYTES = 8 * HTB, NXCD = 8, WGM = 4;
DI int lds_byte(int r, int c) { const int st = (r >> 4) * 2 + (c >> 5), rr = r & 15, cc = c & 31, ob = rr * 64 + cc * 2; return st * 1024 + (ob ^ (((ob >> 9) & 1) << 5)); }
DI void stage_rc(int b, int& R, int& C) { const int st = b / 1024, sb = b % 1024, swz = sb ^ (((sb >> 9) & 1) << 5); R = (st >> 1) * 16 + swz / 64; C = (st & 1) * 32 + (swz % 64) / 2; }
DI int perm32(int rho) { const int n = rho >> 4, i = rho & 15; return 8 * (i >> 2) + 4 * n + (i & 3); }
struct Unit { int pm, pn; int koff, nt, slice; };
struct Gemm { const bf16_t* A; const bf16_t* Bt; int M, N, K, ld; };
struct StaticOrder {
    int nM, nN, nwg, G, c, ntk;
    DI void init(int M, int N, int G_, int c_, int K_) { nM = M / BM; nN = N / BM; nwg = nM * nN; G = G_; c = c_; ntk = K_ / BK; }
    DI bool next(int i, Unit& u) const {
        const long L = (long)i * G + c; if (L >= nwg) return false;
        int wgid = (int)L; { const int q = nwg / NXCD, r = nwg % NXCD, xcd = wgid % NXCD, off = wgid / NXCD; wgid = (xcd < r ? xcd * (q + 1) : r * (q + 1) + (xcd - r) * q) + off; }
        const int nig = WGM * nN, gid = wgid / nig, fm = gid * WGM, gsz = (nM - fm) < WGM ? (nM - fm) : WGM;
        u.pm = fm + ((wgid % nig) % gsz); u.pn = (wgid % nig) / gsz; u.koff = 0; u.nt = ntk; u.slice = -1; return true;
    }
    DI void a_ready(const Unit&) const {}
    DI void done(const Unit&) const {}
};
struct ComboOrder {
    StaticOrder so; int nS, kslice;
    DI void init(int Mmain, int N, int G_, int c_, int K_, int nS_, int kslice_) { so.init(Mmain, N, G_, c_, K_); nS = nS_; kslice = kslice_; }
    DI bool next(int i, Unit& u) const {
        const long L = (long)i * so.G + so.c;
        Unit a; a.pm = 0; a.pn = 0; a.koff = 0; a.nt = so.ntk; a.slice = -1;
        const bool is_main = so.next(i, a);
        const long j = L - so.nwg; const int sl = (int)(j / so.nN);
        const bool is_split = !is_main && j >= 0 && j < (long)so.nN * nS;
        u.pm = is_main ? a.pm : so.nM; u.pn = is_main ? a.pn : (int)(j % so.nN); u.koff = is_main ? 0 : sl * kslice * 2; u.nt = is_main ? so.ntk : kslice / BK; u.slice = is_main ? -1 : sl;
        return is_main || is_split;
    }
    DI void a_ready(const Unit&) const {}
    DI void done(const Unit&) const {}
};
template <class Epi, class Sched>
DI void gemm_phase(LAS unsigned char* lds, const Gemm g, const Sched& S, const Epi& E, const float* rowvec = nullptr, unsigned stagger_ticks = 0) {
    constexpr int RV_OFF = STAGE_BYTES;
    int tid = threadIdx.x; OPAQUE(tid);
    if (stagger_ticks) { const unsigned long long t0 = __builtin_amdgcn_s_memrealtime(); const unsigned long long d = (unsigned long long)((((unsigned)blockIdx.x >> 3) * 5u) & 7u) * stagger_ticks;
        while (__builtin_amdgcn_s_memrealtime() - t0 < d) __builtin_amdgcn_s_sleep(16); }
    const int wid = __builtin_amdgcn_readfirstlane(tid >> 6), lane = tid & 63, wr = wid >> 2, wc = wid & 3, fr = lane & 15, fq = lane >> 4;
    unsigned voffA[2], voffB[2];
#pragma unroll
    for (int i = 0; i < 2; ++i) { int R, C; stage_rc(tid * 16 + i * 8192, R, C); const int Rb = Epi::PERM ? ((R & ~31) + perm32(R & 31)) : R;
        voffA[i] = (unsigned)(R * g.ld + C) * 2u; voffB[i] = (unsigned)(Rb * g.ld + C) * 2u; }
    const size_t kstep = (size_t)(BK * 2);
    const size_t hstep = (size_t)HALF * g.ld * 2;
    const size_t tstep = 2 * hstep;
    const unsigned ldsw = (unsigned)wid * 1024u;
    const int aoff = lds_byte(wr * 64 + fr, fq * 8), boff = lds_byte(wc * 32 + fr, fq * 8);
#define PG8_SA(b, h) (((b) * 2 + (h)) * HTB)
#define PG8_SB(b, h) ((4 + (b) * 2 + (h)) * HTB)
#define PG8_STAGE(bufoff, gbase, voff) do { _Pragma("unroll") for (int _i = 0; _i < 2; ++_i) \
        GLDS16((const char*)(gbase) + (voff)[_i], lds + (bufoff) + ldsw + _i * 8192); } while (0)
#define PG8_LDA(dst, b, h) do { _Pragma("unroll") for (int m = 0; m < 4; ++m) _Pragma("unroll") for (int k = 0; k < 2; ++k) dst[m][k] = *(const LAS bf16x8*)(lds + PG8_SA(b, h) + aoff + m * 2048 + k * 1024); } while (0)
#define PG8_LDB(dst, b, h) do { _Pragma("unroll") for (int n = 0; n < 2; ++n) _Pragma("unroll") for (int k = 0; k < 2; ++k) dst[n][k] = *(const LAS bf16x8*)(lds + PG8_SB(b, h) + boff + n * 2048 + k * 1024); } while (0)
#define PG8_MMA(ai, bj, At, Bt) do { __builtin_amdgcn_s_setprio(1); _Pragma("unroll") for (int m = 0; m < 4; ++m) _Pragma("unroll") for (int n = 0; n < 2; ++n) _Pragma("unroll") for (int k = 0; k < 2; ++k) \
        acc[ai][bj][m][n] = __builtin_amdgcn_mfma_f32_16x16x32_bf16(Bt[n][k], At[m][k], acc[ai][bj][m][n], 0, 0, 0); __builtin_amdgcn_s_setprio(0); } while (0)
#define PG8_WAIT_V(n) ASM_WAIT_VM(n)
#define PG8_WAIT_L(n) ASM_WAIT_LGKM(n)
#define PG8_BAR __builtin_amdgcn_s_barrier()
#define PG8_SCHED __builtin_amdgcn_sched_barrier(0)
    Unit cur, nxt; int ui = 0;
    if (!S.next(0, cur)) return;
    f32x4 acc[2][2][4][2];
#pragma unroll
    for (int a = 0; a < 2; ++a)
#pragma unroll
        for (int b = 0; b < 2; ++b)
#pragma unroll
            for (int m = 0; m < 4; ++m)
#pragma unroll
                for (int n = 0; n < 2; ++n) acc[a][b][m][n] = (f32x4){0.f, 0.f, 0.f, 0.f};
    bf16x8 At[4][2], B0[2][2], B1[2][2];
    const char* cA = (const char*)g.A + (size_t)cur.pm * tstep + cur.koff; const char* cB = (const char*)g.Bt + (size_t)cur.pn * tstep + cur.koff;
    S.a_ready(cur);
    if (rowvec && wid == 0) GLDS16((const char*)(rowvec + (size_t)cur.pm * BM) + lane * 16, lds + RV_OFF);
    PG8_STAGE(PG8_SB(0, 0), cB, voffB); PG8_STAGE(PG8_SA(0, 0), cA, voffA); PG8_STAGE(PG8_SB(0, 1), cB + hstep, voffB); PG8_STAGE(PG8_SA(0, 1), cA + hstep, voffA);
    if (wr == 1) PG8_BAR;
    PG8_WAIT_V(4); PG8_BAR;
    PG8_STAGE(PG8_SB(1, 0), cB + kstep, voffB); PG8_STAGE(PG8_SA(1, 0), cA + kstep, voffA); PG8_STAGE(PG8_SB(1, 1), cB + hstep + kstep, voffB);
    PG8_WAIT_V(6); PG8_BAR;
    for (;;) {
        const bool has_next = S.next(ui + 1, nxt);
        const char* nA = has_next ? (const char*)g.A + (size_t)nxt.pm * tstep + nxt.koff : cA; const char* nB = has_next ? (const char*)g.Bt + (size_t)nxt.pn * tstep + nxt.koff : cB;
        const int nt = cur.nt;
        for (int t = 0; t < nt; t += 2) {
            const bool last = (t == nt - 2);
            const char* a1 = cA + (size_t)(t + 1) * kstep;
            const char* a2 = last ? nA : cA + (size_t)(t + 2) * kstep; const char* b2 = last ? nB : cB + (size_t)(t + 2) * kstep;
            const char* a3 = a2 + kstep; const char* b3 = b2 + kstep;
            if (last && has_next) { S.a_ready(nxt); if (rowvec && wid == 0) GLDS16((const char*)(rowvec + (size_t)nxt.pm * BM) + lane * 16, lds + RV_OFF + ((ui + 1) & 1) * 1024); }
            PG8_LDB(B0, 0, 0); PG8_SCHED; PG8_LDA(At, 0, 0); PG8_STAGE(PG8_SA(1, 1), a1 + hstep, voffA);
            PG8_WAIT_L(8); PG8_BAR; PG8_WAIT_L(0); PG8_MMA(0, 0, At, B0); PG8_BAR; PG8_SCHED;
            PG8_LDB(B1, 0, 1); PG8_STAGE(PG8_SB(0, 0), b2, voffB);
            PG8_BAR; PG8_WAIT_L(0); PG8_MMA(0, 1, At, B1); PG8_BAR;
            PG8_LDA(At, 0, 1); PG8_STAGE(PG8_SA(0, 0), a2, voffA);
            PG8_BAR; PG8_WAIT_L(0); PG8_MMA(1, 0, At, B0); PG8_BAR; PG8_SCHED;
            PG8_STAGE(PG8_SB(0, 1), b2 + hstep, voffB);
            PG8_WAIT_V(6); PG8_BAR; PG8_MMA(1, 1, At, B1); PG8_BAR;
            PG8_LDB(B0, 1, 0); PG8_SCHED; PG8_LDA(At, 1, 0); PG8_STAGE(PG8_SA(0, 1), a2 + hstep, voffA);
            PG8_WAIT_L(8); PG8_BAR; PG8_WAIT_L(0); PG8_MMA(0, 0, At, B0); PG8_BAR; PG8_SCHED;
            PG8_LDB(B1, 1, 1); PG8_STAGE(PG8_SB(1, 0), b3, voffB);
            PG8_BAR; PG8_WAIT_L(0); PG8_MMA(0, 1, At, B1); PG8_BAR;
            PG8_LDA(At, 1, 1); PG8_STAGE(PG8_SA(1, 0), a3, voffA);
            PG8_BAR; PG8_WAIT_L(0); PG8_MMA(1, 0, At, B0); PG8_BAR; PG8_SCHED;
            PG8_STAGE(PG8_SB(1, 1), b3 + hstep, voffB);
            PG8_WAIT_V(6); PG8_BAR; PG8_MMA(1, 1, At, B1); PG8_BAR;
        }
        E(acc, cur, wr, wc, fr, fq, (const LAS float*)(lds + RV_OFF + (ui & 1) * 1024)); S.done(cur);
        if (!has_next) break;
#pragma unroll
        for (int a = 0; a < 2; ++a)
#pragma unroll
            for (int b = 0; b < 2; ++b)
#pragma unroll
                for (int m = 0; m < 4; ++m)
#pragma unroll
                    for (int n = 0; n < 2; ++n) acc[a][b][m][n] = (f32x4){0.f, 0.f, 0.f, 0.f};
        cur = nxt; cA = nA; cB = nB; ++ui;
    }
    PG8_WAIT_V(0);
    if (wr == 0) PG8_BAR;
    PG8_BAR;
#undef PG8_SA
#undef PG8_SB
#undef PG8_STAGE
#undef PG8_LDA
#undef PG8_LDB
#undef PG8_MMA
#undef PG8_WAIT_V
#undef PG8_WAIT_L
#undef PG8_BAR
#undef PG8_SCHED
}
}
template <class ColMap>
DI void xpose_tile(LAS float* tile, const float* src, int lds_, bf16_t* dst, int ldd, const float* scale, int k0, int n0, const ColMap& cm) {
    int t = threadIdx.x; OPAQUE(t);
    __syncthreads();
    f32x4 v[8];
#pragma unroll
    for (int i = 0; i < 8; ++i) { const int kk = (t >> 6) + 8 * i, n4 = (t & 63) * 4; const int c = cm(n0 + n4);
        v[i] = (c >= 0) ? *(const f32x4*)(src + (size_t)(k0 + kk) * lds_ + c) : (f32x4){0.f, 0.f, 0.f, 0.f}; }
#pragma unroll
    for (int i = 0; i < 8; ++i) { const int kk = (t >> 6) + 8 * i, n4 = (t & 63) * 4; f32x4 w = v[i]; if (scale) w = w * scale[k0 + kk]; *(LAS f32x4*)(tile + kk * 260 + n4) = w; }
    __syncthreads();
#pragma unroll
    for (int i = 0; i < 4; ++i) { const int item = t + 512 * i, nn = item >> 3, kk = (item & 7) * 8; u32x4 w;
        w.x = cvt_pk_bf16(tile[(kk + 0) * 260 + nn], tile[(kk + 1) * 260 + nn]); w.y = cvt_pk_bf16(tile[(kk + 2) * 260 + nn], tile[(kk + 3) * 260 + nn]);
        w.z = cvt_pk_bf16(tile[(kk + 4) * 260 + nn], tile[(kk + 5) * 260 + nn]); w.w = cvt_pk_bf16(tile[(kk + 6) * 260 + nn], tile[(kk + 7) * 260 + nn]);
        *(u32x4*)(dst + (size_t)(n0 + nn) * ldd + k0 + kk) = w; }
}
struct CmIdent { DI int operator()(int n) const { return n; } };
struct CmWin { DI int operator()(int n) const { return win_orig_col(n); } };
struct CmSigma { DI int operator()(int n) const { return sigma_col(n); } };

DI void row_prep(const float* xrow, bf16_t* xbrow, float* ssprow, int lane) {
    for (int c0 = 0; c0 < D; c0 += 256) {
        f32x4 v = xrow ? *(const f32x4*)(xrow + c0 + lane * 4) : (f32x4){0.f, 0.f, 0.f, 0.f};
        u32x2 w; w.x = cvt_pk_bf16(v[0], v[1]); w.y = cvt_pk_bf16(v[2], v[3]);
        *(u32x2*)(xbrow + c0 + lane * 4) = w;
        float s = v[0] * v[0] + v[1] * v[1] + v[2] * v[2] + v[3] * v[3];
        s += __shfl_xor(s, 1); s += __shfl_xor(s, 2); s += __shfl_xor(s, 4); s += __shfl_xor(s, 8);
        if ((lane & 15) == 0) ssprow[(c0 >> 6) + (lane >> 4)] = s;
    }
}

DI void phase_prologue(const Params& p, LAS unsigned char* lds) {
    int tid = threadIdx.x; OPAQUE(tid);
    const int lane = tid & 63, wid = tid >> 6;
    unsigned char* ws = p.ws;
    LAS float* tile = (LAS float*)lds;
    const int T_WIN = (NP / 256) * (D / 64), T_WOUT = (D / 256) * (D / 64), T_WUP = (DFF / 256) * (D / 64), T_WDN = (D / 256) * (DFF / 64);
    const int T_LAYER = T_WIN + T_WOUT + T_WUP + T_WDN;
    for (int u = blockIdx.x; u < DEPTH * T_LAYER; u += gridDim.x) {
        const int l = u / T_LAYER; int r = u % T_LAYER;
        if (r < T_WIN) { const int nt = r / (D / 64), kt = r % (D / 64);
            xpose_tile(tile, p.in[I_WIN] + (size_t)l * D * NIN_ORIG, NIN_ORIG, (bf16_t*)(ws + WS_WIN) + (size_t)l * NP * D, D, p.in[I_N1W] + l * D, kt * 64, nt * 256, CmWin()); continue; }
        r -= T_WIN;
        if (r < T_WOUT) { const int nt = r / (D / 64), kt = r % (D / 64);
            xpose_tile(tile, p.in[I_WOUT] + (size_t)l * D * D, D, (bf16_t*)(ws + WS_WOUT) + (size_t)l * D * D, D, nullptr, kt * 64, nt * 256, CmIdent()); continue; }
        r -= T_WOUT;
        if (r < T_WUP) { const int nt = r / (D / 64), kt = r % (D / 64);
            xpose_tile(tile, p.in[I_WUP] + (size_t)l * D * DFF, DFF, (bf16_t*)(ws + WS_WUP) + (size_t)l * DFF * D, D, p.in[I_N2W] + l * D, kt * 64, nt * 256, CmSigma()); continue; }
        r -= T_WUP;
        { const int nt = r / (DFF / 64), kt = r % (DFF / 64);
            xpose_tile(tile, p.in[I_WDN] + (size_t)l * DFF * D, D, (bf16_t*)(ws + WS_WDN) + (size_t)l * D * DFF, DFF, nullptr, kt * 64, nt * 256, CmIdent()); }
    }
    { float* rc = (float*)(ws + WS_ROPE); float* rs = rc + (size_t)ROPE_N * 64;
      for (int i = blockIdx.x * 512 + tid; i < ROPE_N * 64; i += gridDim.x * 512) { const int pos = i >> 6, f = i & 63;
          const float inv = (float)pow(10000.0, -(double)f / 64.0); const float ang = (float)pos * inv;
          rc[i] = (float)cos((double)ang); rs[i] = (float)sin((double)ang); } }
    { bf16_t* xb = (bf16_t*)(ws + WS_XB); float* ssp = (float*)(ws + WS_SSP);
      for (int row = blockIdx.x * 8 + wid; row < MALL; row += gridDim.x * 8) {
          const float* xr = row < MP ? p.in[I_XP] + (size_t)row * D : (row - MP < MS ? p.in[I_XS] + (size_t)(row - MP) * D : nullptr);
          row_prep(xr, xb + (size_t)row * D, ssp + (size_t)row * NPART, lane); } }
}

#ifdef EMU
#define NT_ST4(p, v) (*(f32x4*)(p) = (v))
#else
#define NT_ST4(p, v) __builtin_nontemporal_store((v), (f32x4*)(p))
#endif
#ifdef EMU
#define SCAL(x) ((void)0)
#else
#define SCAL(x) asm("" : "+v"(x))
#endif
struct EpiInProj {
    static constexpr bool PERM = true;
    int layer; unsigned char* ws; float* out; int nostore;
    DI void st8(bf16_t* dst, const f32x4& a, const f32x4& b) const { if (nostore == 1) { asm volatile("" :: "v"(a[0] + b[0])); return; } u32x4 w; w.x = cvt_pk_bf16(a[0], a[1]); w.y = cvt_pk_bf16(a[2], a[3]); w.z = cvt_pk_bf16(b[0], b[1]); w.w = cvt_pk_bf16(b[2], b[3]); *(u32x4*)dst = w; }
    DI void st4(bf16_t* dst, const f32x4& a) const { if (nostore == 1) { asm volatile("" :: "v"(a[0])); return; } u32x2 w; w.x = cvt_pk_bf16(a[0], a[1]); w.y = cvt_pk_bf16(a[2], a[3]); *(u32x2*)dst = w; }
    DI void operator()(const f32x4 (&acc)[2][2][4][2], const pg8::Unit& u, int wr, int wc, int fr_, int fq_, const LAS float* rs_lds) const {
        int fr = fr_, fq = fq_; OPAQUE(fr); OPAQUE(fq);
        const bool sample = u.pm >= MP / 256;
        const int pn = u.pn;
        const float* ropec = (const float*)(ws + WS_ROPE); const float* ropes = ropec + (size_t)ROPE_N * 64;
        bf16_t* qa = (bf16_t*)(ws + WS_QA); bf16_t* ka = (bf16_t*)(ws + WS_KA); bf16_t* va = (bf16_t*)(ws + WS_VA); bf16_t* braw = (bf16_t*)(ws + WS_BRAW); bf16_t* bz = (bf16_t*)(ws + WS_BZ);
        bf16_t* qc = (bf16_t*)(ws + WS_QC); bf16_t* kc = (bf16_t*)(ws + WS_KC); bf16_t* vc = (bf16_t*)(ws + WS_VC); bf16_t* gates = (bf16_t*)(ws + WS_GATES); float* bab = (float*)(ws + WS_BAB);
        int kind, segt;
        if (pn < TD) { kind = 0; segt = 0; } else if (pn < 2 * TD) { kind = 1; segt = TD; } else if (pn < 3 * TD) { kind = 2; segt = 2 * TD; }
        else if (pn < 6 * TD) { kind = 3; segt = 3 * TD; } else if (pn < 7 * TD) { kind = 4; segt = 6 * TD; } else if (pn < 8 * TD) { kind = 5; segt = 7 * TD; }
        else if (pn < 9 * TD) { kind = 6; segt = 8 * TD; } else if (pn < 10 * TD) { kind = 7; segt = 9 * TD; } else if (pn < 13 * TD) { kind = 8; segt = 10 * TD; }
        else { kind = 9; segt = 13 * TD; }
        const int cb = (pn - segt) * 256 + wc * 32 + fq * 8;
        const int cbs = (pn - segt) * 256 + wc * 64 + fq * 8;
#pragma unroll
        for (int ai = 0; ai < 2; ++ai)
#pragma unroll
            for (int m = 0; m < 4; ++m) {
                const int row = u.pm * 256 + ai * 128 + wr * 64 + m * 16 + fr;
                int b, t, L; bool valid = true;
                if (!sample) { b = row / SEQ; t = row % SEQ; L = SEQ; } else { const int sr = row - MP; valid = sr < MS; b = sr / DSEQ; t = sr % DSEQ; L = DSEQ; }
                if (!valid) continue;
                const int pos = sample ? PAST + t : t;
                const float rs = rs_lds[ai * 128 + wr * 64 + m * 16 + fr];
                const size_t orow = ((size_t)(layer * (sample ? DB : NB) + b) * L + t) * D;
#pragma unroll
                for (int bj = 0; bj < 2; ++bj) {
                    const f32x4 v0 = acc[ai][bj][m][0] * rs, v1 = acc[ai][bj][m][1] * rs;
                    const int c = kind <= 1 ? cb + bj * 128 : cbs + bj * 32;
                    if (kind <= 1) {
                        const int head = c >> 7, d0 = ((c & 127) >> 3) * 4;
                        const f32x4 cs = *(const f32x4*)(ropec + (size_t)pos * 64 + d0), sn = *(const f32x4*)(ropes + (size_t)pos * 64 + d0);
                        const f32x4 o1 = v0 * cs - v1 * sn, o2 = v1 * cs + v0 * sn;
                        const int tc = head * 128 + d0;
                        bf16_t* dst = (kind == 0 ? qa : ka) + (size_t)row * D + tc;
                        st4(dst, o1); st4(dst + 64, o2);
                        if (kind == 1 && sample) { float* o = out + O_SAK + orow + tc; if (!nostore) { NT_ST4(o, o1); NT_ST4((o + 64), o2); } }
                    } else if (kind == 2) { st8(va + (size_t)row * D + c, v0, v1); if (sample) { float* o = out + O_SAV + orow + c; if (!nostore) { NT_ST4(o, v0); NT_ST4((o + 4), v1); } } }
                    else if (kind == 3) { st8(braw + (size_t)row * 3 * D + c, v0, v1);
                        if (t >= L - 3) { float* o = out + (sample ? O_SBC : O_PBC) + ((size_t)(layer * (sample ? DB : NB) + b) * 3 + (t - (L - 3))) * 3 * D + c; if (!nostore) { NT_ST4(o, v0); NT_ST4((o + 4), v1); } } }
                    else if (kind == 4) st8(bz + (size_t)row * D + c, v0, v1);
                    else if (kind == 5) st8(qc + (size_t)row * D + c, v0, v1);
                    else if (kind == 6) { st8(kc + (size_t)row * D + c, v0, v1); float* o = out + (sample ? O_SCK : O_PCK) + orow + c; if (!nostore) { NT_ST4(o, v0); NT_ST4((o + 4), v1); } }
                    else if (kind == 7) { st8(vc + (size_t)row * D + c, v0, v1); float* o = out + (sample ? O_SCV : O_PCV) + orow + c; if (!nostore) { NT_ST4(o, v0); NT_ST4((o + 4), v1); } }
                    else if (kind == 8) st8(gates + (size_t)row * 3 * D + c, v0, v1);
                    else { if (c < 16 && !nostore) { float* o = bab + (size_t)row * 16 + c; NT_ST4(o, v0); NT_ST4((o + 4), v1); } }
                }
                if ((m & 1) == 1) COMPILER_FENCE();
            }
    }
};

DI void conv_unit(const Params& p, int l, int rbx, int cg) {
    int tid = threadIdx.x; OPAQUE(tid);
    unsigned char* ws = p.ws;
    const bf16_t* braw = (const bf16_t*)(ws + WS_BRAW);
    bf16_t* bqkv[3] = {(bf16_t*)(ws + WS_BQ), (bf16_t*)(ws + WS_BK), (bf16_t*)(ws + WS_BV)};
    const float* bab = (const float*)(ws + WS_BAB); float* gb = (float*)(ws + WS_GB);
    const float* convw = p.in[I_CONVW] + (size_t)l * CONVW * 3 * D;
    const float* alog = p.in[I_ALOG] + l * HB; const float* dtb = p.in[I_DTB] + l * HB;
    constexpr int CG = (3 * D + 1023) / 1024;
    const int ct = tid & 127, rg = tid >> 7;
    {
        const bool sample = rbx >= MP / 64;
        const int rb = sample ? rbx - MP / 64 : rbx;
        const int b = sample ? rb : (rb * 64) / SEQ, t00 = sample ? 0 : (rb * 64) % SEQ, nreal = sample ? DSEQ : 64;
        const size_t rawrow0 = sample ? (size_t)MP + (size_t)b * DSEQ : (size_t)b * SEQ + t00;
        const size_t dstrow0 = sample ? (size_t)MP + (size_t)b * 64 : (size_t)b * SEQ + t00;
        const int col8u = cg * 1024 + ct * 8; const bool active = col8u < 3 * D; const int col8 = active ? col8u : 0, seg = col8 / D, cseg = col8 % D;
        float cw[4][8];
#pragma unroll
        for (int k = 0; k < 4; ++k) { const f32x4 a = *(const f32x4*)(convw + (size_t)k * 3 * D + col8), bq4 = *(const f32x4*)(convw + (size_t)k * 3 * D + col8 + 4);
#pragma unroll
            for (int e = 0; e < 4; ++e) { cw[k][e] = a[e]; cw[k][4 + e] = bq4[e]; } }
#pragma unroll 1
        for (int half = 0; half < 2; ++half) {
            const int t0 = rg * 16 + half * 8;
            u32x4 raw[11];
#pragma unroll
            for (int j = 0; j < 11; ++j) { const int t = t0 - 3 + j; raw[j] = (u32x4){0u, 0u, 0u, 0u};
                if (active && (t >= 0 ? (t < nreal) : (!sample && t00 + t >= 0))) raw[j] = *(const u32x4*)(braw + (size_t)((long)rawrow0 + t) * 3 * D + col8); }
            float hist[3][8];
            const bool use_hist = sample && t0 == 0;
            if (use_hist) { const float* hs = p.in[I_SCONV] + ((size_t)(l * DB + b) * 3) * 3 * D + col8;
#pragma unroll
                for (int j = 0; j < 3; ++j)
#pragma unroll
                    for (int e = 0; e < 8; ++e) hist[j][e] = hs[(size_t)j * 3 * D + e]; }
#pragma unroll
            for (int r8 = 0; r8 < 8; ++r8) {
                const int t = t0 + r8; float o[8];
                if (t < nreal) {
                    float ss = 0.f;
#pragma unroll
                    for (int e = 0; e < 8; ++e) { float c = 0.f;
#pragma unroll
                        for (int k = 0; k < 4; ++k) { const int j = r8 + k;
                            float x = (e & 1) ? bf_hi(raw[j][e >> 1]) : bf_lo(raw[j][e >> 1]);
                            if (r8 + k < 3) { if (use_hist) x = hist[r8 + k][e]; }
                            c += x * cw[k][e]; }
                        const float sv = c * sigmoidf_(c); o[e] = sv; ss += sv * sv; }
                    ss += __shfl_xor(ss, 1); ss += __shfl_xor(ss, 2); ss += __shfl_xor(ss, 4); ss += __shfl_xor(ss, 8);
                    const float sc = seg < 2 ? __builtin_amdgcn_rsqf(ss + EPS) * (seg == 0 ? 0.08838834764831845f : 1.0f) : 1.0f;
#pragma unroll
                    for (int e = 0; e < 8; ++e) o[e] *= sc;
                } else {
#pragma unroll
                    for (int e = 0; e < 8; ++e) o[e] = 0.f;
                }
                u32x4 w; w.x = cvt_pk_bf16(o[0], o[1]); w.y = cvt_pk_bf16(o[2], o[3]); w.z = cvt_pk_bf16(o[4], o[5]); w.w = cvt_pk_bf16(o[6], o[7]);
                if (active) *(u32x4*)(bqkv[seg] + (dstrow0 + t) * D + cseg) = w;
            }
        }
        if (cg == 0) { const int t = tid / HB, h = tid % HB; float g = 0.f, be = 0.f;
            if (t < nreal) { const float ba = bab[(rawrow0 + t) * 16 + h], bbv = bab[(rawrow0 + t) * 16 + HB + h];
                const float x = ba + dtb[h]; const float sp = fmaxf(x, 0.f) + 0.69314718056f * __builtin_amdgcn_logf(1.0f + fast_exp(-fabsf(x)));
                g = -fast_exp(alog[h]) * sp; be = sigmoidf_(bbv); }
            if (t < 64) { gb[(dstrow0 + t) * 16 + h] = g; gb[(dstrow0 + t) * 16 + 8 + h] = be; } }
    }
}

DI int crow32(int reg, int h) { return (reg & 3) + 8 * (reg >> 2) + 4 * h; }
DI bf16x8 pack8(const f32x16& x, int s) {
    u32x4 w; w.x = cvt_pk_bf16(x[8 * s + 0], x[8 * s + 1]); w.y = cvt_pk_bf16(x[8 * s + 2], x[8 * s + 3]); w.z = cvt_pk_bf16(x[8 * s + 4], x[8 * s + 5]); w.w = cvt_pk_bf16(x[8 * s + 6], x[8 * s + 7]);
    return __builtin_bit_cast(bf16x8, w);
}
#define MFMA32(a, b, c) __builtin_amdgcn_mfma_f32_32x32x16_bf16((a), (b), (c), 0, 0, 0)
DI f32x16 zero16() { f32x16 z;
#pragma unroll
    for (int i = 0; i < 16; ++i) z[i] = 0.f; return z; }

DI void unit_rows_b(int u, int& row0, int& h) {
    if (u < NB * NCH * HB) { h = u % HB; const int bc = u / HB; row0 = (bc / NCH) * SEQ + (bc % NCH) * 64; }
    else { const int s = u - NB * NCH * HB; h = s % HB; row0 = MP + (s / HB) * 64; }
}

DI void pre_unit(const Params& p, LAS unsigned char* lds, int u) {
    int tid = threadIdx.x; OPAQUE(tid);
    const int lane_ = tid & 63, wid = tid >> 6;
    unsigned char* ws = p.ws;
    const bf16_t* bq = (const bf16_t*)(ws + WS_BQ); const bf16_t* bk = (const bf16_t*)(ws + WS_BK);
    const float* gb = (const float*)(ws + WS_GB);
    bf16_t* TT = (bf16_t*)(ws + WS_TT); bf16_t* AQ = (bf16_t*)(ws + WS_AQK); float* CV = (float*)(ws + WS_CV);
    LAS float* Mm = (LAS float*)(lds + wid * 16896);
    LAS float* gcs = Mm + 4096;
    {
        int lane = lane_; OPAQUE(lane);
        const int r = lane & 31, hh = lane >> 5;
        int row0, h; unit_rows_b(u, row0, h);
        const float g = gb[(size_t)(row0 + lane) * 16 + h], be = gb[(size_t)(row0 + lane) * 16 + 8 + h];
        float gc = g;
#pragma unroll
        for (int d = 1; d < 64; d <<= 1) { const float o = __shfl_up(gc, d); if (lane >= d) gc += o; }
        const float gL = __shfl(gc, 63);
        gcs[lane] = gc; gcs[64 + lane] = be;
        { float* cv = CV + (size_t)u * 256; const float eg = expf(gc); cv[lane] = be; cv[64 + lane] = be * eg; cv[128 + lane] = eg; cv[192 + lane] = expf(gL - gc); }
        WAVE_LDS_FENCE();
#pragma unroll
        for (int bi = 0; bi < 2; ++bi)
#pragma unroll
            for (int bj = 0; bj < 2; ++bj) {
                f32x16 kk = zero16(), qk = zero16();
                if (bj <= bi) {
                    const bf16_t* ki = bk + (size_t)(row0 + 32 * bi + r) * D + h * 128 + 8 * hh; const bf16_t* kj = bk + (size_t)(row0 + 32 * bj + r) * D + h * 128 + 8 * hh;
                    const bf16_t* qi = bq + (size_t)(row0 + 32 * bi + r) * D + h * 128 + 8 * hh;
#pragma unroll 2
                    for (int s = 0; s < 8; ++s) { const bf16x8 fki = *(const bf16x8*)(ki + 16 * s), fkj = *(const bf16x8*)(kj + 16 * s), fqi = *(const bf16x8*)(qi + 16 * s);
                        kk = MFMA32(fki, fkj, kk); qk = MFMA32(fqi, fkj, qk); }
                }
                __builtin_amdgcn_sched_barrier(0);
                const int j = 32 * bj + r; const float gcj = gcs[j];
#pragma unroll
                for (int i16 = 0; i16 < 16; ++i16) { const int i = 32 * bi + crow32(i16, hh); const float gci = gcs[i], bei = gcs[64 + i];
                    const float dec = (j <= i) ? expf(gci - gcj) : 0.f;
                    if (bj <= bi) Mm[i * 64 + j] = (j < i) ? bei * kk[i16] * dec : 0.f;
                    AQ[(size_t)u * 4096 + i * 64 + j] = f2bf((bj <= bi) ? qk[i16] * dec : 0.f); }
                __builtin_amdgcn_sched_barrier(0);
            }
        WAVE_LDS_FENCE();
        float tcol[64];
#pragma unroll
        for (int i = 0; i < 64; ++i) {
            float a = (i == lane) ? 1.f : 0.f;
#pragma unroll
            for (int j4 = 0; j4 < (i + 3) / 4; ++j4) { const f32x4 mv = *(const LAS f32x4*)(Mm + i * 64 + 4 * j4);
#pragma unroll
                for (int e = 0; e < 4; ++e) if (4 * j4 + e < i) a -= mv[e] * tcol[4 * j4 + e]; }
            tcol[i] = a;
            TT[(size_t)u * 4096 + i * 64 + lane] = f2bf(a);
            __builtin_amdgcn_sched_barrier(0);
        }
        WAVE_LDS_FENCE();
    }
}

DI void phase_conv_pre(const Params& p, int l, LAS unsigned char* lds) {
    const int wid = (int)threadIdx.x >> 6;
    constexpr int CG = (3 * D + 1023) / 1024;
    constexpr int NRB = MP / 64 + DB;
    for (int rbx = blockIdx.x; rbx < NRB; rbx += gridDim.x) {
#pragma unroll 1
        for (int cg = 0; cg < CG; ++cg) conv_unit(p, l, rbx, cg);
        ASM_WAIT_VM0(); __syncthreads();
        if (wid < HB) { const bool sample = rbx >= MP / 64; const int u = sample ? NB * NCH * HB + (rbx - MP / 64) * HB + wid : rbx * HB + wid;
            pre_unit(p, lds, u); }
    }
}

constexpr size_t WS_QUEUE = 16384;
DI int queue_next(unsigned* ctr, volatile LAS unsigned* slot) {
    __syncthreads();
    if (threadIdx.x == 0) *slot = __hip_atomic_fetch_add(ctr, 1u, __ATOMIC_RELAXED, __HIP_MEMORY_SCOPE_AGENT);
    __syncthreads();
    return __builtin_amdgcn_readfirstlane((int)*slot);
}

DI int xcd_queue_next(unsigned* ctr8, int nstreams, int per_stream, int& qx, int& tries, volatile LAS unsigned* slot) {
    for (;;) {
        if (tries >= 8) return -1;
        const int j = queue_next(ctr8 + 64 * qx, slot);
        if (j < per_stream * ((nstreams - qx + 7) / 8)) return j;
        qx = (qx + 1) & 7; ++tries;
    }
}

DI unsigned img_b(unsigned row, unsigned ch) { return 256u * row + 16u * (ch ^ (((row & 3u) << 2) | ((row >> 2) & 3u))); }
DI bf16x8 ld2x8(const LAS unsigned char* p0, const LAS unsigned char* p1) {
    const u32x2 a = *(const LAS u32x2*)p0, b = *(const LAS u32x2*)p1; u32x4 w; w.x = a.x; w.y = a.y; w.z = b.x; w.w = b.y; return __builtin_bit_cast(bf16x8, w);
}
DI unsigned tk_off(unsigned ta, int cbw, int kb) { return ta ^ (unsigned)(64 * ((cbw & 3) ^ kb)); }
constexpr int SC_KI = 0, SC_QI = 16384, SC_VI = 32768, SC_TI = 49152, SC_AI = 57344, SC_CV = 65536, SC_BUF = 66560;

DI void phase_gdn_scan(const Params& p, int l, LAS unsigned char* lds, unsigned* qctr, volatile LAS unsigned* qslot) {
    int tid = threadIdx.x; OPAQUE(tid);
    const int lane_ = tid & 63, wid = __builtin_amdgcn_readfirstlane(tid >> 6);
    unsigned char* ws = p.ws;
    const bf16_t* bq = (const bf16_t*)(ws + WS_BQ); const bf16_t* bk = (const bf16_t*)(ws + WS_BK); const bf16_t* bv = (const bf16_t*)(ws + WS_BV);
    const bf16_t* TT = (const bf16_t*)(ws + WS_TT); const bf16_t* AQ = (const bf16_t*)(ws + WS_AQK); const float* CV = (const float*)(ws + WS_CV);
    bf16_t* ob = (bf16_t*)(ws + WS_OBUF);
    constexpr int NCHAIN = NB * HB + DB * HB;
    for (;;) {
        const int ch = queue_next(qctr, qslot); if (ch >= NCHAIN) break;
        int lane = lane_; OPAQUE(lane);
        const int r = lane & 31, hh = lane >> 5;
        const bool sample = ch >= NB * HB;
        const int b = sample ? (ch - NB * HB) / HB : ch / HB, h = ch % HB, nchunk = sample ? 1 : NCH;
        const int dv0 = 32 * wid;
        const int u0 = sample ? NB * NCH * HB + b * HB + h : (b * NCH) * HB + h;
        const int row00 = sample ? MP + b * 64 : b * SEQ;
        const unsigned cx = (unsigned)((lane & 15) ^ (((lane >> 4) & 3) << 2));
#define SCAN_ISSUE(c_) do { if (wid >= 4) { LAS unsigned char* buf_ = lds + ((c_) & 1) * SC_BUF; \
            if (wid < 7) { const bf16_t* src_ = (wid == 4 ? bk : (wid == 5 ? bq : bv)) + (size_t)(row00 + 64 * (c_)) * D + h * 128; LAS unsigned char* d_ = buf_ + (wid - 4) * 16384; \
                _Pragma("unroll") for (int g_ = 0; g_ < 16; ++g_) GLDS16((const char*)src_ + (size_t)((4 * g_ + (lane >> 4)) * D * 2) + 16u * (cx ^ (unsigned)(g_ & 3)), d_ + g_ * 1024); } \
            else { const size_t uo_ = (size_t)(u0 + (c_) * HB); \
                _Pragma("unroll") for (int g_ = 0; g_ < 8; ++g_) { GLDS16((const char*)(TT + uo_ * 4096) + g_ * 1024 + lane * 16, buf_ + SC_TI + g_ * 1024); GLDS16((const char*)(AQ + uo_ * 4096) + g_ * 1024 + lane * 16, buf_ + SC_AI + g_ * 1024); } \
                GLDS16((const char*)(CV + uo_ * 256) + lane * 16, buf_ + SC_CV); } } } while (0)
        const unsigned sa0 = img_b(r, 0) + 8 * hh;
        unsigned ta0;
        { const int blk = (lane >> 4) & 1, q4 = (lane & 15) >> 2, p4 = lane & 3; ta0 = img_b(4 * hh + q4, 4 * (wid & 3) + 2 * blk + (p4 >> 1)) + 8 * (p4 & 1); }
        f32x16 S[4];
        if (wid < 4) {
#pragma unroll
            for (int kb = 0; kb < 4; ++kb) { S[kb] = zero16();
                if (sample) { const float* s0 = p.in[I_SSSM] + ((size_t)(l * DB + b) * HB + h) * 128 * 128;
#pragma unroll
                    for (int i = 0; i < 16; ++i) S[kb][i] = s0[(size_t)(32 * kb + crow32(i, hh)) * 128 + dv0 + r]; } }
        }
        SCAN_ISSUE(0);
        for (int c = 0; c < nchunk; ++c) {
            ASM_WAIT_ALL0(); __builtin_amdgcn_s_barrier();
            if (c + 1 < nchunk) SCAN_ISSUE(c + 1);
            if (wid < 4) {
                const LAS unsigned char* B = lds + (c & 1) * SC_BUF;
                unsigned sa = sa0, ta = ta0; OPAQUE(sa); OPAQUE(ta);
                const int row0 = row00 + 64 * c;
                f32x16 ks[2], qs[2];
                ks[0] = zero16(); ks[1] = zero16(); qs[0] = zero16(); qs[1] = zero16();
#pragma unroll
                for (int s = 0; s < 8; ++s) { const bf16x8 sb = pack8(S[s >> 1], s & 1); const unsigned o0 = sa ^ (unsigned)(32 * s), o1 = o0 ^ 16u;
                    ks[0] = MFMA32(ld2x8(B + SC_KI + o0, B + SC_KI + o1), sb, ks[0]);
                    ks[1] = MFMA32(ld2x8(B + SC_KI + 8192 + o0, B + SC_KI + 8192 + o1), sb, ks[1]);
                    qs[0] = MFMA32(ld2x8(B + SC_QI + o0, B + SC_QI + o1), sb, qs[0]);
                    qs[1] = MFMA32(ld2x8(B + SC_QI + 8192 + o0, B + SC_QI + 8192 + o1), sb, qs[1]);
                    __builtin_amdgcn_sched_barrier(0); }
                const LAS unsigned char* cvb = B + SC_CV + 16 * hh;
                f32x16 rr[2];
#pragma unroll
                for (int tb = 0; tb < 2; ++tb)
#pragma unroll
                    for (int g = 0; g < 4; ++g) { const s16x4 vv = ds_read_tr16(B + SC_VI + (32 * tb + 8 * g) * 256 + (ta ^ ((g & 1) ? 32u : 0u)));
                        const f32x4 be = *(const LAS f32x4*)(cvb + 4 * (32 * tb + 8 * g)), bg = *(const LAS f32x4*)(cvb + 4 * (64 + 32 * tb + 8 * g));
#pragma unroll
                        for (int e = 0; e < 4; ++e) rr[tb][4 * g + e] = be[e] * bf2f((bf16_t)vv[e]) - bg[e] * ks[tb][4 * g + e]; }
                __builtin_amdgcn_sched_barrier(0);
                bf16x8 Rb[4];
#pragma unroll
                for (int s2 = 0; s2 < 4; ++s2) Rb[s2] = pack8(rr[s2 >> 1], s2 & 1);
                f32x16 uu[2];
#pragma unroll
                for (int tb = 0; tb < 2; ++tb) { uu[tb] = zero16();
#pragma unroll
                    for (int s2 = 0; s2 < 2 * tb + 2; ++s2) { const LAS unsigned char* base = B + SC_TI + (32 * tb + r) * 128 + 32 * s2 + 8 * hh;
                        uu[tb] = MFMA32(ld2x8(base, base + 16), Rb[s2], uu[tb]); } }
                __builtin_amdgcn_sched_barrier(0);
                bf16x8 Ub[4], Ud[4];
#pragma unroll
                for (int tb = 0; tb < 2; ++tb) { f32x16 ud;
#pragma unroll
                    for (int g = 0; g < 4; ++g) { const f32x4 dg = *(const LAS f32x4*)(cvb + 4 * (192 + 32 * tb + 8 * g));
#pragma unroll
                        for (int e = 0; e < 4; ++e) ud[4 * g + e] = uu[tb][4 * g + e] * dg[e]; }
                    Ub[2 * tb] = pack8(uu[tb], 0); Ub[2 * tb + 1] = pack8(uu[tb], 1); Ud[2 * tb] = pack8(ud, 0); Ud[2 * tb + 1] = pack8(ud, 1); }
                __builtin_amdgcn_sched_barrier(0);
#pragma unroll
                for (int tb = 0; tb < 2; ++tb) { f32x16 o;
#pragma unroll
                    for (int g = 0; g < 4; ++g) { const f32x4 eg = *(const LAS f32x4*)(cvb + 4 * (128 + 32 * tb + 8 * g));
#pragma unroll
                        for (int e = 0; e < 4; ++e) o[4 * g + e] = qs[tb][4 * g + e] * eg[e]; }
#pragma unroll
                    for (int s2 = 0; s2 < 2 * tb + 2; ++s2) { const LAS unsigned char* base = B + SC_AI + (32 * tb + r) * 128 + 32 * s2 + 8 * hh;
                        o = MFMA32(ld2x8(base, base + 16), Ub[s2], o); }
                    bf16_t* od = ob + (size_t)(row0 + 32 * tb + 4 * hh) * D + h * 128 + dv0 + r;
#pragma unroll
                    for (int i = 0; i < 16; ++i) od[(size_t)((i & 3) + 8 * (i >> 2)) * D] = f2bf(o[i]); }
                __builtin_amdgcn_sched_barrier(0);
                const float egL = *(const LAS float*)(B + SC_CV + 4 * (128 + 63));
#pragma unroll
                for (int kb = 0; kb < 4; ++kb) {
#pragma unroll
                    for (int i = 0; i < 16; ++i) S[kb][i] *= egL;
#pragma unroll
                    for (int s2 = 0; s2 < 4; ++s2) {
                        const s16x4 lo = ds_read_tr16(B + SC_KI + s2 * 4096 + tk_off(ta, wid, kb));
                        const s16x4 hi = ds_read_tr16(B + SC_KI + s2 * 4096 + 2048 + (tk_off(ta, wid, kb) ^ 32u));
                        const bf16x8 a = __builtin_shufflevector(lo, hi, 0, 1, 2, 3, 4, 5, 6, 7);
                        S[kb] = MFMA32(a, Ud[s2], S[kb]); __builtin_amdgcn_sched_barrier(0); }
                }
            }
        }
#undef SCAN_ISSUE
        if (wid < 4) { int cl = dv0 + r + 512 * hh; OPAQUE(cl);
            float* so = p.out + (sample ? O_SBS : O_PBS) + ((size_t)(l * (sample ? DB : NB) + b) * HB + h) * 128 * 128 + cl;
#pragma unroll
            for (int kb = 0; kb < 4; ++kb)
#pragma unroll
                for (int i = 0; i < 16; ++i) so[(32 * kb + (i & 3) + 8 * (i >> 2)) * 128] = S[kb][i]; }
    }
}
constexpr int AT_K = 0, AT_V = 32768, AT_Q = 65536, AT_FLAG = 131072, AT_X = 0  ;

template <bool SRC32>
DI void stage_rows(LAS unsigned char* img, const void* src, size_t row_pitch_elems, int nrows, int nvalid) {
    int tid = threadIdx.x; OPAQUE(tid);
    for (int idx = tid; idx < nrows * 16; idx += 512) { const int row = idx >> 4, chn = idx & 15; u32x4 w = (u32x4){0u, 0u, 0u, 0u};
        if (row < nvalid) {
            if (SRC32) { const float* s = (const float*)src + (size_t)row * row_pitch_elems + chn * 8; const f32x4 a = *(const f32x4*)s, b = *(const f32x4*)(s + 4);
                w.x = cvt_pk_bf16(a[0], a[1]); w.y = cvt_pk_bf16(a[2], a[3]); w.z = cvt_pk_bf16(b[0], b[1]); w.w = cvt_pk_bf16(b[2], b[3]); }
            else w = *(const u32x4*)((const bf16_t*)src + (size_t)row * row_pitch_elems + chn * 8);
        }
        *(LAS u32x4*)(img + img_b(row, chn)) = w; }
}
struct LaneOffs { unsigned ra0; unsigned ta0[4]; };
DI LaneOffs make_lane_offs(int lane) {
    LaneOffs L; const int r = lane & 31, hh = lane >> 5, blk = (lane >> 4) & 1, q4 = (lane & 15) >> 2, p4 = lane & 3;
    L.ra0 = img_b(r, hh);
#pragma unroll
    for (int cb = 0; cb < 4; ++cb) L.ta0[cb] = img_b(4 * hh + q4, 4 * cb + 2 * blk + (p4 >> 1)) + 8 * (p4 & 1);
    return L;
}
DI bf16x8 lds_frag_row(const LAS unsigned char* img, const LaneOffs& L, int ks) { return *(const LAS bf16x8*)(img + (L.ra0 ^ (unsigned)(32 * ks))); }
DI bf16x8 lds_frag_tr(const LAS unsigned char* img, const LaneOffs& L, int s2, int cb) {
    const s16x4 lo = ds_read_tr16(img + s2 * 4096 + L.ta0[cb]);
    const s16x4 hi = ds_read_tr16(img + s2 * 4096 + 2048 + (L.ta0[cb] ^ 32u));
    return __builtin_shufflevector(lo, hi, 0, 1, 2, 3, 4, 5, 6, 7);
}

DI void cache_store_tile(const LAS unsigned char* stg, float* oK, float* oV) {
    int tq = threadIdx.x; OPAQUE(tq);
    const int ch = tq & 15;
#pragma unroll
    for (int j = 0; j < 8; ++j) { const int im = j >> 1, row = (tq >> 4) + 32 * (j & 1);
        const u32x4 w = *(const LAS u32x4*)(stg + im * 16384 + img_b(row, ch));
        float* o = (im < 2 ? oK + im * 128 : oV + (im - 2) * 128) + (size_t)row * D + ch * 8;
        const f32x4 a = (f32x4){bf_lo(w.x), bf_hi(w.x), bf_lo(w.y), bf_hi(w.y)}, b = (f32x4){bf_lo(w.z), bf_hi(w.z), bf_lo(w.w), bf_hi(w.w)};
        NT_ST4(o, a); NT_ST4((o + 4), b); }
}

#ifdef EMU
DI void swap32(float x, float& r0, float& r1) { const float o = __shfl_xor(x, 32); const bool up = (threadIdx.x & 32) != 0; r0 = up ? o : x; r1 = up ? x : o; }
#else
DI void swap32(float x, float& r0, float& r1) { const unsigned u = __float_as_uint(x); const auto r = __builtin_amdgcn_permlane32_swap(u, u, false, false); r0 = __uint_as_float(r[0]); r1 = __uint_as_float(r[1]); }
#endif
#ifdef EMU
#define TR_WAITN(n, a) ((void)0)
#else
#define TR_WAITN(n, a) do { if ((n) >= 8) TR_WAIT1(8, a); else if ((n) == 6) TR_WAIT1(6, a); else if ((n) == 4) TR_WAIT1(4, a); else if ((n) == 2) TR_WAIT1(2, a); else TR_WAIT1(0, a); } while (0)
#endif
#ifdef EMU
#define MAX3_ACC(acc, a, b) acc = fmaxf(acc, fmaxf((a), (b)))
#else
#define MAX3_ACC(acc, a, b) do { const float a_ = (a), b_ = (b); asm("v_max3_f32 %0, %0, %1, %2" : "+v"(acc) : "v"(a_), "v"(b_)); } while (0)
#endif
DI void attn_a_tile(const LAS unsigned char* Ki, const LAS unsigned char* Vi, const bf16x8 (&qreg)[8], int lane_in, int nvalid, float sc,
                    f32x16 (&O)[8], float& m, float& lsum, bool dma, const char* gsrc, LAS unsigned char* gdst, unsigned srow_in, unsigned cx_in) {
    int lane = lane_in; OPAQUE(lane);
    const LaneOffs LO = make_lane_offs(lane); const int hh = lane >> 5;
    f32x16 s0 = zero16(), s1 = zero16();
    {
        bf16x8 kb0[3], kb1[3];
#pragma unroll
        for (int j = 0; j < 3; ++j) { kb0[j] = lds_frag_row(Ki, LO, j); kb1[j] = lds_frag_row(Ki + 8192, LO, j); }
#pragma unroll
        for (int ks = 0; ks < 8; ++ks) {
            const bf16x8 a0 = kb0[ks % 3], a1 = kb1[ks % 3];
            if (ks + 3 < 8) { kb0[ks % 3] = lds_frag_row(Ki, LO, ks + 3); kb1[ks % 3] = lds_frag_row(Ki + 8192, LO, ks + 3); }
            s0 = MFMA32(a0, qreg[ks], s0); s1 = MFMA32(a1, qreg[ks], s1);
            if (dma && (ks & 1) == 0) { const int pc = ks >> 1; unsigned srow_ = srow_in, cx_ = cx_in; OPAQUE(srow_); OPAQUE(cx_); GLDS16(gsrc + (srow_ + (unsigned)(pc * 4 * D * 2) + 16u * (cx_ ^ (unsigned)(pc & 3))), gdst + pc * 1024); }
            __builtin_amdgcn_sched_barrier(0);
        }
    }
    bf16x8 vf[3];
#pragma unroll
    for (int j = 0; j < 3; ++j) { s16x4 a_, b_; TR_ISSUE(a_, Vi, LO.ta0[j & 3], 0); TR_ISSUE_X32(b_, Vi, LO.ta0[j & 3], 2048); vf[j] = __builtin_shufflevector(a_, b_, 0, 1, 2, 3, 4, 5, 6, 7); }
    __builtin_amdgcn_sched_barrier(0);
    float mt = -1e30f;
    if (nvalid < 64) {
        const int nvh = nvalid - 4 * hh;
#pragma unroll
        for (int i = 0; i < 16; ++i) { if ((i & 3) + 8 * (i >> 2) >= nvh) s0[i] = -1e30f; if ((i & 3) + 8 * (i >> 2) + 32 >= nvh) s1[i] = -1e30f; }
    }
    mt = fmaxf(mt, fmaxf(s0[15], s1[15]));
#pragma unroll
    for (int i = 0; i < 15; ++i) MAX3_ACC(mt, s0[i], s1[i]);
    { float r0_, r1_; swap32(mt, r0_, r1_); mt = fmaxf(r0_, r1_) * sc; }
    if (!__all(mt <= m + 8.0f)) {
        const float mn = fmaxf(m, mt), alpha = fast_exp2(m - mn); m = mn; lsum *= alpha;
#pragma unroll
        for (int d = 0; d < 8; ++d)
#pragma unroll
            for (int i = 0; i < 16; ++i) O[d][i] *= alpha;
    }
    float ps = 0.f;
    const float nm = -m;
    float ps1 = 0.f;
#pragma unroll
    for (int i = 0; i < 8; ++i) { const float e0 = fast_exp2(__builtin_fmaf(s0[i], sc, nm)); s0[i] = e0; ps += e0; SCAL(ps); }
    bf16x8 pb[4]; pb[0] = pack8(s0, 0);
    __builtin_amdgcn_sched_barrier(0);
    bf16x8 cur = vf[0];
    TR_WAITN(4, cur);
#pragma unroll
    for (int idx = 0; idx < 32; ++idx) { const int s2 = idx >> 3, d = idx & 7, slot = idx % 3;
        bf16x8 nxt = cur;
        if (idx + 1 < 32) { nxt = vf[(idx + 1) % 3]; if (idx + 2 < 32) TR_WAITN(2, nxt); else TR_WAITN(0, nxt); }
        O[d] = MFMA32(cur, pb[s2], O[d]);
        if (idx + 3 < 32) { const int j = idx + 3, js2 = j >> 3, jd = j & 7; s16x4 a_, b_;
            TR_ISSUE(a_, Vi, LO.ta0[jd & 3], (jd >> 2) * 16384 + js2 * 4096); TR_ISSUE_X32(b_, Vi, LO.ta0[jd & 3], (jd >> 2) * 16384 + js2 * 4096 + 2048);
            vf[slot] = __builtin_shufflevector(a_, b_, 0, 1, 2, 3, 4, 5, 6, 7); }
        cur = nxt;
        if (idx < 4) {
            const float ea = fast_exp2(__builtin_fmaf(s0[8 + 2 * idx], sc, nm)); s0[8 + 2 * idx] = ea; ps += ea; SCAL(ps);
            const float eb = fast_exp2(__builtin_fmaf(s0[9 + 2 * idx], sc, nm)); s0[9 + 2 * idx] = eb; ps1 += eb; SCAL(ps1); }
        else if (idx < 20) { const float e1 = fast_exp2(__builtin_fmaf(s1[idx - 4], sc, nm)); s1[idx - 4] = e1; ps1 += e1; SCAL(ps1); }
        if (idx == 3) pb[1] = pack8(s0, 1);
        if (dma && idx >= 5 && idx <= 17 && ((idx - 5) & 3) == 0) { const int pc = 4 + ((idx - 5) >> 2); unsigned srow_ = srow_in, cx_ = cx_in; OPAQUE(srow_); OPAQUE(cx_); GLDS16(gsrc + (srow_ + (unsigned)(pc * 4 * D * 2) + 16u * (cx_ ^ (unsigned)(pc & 3))), gdst + pc * 1024); }
        if (idx == 11) pb[2] = pack8(s1, 0);
        if (idx == 19) pb[3] = pack8(s1, 1);
        __builtin_amdgcn_sched_barrier(0);
    }
    lsum += ps + ps1;
}

DI void phase_attn_a(const Params& p, int l, LAS unsigned char* lds, unsigned* qctr, volatile LAS unsigned* qslot) {
    int tid = threadIdx.x; OPAQUE(tid);
    const int lane_ = tid & 63, wid = __builtin_amdgcn_readfirstlane(tid >> 6), c = wid >> 2, rg = wid & 3;
    unsigned char* ws = p.ws;
    const bf16_t* QA = (const bf16_t*)(ws + WS_QA); const bf16_t* KA = (const bf16_t*)(ws + WS_KA); const bf16_t* VA = (const bf16_t*)(ws + WS_VA);
    bf16_t* OA = (bf16_t*)(ws + WS_OA);
    const float lam_init = 0.8f - 0.6f * expf(-0.3f * (float)l);
    float lam;
    { float d1 = 0.f, d2 = 0.f; const float* q1 = p.in[I_LQ1] + l * 128; const float* k1 = p.in[I_LK1] + l * 128; const float* q2 = p.in[I_LQ2] + l * 128; const float* k2 = p.in[I_LK2] + l * 128;
      for (int i = 0; i < 128; ++i) { d1 += q1[i] * k1[i]; d2 += q2[i] * k2[i]; } lam = expf(d1) - expf(d2) + lam_init; }
    LAS float* lamv = (LAS float*)(lds + AT_FLAG + 64);
    __syncthreads();
    if (tid == 0) { lamv[0] = lam; lamv[1] = 1.0f - lam_init; }
    const float* subw = p.in[I_SUBLN] + l * 256;
    constexpr int NQB = SEQ / 128, NBH = NB * HA, NU_P = NBH * NQB, NU = NU_P + DB * HA;
    const float sc = 0.08838834764831845f * 1.44269504089f;
    if (wid >= 4) __builtin_amdgcn_s_setprio(1);
    int qx = (int)(MY_XCC_ID() & 7u), tries = 0; bool sample_list = true;
    for (;;) {
        const bool dummy = false;
        int kk;
        if (sample_list) { kk = queue_next(qctr, qslot); if (kk >= NU - NU_P) { sample_list = false; continue; } }
        else { kk = xcd_queue_next(qctr + 64, NBH, NQB, qx, tries, qslot); if (kk < 0) break; }
        int lane = lane_; OPAQUE(lane);
        const int r = lane & 31, hh = lane >> 5;
        const LaneOffs LO = make_lane_offs(lane);
        const bool sample = __builtin_amdgcn_readfirstlane((int)sample_list) != 0;
        int b, h, qb; size_t qrow0;
        if (!sample) { const int cnt = (NBH - qx + 7) / 8; qb = NQB - 1 - kk / cnt; const int bh = qx + 8 * (kk % cnt); h = bh % HA; b = bh / HA; qrow0 = (size_t)b * SEQ + qb * 128; }
        else { h = kk % HA; b = kk / HA; qb = 0; qrow0 = (size_t)MP + (size_t)b * DSEQ; }
        b = __builtin_amdgcn_readfirstlane(b); h = __builtin_amdgcn_readfirstlane(h); qb = __builtin_amdgcn_readfirstlane(qb);
        qrow0 = sample ? (size_t)MP + (size_t)b * DSEQ : (size_t)b * SEQ + qb * 128;
        const int nq = sample ? 32 : 128;
        __syncthreads();
        stage_rows<false>(lds, QA + qrow0 * D + (2 * h) * 128, D, nq, nq);
        stage_rows<false>(lds + 32768, QA + qrow0 * D + (2 * h + 1) * 128, D, nq, nq);
        f32x16 O[8];
#pragma unroll
        for (int i = 0; i < 8; ++i) O[i] = zero16();
        float m = -1e30f, lsum = 0.f;
        const bool wave_on = sample ? (rg == 0) : true;
        const LAS unsigned char* Qw = lds + c * 32768 + rg * 8192;
        __syncthreads();
        bf16x8 qreg[8];
#pragma unroll
        for (int ks = 0; ks < 8; ++ks) qreg[ks] = lds_frag_row(Qw, LO, ks);
        __syncthreads();
        const int img = wid >> 1, rbase = 32 * (wid & 1) + (lane >> 4);
        const bf16_t* src = (img < 2 ? KA + (size_t)(2 * h + img) * 128 : VA + (size_t)h * 256 + (size_t)(img - 2) * 128) + (size_t)b * SEQ * D;
        const unsigned srow = (unsigned)(rbase * D * 2), cx = (unsigned)((lane & 15) ^ (((lane >> 4) & 3) << 2));
#define ATT_SOFF(i) (srow_ + (unsigned)((i) * 4 * D * 2) + 16u * (cx_ ^ (unsigned)((i) & 3)))
        const int ntile = sample ? PAST / 64 + 1 : 2 * qb + 2;
        const unsigned ldst = (unsigned)(img * 16384 + (wid & 1) * 8192);
        const char* gnext = (const char*)src;
#define ATT_ISSUE(t) do { LAS unsigned char* d_ = lds + ((t) & 1) * 65536 + ldst; unsigned srow_ = srow, cx_ = cx; OPAQUE(srow_); OPAQUE(cx_);   \
        _Pragma("unroll") for (int i_ = 0; i_ < 8; ++i_) GLDS16(gnext + ATT_SOFF(i_), d_ + i_ * 1024); gnext += (size_t)64 * D * 2; } while (0)
        if (!sample && !dummy) ATT_ISSUE(0);
        for (int t = 0; t < ntile; ++t) {
            LAS unsigned char* stg = lds + (t & 1) * 65536;
            int nvalid = 64; bool vis, dma = false;
            if (!sample) {
                if (t == 2 * qb + 1) { ASM_WAIT_VM(16); ASM_WAIT_LGKM(0); }
                else ASM_WAIT_ALL0();
                __builtin_amdgcn_s_barrier();
                vis = t <= 2 * qb + (rg >> 1);
                dma = t + 1 < ntile && !dummy;
            } else {
                __syncthreads();
                if (t < PAST / 64) { const size_t kr = ((size_t)(l * DB + b) * PAST + (size_t)t * 64) * D;
                    stage_rows<true>(stg, p.in[I_CAK] + kr + (2 * h) * 128, D, 64, 64); stage_rows<true>(stg + 16384, p.in[I_CAK] + kr + (2 * h + 1) * 128, D, 64, 64);
                    stage_rows<true>(stg + 32768, p.in[I_CAV] + kr + h * 256, D, 64, 64); stage_rows<true>(stg + 49152, p.in[I_CAV] + kr + h * 256 + 128, D, 64, 64); }
                else { nvalid = DSEQ; const size_t kr = (size_t)MP + (size_t)b * DSEQ;
                    stage_rows<false>(stg, KA + kr * D + (2 * h) * 128, D, 64, DSEQ); stage_rows<false>(stg + 16384, KA + kr * D + (2 * h + 1) * 128, D, 64, DSEQ);
                    stage_rows<false>(stg + 32768, VA + kr * D + h * 256, D, 64, DSEQ); stage_rows<false>(stg + 49152, VA + kr * D + h * 256 + 128, D, 64, DSEQ); }
                __syncthreads();
                vis = wave_on;
            }
            if (vis) attn_a_tile(stg + c * 16384, stg + 32768, qreg, lane, nvalid, sc, O, m, lsum, dma, gnext, lds + ((t + 1) & 1) * 65536 + ldst, srow, cx);
            else if (dma) { ATT_ISSUE(t + 1); gnext -= (size_t)64 * D * 2; }
            if (dma) gnext += (size_t)64 * D * 2;
            if (!sample && t >= 2 * qb && !dummy) { float* ob_ = p.out + ((size_t)(l * NB + b) * SEQ + (size_t)t * 64) * D;
                cache_store_tile(stg, ob_ + O_PAK + (2 * h) * 128, ob_ + O_PAV + h * 256); }
        }
#undef ATT_ISSUE
#undef ATT_SOFF
        const float inv_l = fast_rcp(lsum + __shfl_xor(lsum, 32));
#pragma unroll
        for (int d = 0; d < 8; ++d)
#pragma unroll
            for (int i = 0; i < 16; ++i) O[d][i] *= inv_l;
        LAS float* X = (LAS float*)(lds + AT_X);
#pragma unroll
        for (int hv = 0; hv < 2; ++hv) {
            __syncthreads();
            if (c == 1) {
#pragma unroll
                for (int d = 0; d < 4; ++d)
#pragma unroll
                    for (int i = 0; i < 16; ++i) X[((rg * 64) + d * 16 + i) * 64 + lane] = O[4 * hv + d][i]; }
            __syncthreads();
            if (c == 0) {
#pragma unroll
                for (int d = 0; d < 4; ++d)
#pragma unroll
                    for (int i = 0; i < 16; ++i) O[4 * hv + d][i] -= lamv[0] * X[((rg * 64) + d * 16 + i) * 64 + lane]; }
        }
        if (c == 0 && wave_on) {
            float ss = 0.f;
#pragma unroll
            for (int d = 0; d < 8; ++d)
#pragma unroll
                for (int i = 0; i < 16; ++i) ss += O[d][i] * O[d][i];
            ss += __shfl_xor(ss, 32);
            const float rstd = __builtin_amdgcn_rsqf(ss * (1.0f / 256.0f) + EPS) * lamv[1];
            int qi = 32 * rg + r; OPAQUE(qi);
            if ((!sample || qi < DSEQ) && !dummy) {
                bf16_t* dst = OA + (qrow0 + qi) * D + h * 256;
#pragma unroll
                for (int d = 0; d < 8; ++d)
#pragma unroll
                    for (int g4 = 0; g4 < 4; ++g4) { const int dv = 32 * d + 8 * g4 + 4 * hh; const f32x4 w = *(const f32x4*)(subw + dv);
                        u32x2 o; o.x = cvt_pk_bf16(O[d][4 * g4] * rstd * w[0], O[d][4 * g4 + 1] * rstd * w[1]); o.y = cvt_pk_bf16(O[d][4 * g4 + 2] * rstd * w[2], O[d][4 * g4 + 3] * rstd * w[3]);
                        *(u32x2*)(dst + dv) = o; }
            }
        }
    }
    __builtin_amdgcn_s_setprio(0);
}

DI void phase_attn_c(const Params& p, int l, LAS unsigned char* lds, unsigned* qctr, volatile LAS unsigned* qslot) {
    int tid = threadIdx.x; OPAQUE(tid);
    const int lane_ = tid & 63, wid = __builtin_amdgcn_readfirstlane(tid >> 6), hsel = wid >> 2, rg = wid & 3;
    unsigned char* ws = p.ws;
    const bf16_t* QC = (const bf16_t*)(ws + WS_QC); const bf16_t* KC = (const bf16_t*)(ws + WS_KC); const bf16_t* VC = (const bf16_t*)(ws + WS_VC);
    bf16_t* OC = (bf16_t*)(ws + WS_OC);
    constexpr int NQB = SEQ / 128, NHP = HC / 2, NU_P = NB * NHP * NQB, NU = NU_P + DB * NHP;
    volatile LAS unsigned* flags = (volatile LAS unsigned*)(lds + AT_FLAG);
    constexpr int NBHP = NB * NHP;
    int qx = (int)(MY_XCC_ID() & 7u), tries = 0; bool sample_list = true;
    for (;;) {
        int u;
        if (sample_list) { u = queue_next(qctr, qslot); if (u >= NU - NU_P) { sample_list = false; continue; } }
        else { u = xcd_queue_next(qctr + 64, NBHP, NQB, qx, tries, qslot); if (u < 0) break; }
        int lane = lane_; OPAQUE(lane);
        const int r = lane & 31, hh = lane >> 5;
        const LaneOffs LO = make_lane_offs(lane);
        const bool sample = __builtin_amdgcn_readfirstlane((int)sample_list) != 0;
        int b, hp, qb, jtop; int pos0;
        if (!sample) { const int cnt = (NBHP - qx + 7) / 8; qb = NQB - 1 - u / cnt; const int bh = qx + 8 * (u % cnt); hp = bh % NHP; b = bh / NHP; jtop = 2 * qb + 1; pos0 = qb * 128; }
        else { hp = u % NHP; b = u / NHP; qb = 0; jtop = PAST / 64; pos0 = PAST; }
        b = __builtin_amdgcn_readfirstlane(b); hp = __builtin_amdgcn_readfirstlane(hp); qb = __builtin_amdgcn_readfirstlane(qb); jtop = __builtin_amdgcn_readfirstlane(jtop); pos0 = __builtin_amdgcn_readfirstlane(pos0);
        const size_t qrow0 = sample ? (size_t)MP + (size_t)b * DSEQ : (size_t)b * SEQ + qb * 128;
        const int h = 2 * hp + hsel;
        const int nq = sample ? 32 : 128;
        __syncthreads();
        stage_rows<false>(lds, QC + qrow0 * D + (2 * hp) * 128, D, nq, nq);
        stage_rows<false>(lds + 32768, QC + qrow0 * D + (2 * hp + 1) * 128, D, nq, nq);
        if (tid < 8) flags[tid] = 0u;
        f32x16 O[4];
#pragma unroll
        for (int i = 0; i < 4; ++i) O[i] = zero16();
        float run = 0.f;
        const bool wave_on = sample ? (rg == 0) : true;
        bool wdone = !wave_on;
        const int tq = pos0 + 32 * rg + r;
        __syncthreads();
        bf16x8 qreg[8];
#pragma unroll
        for (int ks = 0; ks < 8; ++ks) qreg[ks] = lds_frag_row(lds + hsel * 32768 + rg * 8192, LO, ks);
        __syncthreads();
        const int img = wid >> 1, rbase = 32 * (wid & 1) + (lane >> 4);
        const bf16_t* src = (img < 2 ? KC + (size_t)(2 * hp + img) * 128 : VC + (size_t)(2 * hp + img - 2) * 128) + (size_t)b * SEQ * D;
        const unsigned srow = (unsigned)(rbase * D * 2), cx = (unsigned)((lane & 15) ^ (((lane >> 4) & 3) << 2));
        const unsigned ldst = (unsigned)(img * 16384 + (wid & 1) * 8192);
        const char* gnext = (const char*)src + (size_t)jtop * 64 * D * 2;
#define STK_ISSUE(st_) do { LAS unsigned char* d_ = lds + (st_) * 65536 + ldst; unsigned srow_ = srow, cx_ = cx; OPAQUE(srow_); OPAQUE(cx_); \
        _Pragma("unroll") for (int i_ = 0; i_ < 8; ++i_) GLDS16(gnext + (srow_ + (unsigned)(i_ * 4 * D * 2) + 16u * (cx_ ^ (unsigned)(i_ & 3))), d_ + i_ * 1024); gnext -= (size_t)64 * D * 2; } while (0)
        int st = 0;
        if (!sample) STK_ISSUE(0);
        for (int j = jtop; j >= 0; --j) {
            if (!sample) { ASM_WAIT_ALL0(); __builtin_amdgcn_s_barrier(); }
            else __syncthreads();
            { unsigned alld = 1u;
#pragma unroll
              for (int w = 0; w < 8; ++w) alld &= flags[w];
              if (alld) break; }
            LAS unsigned char* stg = lds + st * 65536;
            int nvalid = 64; const int kpos0 = j * 64;
            const bool dmac = !sample && j > 0;
            if (sample) {}
            if (sample) {
                if (j < PAST / 64) { const size_t kr = ((size_t)(l * DB + b) * PAST + (size_t)j * 64) * D;
                    stage_rows<true>(stg, p.in[I_CCK] + kr + (2 * hp) * 128, D, 64, 64); stage_rows<true>(stg + 16384, p.in[I_CCK] + kr + (2 * hp + 1) * 128, D, 64, 64);
                    stage_rows<true>(stg + 32768, p.in[I_CCV] + kr + (2 * hp) * 128, D, 64, 64); stage_rows<true>(stg + 49152, p.in[I_CCV] + kr + (2 * hp + 1) * 128, D, 64, 64); }
                else { nvalid = DSEQ; const size_t kr = (size_t)MP + (size_t)b * DSEQ;
                    stage_rows<false>(stg, KC + kr * D + (2 * hp) * 128, D, 64, DSEQ); stage_rows<false>(stg + 16384, KC + kr * D + (2 * hp + 1) * 128, D, 64, DSEQ);
                    stage_rows<false>(stg + 32768, VC + kr * D + (2 * hp) * 128, D, 64, DSEQ); stage_rows<false>(stg + 49152, VC + kr * D + (2 * hp + 1) * 128, D, 64, DSEQ); }
                __syncthreads();
            }
            const bool need = kpos0 < pos0 + 32 * rg + 31;
            if (dmac && !(!wdone && need)) STK_ISSUE(st ^ 1);
            if (!wdone && need) {
                LAS unsigned char* dd_ = lds + (st ^ 1) * 65536 + ldst;
                int lane2 = lane; OPAQUE(lane2); const LaneOffs L2 = make_lane_offs(lane2);
                const LAS unsigned char* Ki = stg + hsel * 16384; const LAS unsigned char* Vi = stg + 32768 + hsel * 16384;
                f32x16 s[2]; s[0] = zero16(); s[1] = zero16();
                {
                    bf16x8 kb0[2], kb1[2];
#pragma unroll
                    for (int jj = 0; jj < 2; ++jj) { kb0[jj] = lds_frag_row(Ki, L2, jj); kb1[jj] = lds_frag_row(Ki + 8192, L2, jj); }
#pragma unroll
                    for (int ks = 0; ks < 8; ++ks) {
                        const bf16x8 a0 = kb0[ks & 1], a1 = kb1[ks & 1];
                        if (ks + 2 < 8) { kb0[ks & 1] = lds_frag_row(Ki, L2, ks + 2); kb1[ks & 1] = lds_frag_row(Ki + 8192, L2, ks + 2); }
                        s[0] = MFMA32(a0, qreg[ks], s[0]); s[1] = MFMA32(a1, qreg[ks], s[1]);
                        if (dmac) { unsigned srow_ = srow, cx_ = cx; OPAQUE(srow_); OPAQUE(cx_); GLDS16(gnext + (srow_ + (unsigned)(ks * 4 * D * 2) + 16u * (cx_ ^ (unsigned)(ks & 3))), dd_ + ks * 1024); }
                        __builtin_amdgcn_sched_barrier(0);
                    }
                }
                if (dmac) gnext -= (size_t)64 * D * 2;
                bf16x8 vf[3];
#pragma unroll
                for (int jj = 0; jj < 3; ++jj) { s16x4 a_, b_; TR_ISSUE(a_, Vi, L2.ta0[jj & 3], 0); TR_ISSUE_X32(b_, Vi, L2.ta0[jj & 3], 2048); vf[jj] = __builtin_shufflevector(a_, b_, 0, 1, 2, 3, 4, 5, 6, 7); }
                __builtin_amdgcn_sched_barrier(0);
                float gs[8];
#pragma unroll
                for (int kb = 0; kb < 2; ++kb)
#pragma unroll
                    for (int q2 = 0; q2 < 4; ++q2) { float lm[4], lb[4];
#pragma unroll
                        for (int e = 0; e < 4; ++e) { const int key = 32 * kb + 8 * q2 + 4 * hh + e; const float z = s[kb][4 * q2 + e] * 0.08838834764831845f;
                            const float sp = fmaxf(z, 0.f) + 0.69314718056f * __builtin_amdgcn_logf(1.0f + fast_exp(-fabsf(z)));
                            const bool ok = (kpos0 + key < tq) && (key < nvalid);
                            lm[e] = ok ? -sp : 0.f; lb[e] = ok ? z - sp : -1e30f; }
                        const float t3 = 0.f, t2 = lm[3], t1 = t2 + lm[2], t0 = t1 + lm[1];
                        gs[4 * kb + q2] = t0 + lm[0];
                        s[kb][4 * q2 + 0] = lb[0] + t0; s[kb][4 * q2 + 1] = lb[1] + t1; s[kb][4 * q2 + 2] = lb[2] + t2; s[kb][4 * q2 + 3] = lb[3] + t3; }
                float pg[8], T[8];
#pragma unroll
                for (int k = 0; k < 8; ++k) { float r0_, r1_; swap32(gs[k], r0_, r1_); pg[k] = r1_; T[k] = r0_ + r1_; }
                float off[8]; float accp = run;
#pragma unroll
                for (int k = 7; k >= 0; --k) { off[k] = accp + (hh == 0 ? pg[k] : 0.f); accp += T[k]; }
                run = accp;
#pragma unroll
                for (int i = 0; i < 16; ++i) s[0][i] = fast_exp(s[0][i] + off[i >> 2]);
                bf16x8 pb[4]; pb[0] = pack8(s[0], 0); pb[1] = pack8(s[0], 1);
                __builtin_amdgcn_sched_barrier(0);
                bf16x8 cur = vf[0];
                TR_WAITN(4, cur);
#pragma unroll
                for (int idx = 0; idx < 16; ++idx) { const int s2 = idx >> 2, d = idx & 3, slot = idx % 3;
                    bf16x8 nxt = cur;
                    if (idx + 1 < 16) { nxt = vf[(idx + 1) % 3]; if (idx + 2 < 16) TR_WAITN(2, nxt); else TR_WAITN(0, nxt); }
                    O[d] = MFMA32(cur, pb[s2], O[d]);
                    if (idx + 3 < 16) { const int j2 = idx + 3, js2 = j2 >> 2, jd = j2 & 3; s16x4 a_, b_;
                        TR_ISSUE(a_, Vi, L2.ta0[jd], js2 * 4096); TR_ISSUE_X32(b_, Vi, L2.ta0[jd], js2 * 4096 + 2048);
                        vf[slot] = __builtin_shufflevector(a_, b_, 0, 1, 2, 3, 4, 5, 6, 7); }
                    cur = nxt;
                    if (idx < 8) { s[1][2 * idx] = fast_exp(s[1][2 * idx] + off[4 + ((2 * idx) >> 2)]); s[1][2 * idx + 1] = fast_exp(s[1][2 * idx + 1] + off[4 + ((2 * idx + 1) >> 2)]); }
                    if (idx == 7) { pb[2] = pack8(s[1], 0); pb[3] = pack8(s[1], 1); }
                    __builtin_amdgcn_sched_barrier(0);
                }
                wdone = __all(run < -110.0f) != 0;
            }
            if (j == 0) wdone = true;
            if (lane == 0) flags[wid] = wdone ? 1u : 0u;
            st ^= 1;
        }
#undef STK_ISSUE
        if (wave_on) { int qi = 32 * rg + r; OPAQUE(qi);
            if (!sample || qi < DSEQ) { bf16_t* dst = OC + (qrow0 + qi) * D + h * 128;
#pragma unroll
                for (int d = 0; d < 4; ++d)
#pragma unroll
                    for (int g4 = 0; g4 < 4; ++g4) { const int dv = 32 * d + 8 * g4 + 4 * hh;
                        u32x2 o; o.x = cvt_pk_bf16(O[d][4 * g4], O[d][4 * g4 + 1]); o.y = cvt_pk_bf16(O[d][4 * g4 + 2], O[d][4 * g4 + 3]); *(u32x2*)(dst + dv) = o; } } }
    }
}
DI void phase_merge(const Params& p, int l, LAS unsigned char* lds) {
    int tid = threadIdx.x; OPAQUE(tid);
    const int lane = tid & 63, wid = tid >> 6;
    unsigned char* ws = p.ws;
    const bf16_t* OA = (const bf16_t*)(ws + WS_OA); const bf16_t* OC = (const bf16_t*)(ws + WS_OC); const bf16_t* OBR = (const bf16_t*)(ws + WS_OBUF);
    const bf16_t* BZ = (const bf16_t*)(ws + WS_BZ); const bf16_t* GT = (const bf16_t*)(ws + WS_GATES); bf16_t* XB = (bf16_t*)(ws + WS_XB);
    const float* gw = p.in[I_GDNW] + l * 128;
    constexpr int NROW = MP + MS, NH = (D + 511) / 512;
    struct MergeIn { u32x4 oa, oc, ob, bz, g0, g1, g2; };
#define MERGE_LOAD(dst, rr_) do { const size_t row_ = (rr_); \
        const size_t brow_ = (rr_) < MP ? (size_t)(rr_) : (size_t)MP + (size_t)(((rr_) - MP) / DSEQ) * 64 + ((rr_) - MP) % DSEQ;   \
        _Pragma("unroll") for (int hf_ = 0; hf_ < NH; ++hf_) { const int cu_ = hf_ * 512 + lane * 8; const int c_ = cu_ < D ? cu_ : 0; \
            dst[hf_].oa = *(const u32x4*)(OA + row_ * D + c_); dst[hf_].oc = *(const u32x4*)(OC + row_ * D + c_); dst[hf_].ob = *(const u32x4*)(OBR + brow_ * D + c_); dst[hf_].bz = *(const u32x4*)(BZ + row_ * D + c_); \
            dst[hf_].g0 = *(const u32x4*)(GT + row_ * 3 * D + c_); dst[hf_].g1 = *(const u32x4*)(GT + row_ * 3 * D + D + c_); dst[hf_].g2 = *(const u32x4*)(GT + row_ * 3 * D + 2 * D + c_); } } while (0)
    const int stride = gridDim.x * 8;
    int rr = blockIdx.x * 8 + wid;
    MergeIn cur[NH];
    if (rr < NROW) MERGE_LOAD(cur, rr);
    for (; rr < NROW; rr += stride) {
        const size_t row = rr;
        MergeIn nxt[NH];
#pragma unroll
        for (int hf = 0; hf < NH; ++hf) nxt[hf] = cur[hf];
        if (rr + stride < NROW) MERGE_LOAD(nxt, rr + stride);
#pragma unroll
        for (int hf = 0; hf < NH; ++hf) {
            const int cu = hf * 512 + lane * 8; const bool cok = cu < D; const int c = cok ? cu : 0;
            const u32x4 oa = cur[hf].oa, oc = cur[hf].oc, ob = cur[hf].ob, bz = cur[hf].bz, g0 = cur[hf].g0, g1 = cur[hf].g1, g2 = cur[hf].g2;
            float o[8]; float ss = 0.f;
#pragma unroll
            for (int e = 0; e < 4; ++e) { o[2 * e] = bf_lo(ob[e]); o[2 * e + 1] = bf_hi(ob[e]); ss += o[2 * e] * o[2 * e] + o[2 * e + 1] * o[2 * e + 1]; }
            ss += __shfl_xor(ss, 1); ss += __shfl_xor(ss, 2); ss += __shfl_xor(ss, 4); ss += __shfl_xor(ss, 8);
            const float rstd = __builtin_amdgcn_rsqf(ss * (1.0f / 128.0f) + EPS);
            const f32x4 w0 = *(const f32x4*)(gw + (c & 127)), w1 = *(const f32x4*)(gw + (c & 127) + 4);
            float mg[8];
#pragma unroll
            for (int e = 0; e < 8; ++e) { const unsigned ua = oa[e >> 1], uc = oc[e >> 1], uz = bz[e >> 1], u0 = g0[e >> 1], u1 = g1[e >> 1], u2 = g2[e >> 1];
                const float a = (e & 1) ? bf_hi(ua) : bf_lo(ua), cc = (e & 1) ? bf_hi(uc) : bf_lo(uc), z = (e & 1) ? bf_hi(uz) : bf_lo(uz);
                const float ga = sigmoidf_((e & 1) ? bf_hi(u0) : bf_lo(u0)), gbv = sigmoidf_((e & 1) ? bf_hi(u1) : bf_lo(u1)), gc = sigmoidf_((e & 1) ? bf_hi(u2) : bf_lo(u2));
                const float w = e < 4 ? w0[e] : w1[e - 4];
                const float obn = o[e] * rstd * w * (z * sigmoidf_(z));
                mg[e] = ga * a + gbv * obn + gc * cc; }
            u32x4 wv; wv.x = cvt_pk_bf16(mg[0], mg[1]); wv.y = cvt_pk_bf16(mg[2], mg[3]); wv.z = cvt_pk_bf16(mg[4], mg[5]); wv.w = cvt_pk_bf16(mg[6], mg[7]);
            if (cok) *(u32x4*)(XB + row * D + c) = wv;
        }
#pragma unroll
        for (int hf = 0; hf < NH; ++hf) cur[hf] = nxt[hf];
    }
#undef MERGE_LOAD
}

DI void phase_rstd(const float* ssp, float* rstd, int row_end) {
    int tid = threadIdx.x; OPAQUE(tid);
    for (int row = blockIdx.x * 512 + tid; row < row_end; row += gridDim.x * 512) {
        float ss = 0.f;
#pragma unroll
        for (int j = 0; j < NPART; j += 4) { const f32x4 q = *(const f32x4*)(ssp + (size_t)row * NPART + j); ss += (q[0] + q[1]) + (q[2] + q[3]); }
        rstd[row] = __builtin_amdgcn_rsqf(ss * (1.0f / D) + EPS);
    }
}

struct EpiResid {
    static constexpr bool PERM = false;
    const float* xin_p; const float* xin_s; float* xout_p; float* xout_s; bf16_t* xb; float* ssp; float* part;
    DI void operator()(const f32x4 (&acc)[2][2][4][2], const pg8::Unit& u, int wr, int wc, int fr_, int fq_, const LAS float*) const {
        int fr = fr_, fq = fq_; OPAQUE(fr); OPAQUE(fq);
        if (u.slice >= 0) {
            float* base = part + (size_t)u.slice * 256 * D;
#pragma unroll
            for (int ai = 0; ai < 2; ++ai)
#pragma unroll
                for (int m = 0; m < 4; ++m) { const int r = ai * 128 + wr * 64 + m * 16 + fr;
                    if (r < MS) {
#pragma unroll
                        for (int bj = 0; bj < 2; ++bj)
#pragma unroll
                            for (int n = 0; n < 2; ++n) *(f32x4*)(base + (size_t)r * D + u.pn * 256 + bj * 128 + wc * 32 + n * 16 + fq * 4) = acc[ai][bj][m][n]; }
                    COMPILER_FENCE(); }
            return;
        }
        const bool sample = u.pm >= MP / 256;
#pragma unroll
        for (int ai = 0; ai < 2; ++ai)
#pragma unroll
            for (int m = 0; m < 4; ++m) {
                const int row = u.pm * 256 + ai * 128 + wr * 64 + m * 16 + fr;
                const bool valid = !sample || (row - MP) < MS;
                const float* xi = sample ? xin_s + (size_t)(row - MP) * D : xin_p + (size_t)row * D;
                float* xo = sample ? xout_s + (size_t)(row - MP) * D : xout_p + (size_t)row * D;
                float ss = 0.f;
#pragma unroll
                for (int bj = 0; bj < 2; ++bj)
#pragma unroll
                    for (int n = 0; n < 2; ++n) { const int c = u.pn * 256 + bj * 128 + wc * 32 + n * 16 + fq * 4;
                        if (valid) { const f32x4 v = *(const f32x4*)(xi + c) + acc[ai][bj][m][n]; *(f32x4*)(xo + c) = v;
                            u32x2 w; w.x = cvt_pk_bf16(v[0], v[1]); w.y = cvt_pk_bf16(v[2], v[3]); *(u32x2*)(xb + (size_t)row * D + c) = w;
                            ss += (v[0] * v[0] + v[1] * v[1]) + (v[2] * v[2] + v[3] * v[3]); } }
                ss += __shfl_xor(ss, 16); ss += __shfl_xor(ss, 32);
                if (valid && fq == 0) ssp[(size_t)row * NPART + u.pn * 4 + wc] = ss;
                if (m == 3) COMPILER_FENCE();
            }
    }
};
DI void sample_reduce(const float* part, int nS, const float* xin_s, float* xout_s, bf16_t* xb, float* rstd, const float* fnw) {
    int tid = threadIdx.x; OPAQUE(tid);
    const int lane = tid & 63, wid = tid >> 6;
    for (int r = blockIdx.x * 8 + wid; r < MS; r += gridDim.x * 8) {
        f32x4 v[D / 256]; float ss = 0.f;
#pragma unroll
        for (int i = 0; i < D / 256; ++i) { const int c = i * 256 + lane * 4;
            f32x4 a = *(const f32x4*)(xin_s + (size_t)r * D + c);
            for (int s = 0; s < nS; ++s) a += *(const f32x4*)(part + ((size_t)s * 256 + r) * D + c);
            v[i] = a; ss += a[0] * a[0] + a[1] * a[1] + a[2] * a[2] + a[3] * a[3]; }
#pragma unroll
        for (int o = 1; o < 64; o <<= 1) ss += __shfl_xor(ss, o);
        const float rs = __builtin_amdgcn_rsqf(ss * (1.0f / D) + EPS);
        if (!fnw && lane == 0) rstd[MP + r] = rs;
#pragma unroll
        for (int i = 0; i < D / 256; ++i) { const int c = i * 256 + lane * 4;
            if (fnw) { *(f32x4*)(xout_s + (size_t)r * D + c) = v[i] * rs * *(const f32x4*)(fnw + c); }
            else { *(f32x4*)(xout_s + (size_t)r * D + c) = v[i];
                u32x2 w; w.x = cvt_pk_bf16(v[i][0], v[i][1]); w.y = cvt_pk_bf16(v[i][2], v[i][3]); *(u32x2*)(xb + (size_t)(MP + r) * D + c) = w; } }
    }
}
struct EpiUp {
    static constexpr bool PERM = true;
    bf16_t* hid; float* part;
    DI void operator()(const f32x4 (&acc)[2][2][4][2], const pg8::Unit& u, int wr, int wc, int fr_, int fq_, const LAS float* rs_lds) const {
        int fr = fr_, fq = fq_; OPAQUE(fr); OPAQUE(fq);
        const bool sample = u.pm >= MP / 256;
        if (u.slice >= 0) {
            float* base = part + (size_t)u.slice * 256 * DFF;
#pragma unroll
            for (int ai = 0; ai < 2; ++ai)
#pragma unroll
                for (int m = 0; m < 4; ++m) { const int r = ai * 128 + wr * 64 + m * 16 + fr;
                    if (r < MS) {
#pragma unroll
                        for (int bj = 0; bj < 2; ++bj) { float* o = base + (size_t)r * DFF + u.pn * 256 + wc * 64 + bj * 32 + fq * 8; *(f32x4*)o = acc[ai][bj][m][0]; *(f32x4*)(o + 4) = acc[ai][bj][m][1]; } }
                    COMPILER_FENCE(); }
            return;
        }
#pragma unroll
        for (int ai = 0; ai < 2; ++ai)
#pragma unroll
            for (int m = 0; m < 4; ++m) {
                const int row = u.pm * 256 + ai * 128 + wr * 64 + m * 16 + fr;
                if (sample && (row - MP) >= MS) continue;
                const float rs = rs_lds[ai * 128 + wr * 64 + m * 16 + fr];
#pragma unroll
                for (int bj = 0; bj < 2; ++bj) { f32x4 a = acc[ai][bj][m][0] * rs, b = acc[ai][bj][m][1] * rs;
#pragma unroll
                    for (int e = 0; e < 4; ++e) { const float x = fmaxf(a[e], 0.f), y = fmaxf(b[e], 0.f); a[e] = x * x; b[e] = y * y; }
                    u32x4 w; w.x = cvt_pk_bf16(a[0], a[1]); w.y = cvt_pk_bf16(a[2], a[3]); w.z = cvt_pk_bf16(b[0], b[1]); w.w = cvt_pk_bf16(b[2], b[3]);
                    *(u32x4*)(hid + (size_t)row * DFF + u.pn * 256 + wc * 64 + bj * 32 + fq * 8) = w; }
            }
    }
};

DI void sample_up_reduce(const float* part, int nS, const float* rstd_mid, bf16_t* hid) {
    int tid = threadIdx.x; OPAQUE(tid);
    for (int i = blockIdx.x * 512 + tid; i < MS * (DFF / 8); i += gridDim.x * 512) { const int r = i / (DFF / 8), c = (i % (DFF / 8)) * 8;
        f32x4 a = (f32x4){0.f, 0.f, 0.f, 0.f}, b = a;
        for (int s = 0; s < nS; ++s) { const float* q = part + ((size_t)s * 256 + r) * DFF + c; a += *(const f32x4*)q; b += *(const f32x4*)(q + 4); }
        const float rs = rstd_mid[MP + r];
#pragma unroll
        for (int e = 0; e < 4; ++e) { const float x = fmaxf(a[e] * rs, 0.f), y = fmaxf(b[e] * rs, 0.f); a[e] = x * x; b[e] = y * y; }
        u32x4 w; w.x = cvt_pk_bf16(a[0], a[1]); w.y = cvt_pk_bf16(a[2], a[3]); w.z = cvt_pk_bf16(b[0], b[1]); w.w = cvt_pk_bf16(b[2], b[3]);
        *(u32x4*)(hid + (size_t)(MP + r) * DFF + c) = w; }
}

DI void phase_final(const Params& p, LAS unsigned char* lds) {
    int tid = threadIdx.x; OPAQUE(tid);
    const int lane = tid & 63, wid = tid >> 6;
    const float* ssp = (const float*)(p.ws + WS_SSP); const float* fw = p.in[I_FNW];
    for (int rr = blockIdx.x * 8 + wid; rr < MP; rr += gridDim.x * 8) {
        float* x = p.out + O_YP + (size_t)rr * D;
        float ss = 0.f;
#pragma unroll
        for (int j = 0; j < NPART; ++j) ss += ssp[(size_t)rr * NPART + j];
        const float rs = __builtin_amdgcn_rsqf(ss * (1.0f / D) + EPS);
        for (int c = lane * 4; c < D; c += 256) { const f32x4 v = *(const f32x4*)(x + c), w = *(const f32x4*)(fw + c); *(f32x4*)(x + c) = v * rs * w; }
    }
}

struct EpiNull {
    static constexpr bool PERM = true;
    float* sink;
    DI void operator()(const f32x4 (&acc)[2][2][4][2], const pg8::Unit& u, int wr, int wc, int fr, int fq, const LAS float*) const {
        float t = 0.f;
#pragma unroll
        for (int ai = 0; ai < 2; ++ai)
#pragma unroll
            for (int bj = 0; bj < 2; ++bj)
#pragma unroll
                for (int m = 0; m < 4; ++m)
#pragma unroll
                    for (int n = 0; n < 2; ++n) t += acc[ai][bj][m][n][0] + acc[ai][bj][m][n][1] + acc[ai][bj][m][n][2] + acc[ai][bj][m][n][3];
        if (t == 123.456f) sink[0] = t;
    }
};
constexpr int LDS_BYTES = 147456;
constexpr int LDS_MISC = 147456 - 256;
constexpr int PH_PER_LAYER = 11;
constexpr int N_PHASES = 1 + DEPTH * PH_PER_LAYER + 1;

__global__ void __launch_bounds__(512, 2) fwd_kernel(Params p) {
#ifdef EMU
    LAS unsigned char* lds = EMU_SMEM();
#else
    extern __shared__ __attribute__((aligned(16))) unsigned char lds_raw[];
    LAS unsigned char* lds = (LAS unsigned char*)lds_raw;
#endif
    volatile LAS unsigned* misc = (volatile LAS unsigned*)(lds + LDS_MISC);
    if (threadIdx.x < 16) misc[threadIdx.x] = 0u;
    __syncthreads();
    const int lo = p.ph_lo, hi = p.ph_hi;
    XcdBarrier bar; bar.bar = (unsigned*)(p.ws + WS_BAR); bar.x = 0; bar.st = misc;
    if (hi - lo > 1) bar = xcd_barrier_post((unsigned*)(p.ws + WS_BAR), misc);
#ifndef ONLY_KIND
#define ONLY_KIND -1
#endif
#define PHK(kind) (ONLY_KIND < 0 || ONLY_KIND == (kind))
#ifndef REPEAT_KIND
#define REPEAT_KIND -1
#endif
#define NREP(kind) ((REPEAT_KIND == (kind) && l == 0) ? 2 : 1)
#define IN(k) (lo <= (k) && (k) < hi)
#ifdef PROBE_KIND
#define STAMP(k) do { if (blockIdx.x == 0 && threadIdx.x == 0) ((unsigned long long*)(p.ws + WS_STAMP))[(k)] = __builtin_amdgcn_s_memrealtime(); } while (0)
#else
#define STAMP(k) ((void)0)
#endif
#define SEAM(k) do { if (IN(k) && IN((k) + 1)) xcd_barrier(bar); STAMP((k) + 1); } while (0)
    unsigned char* ws = p.ws;
    STAMP(0);
    if (PHK(100) && IN(0)) { phase_prologue(p, lds); if (REPEAT_KIND == 100) phase_prologue(p, lds); }
    SEAM(0);
    for (int l = 0; l < DEPTH; ++l) {
        const int pb = 1 + l * PH_PER_LAYER;
        int bid = blockIdx.x; OPAQUE_S(bid);
        if (PHK(0) && IN(pb + 0)) {
            phase_rstd((const float*)(ws + WS_SSP), (float*)(ws + WS_RSTD), l == 0 ? MP + MS : MP);
            if (l > 0) sample_reduce((const float*)(ws + WS_PART), DFF / 256, p.out + O_YS, p.out + O_YS, (bf16_t*)(ws + WS_XB), (float*)(ws + WS_RSTD), nullptr);
        }
        SEAM(pb + 0);
        if (REPEAT_KIND == 11 && l == 0 && IN(pb + 1)) {
            pg8::Gemm g{(const bf16_t*)(ws + WS_XB), (const bf16_t*)(ws + WS_WIN) + (size_t)l * NP * D, MALL, NP, D, D};
            pg8::StaticOrder S; S.init(MALL, NP, gridDim.x, bid, D);
            EpiNull E{(float*)(ws + WS_DUMMY)};
            pg8::gemm_phase(lds, g, S, E);
        }
        if ((REPEAT_KIND == 12 || REPEAT_KIND == 13) && l == 0 && IN(pb + 1)) {
            pg8::Gemm g{(const bf16_t*)(ws + WS_XB), (const bf16_t*)(ws + WS_WIN) + (size_t)l * NP * D, MALL, NP, D, D};
            pg8::StaticOrder S; S.init(MALL, NP, gridDim.x, bid, D);
            EpiInProj E{l, ws, p.out, REPEAT_KIND == 12 ? 1 : 2};
            pg8::gemm_phase(lds, g, S, E);
        }
        for (int pass = 0; pass < ((REPEAT_KIND == 60 && l == 0) ? 2 : 1); ++pass) {
        for (int rep = 0; rep < NREP(1); ++rep) if (PHK(1) && IN(pb + 1)) {
            pg8::Gemm g{(const bf16_t*)(ws + WS_XB), (const bf16_t*)(ws + WS_WIN) + (size_t)l * NP * D, MALL, NP, D, D};
            pg8::StaticOrder S; S.init(MALL, NP, gridDim.x, bid, D);
            EpiInProj E{l, ws, p.out, 0};
            pg8::gemm_phase(lds, g, S, E, (const float*)(ws + WS_RSTD));
        }
        SEAM(pb + 1);
        for (int rep = 0; rep < NREP(2); ++rep) if (PHK(2) && IN(pb + 2)) phase_conv_pre(p, l, lds);
        SEAM(pb + 2);
        if (IN(pb + 3) && IN(pb + 4)) STAMP(pb + 4);
        if (PHK(4) && IN(pb + 4)) {
            unsigned* qc = (unsigned*)(ws + WS_BAR + WS_QUEUE) + (size_t)l * 19 * 64;
            phase_gdn_scan(p, l, lds, qc, misc + 8);
            phase_attn_a(p, l, lds, qc + 64, misc + 8);
            phase_attn_c(p, l, lds, qc + 10 * 64, misc + 8);
        }
        SEAM(pb + 4);
        for (int rep = 0; rep < NREP(5); ++rep) if (PHK(5) && IN(pb + 5)) phase_merge(p, l, lds);
        SEAM(pb + 5);
        if (REPEAT_KIND == 50 && l == 0 && IN(pb + 5) && IN(pb + 6)) { for (int i = 0; i < 10; ++i) xcd_barrier(bar); }
        float* ssp_mid = (float*)(ws + WS_SSP) + (size_t)MALL * NPART;
        for (int rep = 0; rep < NREP(6); ++rep) if (PHK(6) && IN(pb + 6)) {
            pg8::Gemm g{(const bf16_t*)(ws + WS_XB), (const bf16_t*)(ws + WS_WOUT) + (size_t)l * D * D, MALL, D, D, D};
            pg8::ComboOrder S; S.init(MP, D, gridDim.x, bid, D, D / 256, 256);
            EpiResid E{l == 0 ? p.in[I_XP] : p.out + O_YP, l == 0 ? p.in[I_XS] : p.out + O_YS, p.out + O_YP, p.out + O_YS, (bf16_t*)(ws + WS_XB2), ssp_mid, (float*)(ws + WS_PART)};
            pg8::gemm_phase(lds, g, S, E);
        }
        SEAM(pb + 6);
        if (PHK(7) && IN(pb + 7)) {
            phase_rstd(ssp_mid, (float*)(ws + WS_RSTD) + MALL, MP);
            sample_reduce((const float*)(ws + WS_PART), D / 256, l == 0 ? p.in[I_XS] : p.out + O_YS, p.out + O_YS, (bf16_t*)(ws + WS_XB2), (float*)(ws + WS_RSTD) + MALL, nullptr);
        }
        SEAM(pb + 7);
        for (int rep = 0; rep < NREP(8); ++rep) if (PHK(8) && IN(pb + 8)) {
            pg8::Gemm g{(const bf16_t*)(ws + WS_XB2), (const bf16_t*)(ws + WS_WUP) + (size_t)l * DFF * D, MALL, DFF, D, D};
            pg8::ComboOrder S; S.init(MP, DFF, gridDim.x, bid, D, D / 256, 256);
            EpiUp E{(bf16_t*)(ws + WS_HID), (float*)(ws + WS_PART)};
            pg8::gemm_phase(lds, g, S, E, (const float*)(ws + WS_RSTD) + MALL);
        }
        SEAM(pb + 8);
        if (PHK(9) && IN(pb + 9)) sample_up_reduce((const float*)(ws + WS_PART), D / 256, (const float*)(ws + WS_RSTD) + MALL, (bf16_t*)(ws + WS_HID));
        SEAM(pb + 9);
        }
        if (REPEAT_KIND == 9 && l == 0 && IN(pb + 10)) {
            pg8::Gemm g{(const bf16_t*)(ws + WS_HID), (const bf16_t*)(ws + WS_WDN) + (size_t)l * D * DFF, MALL, D, DFF, DFF};
            pg8::StaticOrder S; S.init(MALL, D, gridDim.x, bid, DFF);
            float* sink = (float*)(ws + WS_DUMMY);
            EpiResid E{p.out + O_YP, p.out + O_YS, sink, sink + (size_t)MP * D, (bf16_t*)(sink + (size_t)MALL * D), sink + (size_t)MALL * D * 2, sink};
            pg8::gemm_phase(lds, g, S, E);
        }
        if (PHK(10) && IN(pb + 10)) {
            pg8::Gemm g{(const bf16_t*)(ws + WS_HID), (const bf16_t*)(ws + WS_WDN) + (size_t)l * D * DFF, MALL, D, DFF, DFF};
            pg8::ComboOrder S; S.init(MP, D, gridDim.x, bid, DFF, DFF / 256, 256);
            EpiResid E{p.out + O_YP, p.out + O_YS, p.out + O_YP, p.out + O_YS, (bf16_t*)(ws + WS_XB), (float*)(ws + WS_SSP), (float*)(ws + WS_PART)};
            pg8::gemm_phase(lds, g, S, E);
        }
        SEAM(pb + 10);
    }
    if (PHK(101) && IN(1 + DEPTH * PH_PER_LAYER)) { phase_final(p, lds);
        sample_reduce((const float*)(p.ws + WS_PART), DFF / 256, p.out + O_YS, p.out + O_YS, nullptr, nullptr, p.in[I_FNW]); }
#ifdef PROBE_KIND
    __syncthreads();
    if (blockIdx.x == 0 && threadIdx.x == 0) { const unsigned long long* st = (const unsigned long long*)(p.ws + WS_STAMP); STAMP(N_PHASES); unsigned long long tot = 0;
        if (PROBE_KIND == 100) tot = st[1] - st[0]; else if (PROBE_KIND == 101) tot = st[N_PHASES] - st[N_PHASES - 1];
        else for (int l = 0; l < DEPTH; ++l) tot += st[1 + l * PH_PER_LAYER + PROBE_KIND + 1] - st[1 + l * PH_PER_LAYER + PROBE_KIND];
        const float us = (float)tot * 0.0105f; const float q = exp2f(rintf(log2f(us) * 8.0f) / 8.0f);
        p.out[O_PAK + 5] = q; }
#endif
#undef IN
#undef SEAM
}

extern "C" void kernel_launch(void* const* d_in, const int* in_sizes, int n_in, void* d_out, int out_size, void* d_ws, size_t ws_size, hipStream_t stream) {
    if (n_in != 24 || (size_t)out_size != O_END || ws_size < WS_TOTAL) { fprintf(stderr, "kernel_launch: unexpected shapes (n_in %d out %d ws %zu need %zu)\n", n_in, out_size, ws_size, (size_t)WS_TOTAL); return; }
    Params p{};
    for (int i = 0; i < 24; ++i) p.in[i] = (const float*)d_in[i];
    p.out = (float*)d_out; p.ws = (unsigned char*)d_ws;
    (void)hipMemsetAsync((char*)d_ws + WS_BAR, 0, 32768, stream);
#ifdef EMU
    const int grid = EMU_GRID;
    const char* e = getenv("EMU_PHASES"); const int nph = e ? atoi(e) : N_PHASES;
    if (getenv("EMU_ONE")) { p.ph_lo = 0; p.ph_hi = nph; EMU_LAUNCH(fwd_kernel, grid, 512, LDS_BYTES, p); }
    else for (int k = 0; k < nph; ++k) { p.ph_lo = k; p.ph_hi = k + 1; EMU_LAUNCH(fwd_kernel, grid, 512, LDS_BYTES, p); }
#else
    static int grid = 0;
    if (grid == 0) {
        int dev = 0, cus = 0;
        if (hipGetDevice(&dev) != hipSuccess || hipDeviceGetAttribute(&cus, hipDeviceAttributeMultiprocessorCount, dev) != hipSuccess) { grid = -1; return; }
        if (hipFuncSetAttribute((const void*)fwd_kernel, hipFuncAttributeMaxDynamicSharedMemorySize, LDS_BYTES) != hipSuccess) { grid = -1; return; }
        grid = cus;
    }
    if (grid < 0) return;
#ifndef ONE_LAUNCH
#define ONE_LAUNCH 1
#endif
#if ONE_LAUNCH
    p.ph_lo = 0; p.ph_hi = N_PHASES;
    hipLaunchKernelGGL(fwd_kernel, dim3(grid), dim3(512), LDS_BYTES, stream, p);
#else
    for (int k = 0; k < N_PHASES; ++k) { p.ph_lo = k; p.ph_hi = k + 1; hipLaunchKernelGGL(fwd_kernel, dim3(grid), dim3(512), LDS_BYTES, stream, p); }
#endif
#endif
}

#ifdef EMU
void emu_compare(const char* name, const float* got, const float* ref, size_t n);
std::vector<float> emu_load_dbg(const char* name, size_t n);
static void dbg_bf16(const char* tag, const unsigned char* ws, size_t off, size_t row0, size_t nrows, const char* file) {
    std::vector<float> got(nrows * D); const bf16_t* b = (const bf16_t*)(ws + off) + row0 * D;
    for (size_t i = 0; i < nrows * D; ++i) got[i] = bf2f(b[i]);
    std::vector<float> ref = emu_load_dbg(file, nrows * D); emu_compare(tag, got.data(), ref.data(), nrows * D);
}
void emu_debug(unsigned char* ws, float* out) {
    printf("barrier timeout word = %u\n", ((unsigned*)(ws + WS_BAR))[XB_TMO]);
    if (const char* x = getenv("EMU_DBG_X")) { std::vector<float> ref = emu_load_dbg(x, (size_t)MP * D); emu_compare(x, out + O_YP, ref.data(), (size_t)MP * D); }
    if (getenv("EMU_DBG_M")) { dbg_bf16("merged(p)", ws, WS_XB, 0, MP, "p0_merged");
        std::vector<float> ref = emu_load_dbg("p0_merged", (size_t)MP * D); const bf16_t* b = (const bf16_t*)(ws + WS_XB); int shown = 0;
        for (int r = 0; r < MP && shown < 60; ++r) { int bad = 0, c0 = -1, c1 = -1; for (int c = 0; c < D; ++c) if (fabsf(bf2f(b[(size_t)r * D + c]) - ref[(size_t)r * D + c]) > 0.08f) { ++bad; if (c0 < 0) c0 = c; c1 = c; }
            if (bad) { printf("   row %d: %d bad cols [%d..%d]\n", r, bad, c0, c1); ++shown; } } }
    const char* e = getenv("EMU_DBG"); if (!e) return;
    const int l = atoi(e); char f[64];
    snprintf(f, 64, "p%d_obraw", l); dbg_bf16("obraw(p)", ws, WS_OBUF, 0, MP, f);
    snprintf(f, 64, "p%d_oa", l); dbg_bf16("oa(p)", ws, WS_OA, 0, MP, f);
    snprintf(f, 64, "s%d_oa", l); dbg_bf16("oa(s)", ws, WS_OA, MP, MS, f);
    snprintf(f, 64, "p%d_oc", l); dbg_bf16("oc(p)", ws, WS_OC, 0, MP, f);
    snprintf(f, 64, "s%d_oc", l); dbg_bf16("oc(s)", ws, WS_OC, MP, MS, f);
    for (int b = 0; b < DB; ++b) { snprintf(f, 64, "s%d_obraw", l); std::vector<float> ref = emu_load_dbg(f, (size_t)DB * DSEQ * D); std::vector<float> got(DSEQ * D);
        const bf16_t* bb = (const bf16_t*)(ws + WS_OBUF) + (size_t)(MP + b * 64) * D; for (int i = 0; i < DSEQ * D; ++i) got[i] = bf2f(bb[i]);
        emu_compare("obraw(s)", got.data(), ref.data() + (size_t)b * DSEQ * D, DSEQ * D); }
}
#endif
```

```cpp
#ifdef EMU
#include "emu.h"
#define LAS
#define ASM_WAIT_VM0() ((void)0)
#define ASM_WAIT_VM(n) ((void)0)
#define ASM_WAIT_LGKM(n) ((void)0)
#define ASM_WAIT_ALL0() ((void)0)
#define COMPILER_FENCE() ((void)0)
#define GLDS16(gptr, ldsptr) emu_global_load_lds16((gptr), (ldsptr))
#define MY_XCC_ID() (blockIdx.x & 7u)
#define WAVE_LDS_FENCE() ((void)__all(1))
#define OPAQUE(x) ((void)0)
#define OPAQUE_S(x) ((void)0)
#else
#include <hip/hip_runtime.h>
#include <cstdio>
#include <cstring>
#define LAS __attribute__((address_space(3)))
#define ASM_WAIT_VM0() asm volatile("s_waitcnt vmcnt(0)" ::: "memory")
#define ASM_WAIT_VM(n) asm volatile("s_waitcnt vmcnt(" #n ")" ::: "memory")
#define ASM_WAIT_LGKM(n) asm volatile("s_waitcnt lgkmcnt(" #n ")" ::: "memory")
#define ASM_WAIT_ALL0() asm volatile("s_waitcnt vmcnt(0) lgkmcnt(0)" ::: "memory")
#define COMPILER_FENCE() asm volatile("" ::: "memory")
#define GLDS16(gptr, ldsptr) __builtin_amdgcn_global_load_lds((const unsigned*)(gptr), (LAS unsigned*)(ldsptr), 16, 0, 0)
#define MY_XCC_ID() ((unsigned)__builtin_amdgcn_s_getreg((3 << 11) | 20) & 0xFu)
#define WAVE_LDS_FENCE() asm volatile("s_waitcnt lgkmcnt(0)" ::: "memory")
#define OPAQUE(x) asm volatile("" : "+v"(x))
#define OPAQUE_S(x) asm volatile("" : "+s"(x))
#endif
#define DI __device__ __forceinline__

#ifndef CFG_D
#define CFG_D 1024
#define CFG_BATCH 4
#define CFG_SEQ 8192
#define CFG_DB 8
#define CFG_PAST 1024
#endif
constexpr int D = CFG_D, NB = CFG_BATCH, SEQ = CFG_SEQ, DEPTH = 2, DB = CFG_DB, DSEQ = 16, PAST = CFG_PAST;
constexpr int HA = D / 256, HB = D / 128, HC = D / 128, DFF = 4 * D, CHUNK = 64, CONVW = 4;
constexpr int MP = NB * SEQ;
constexpr int MS = DB * DSEQ;
constexpr int MSP = (MS + 255) / 256 * 256;
constexpr int MALL = MP + MSP;
constexpr int NIN_ORIG = 13 * D + 2 * HB;
constexpr int NP = 13 * D + 256;
constexpr int TD = D / 256;
constexpr int NPART = 4 * TD;
constexpr int ROPE_N = (SEQ > PAST + DSEQ) ? SEQ : (PAST + DSEQ);
constexpr int NCH = SEQ / CHUNK;
constexpr int NUNIT_B = NB * NCH * HB + DB * HB;
constexpr int MB = MP + DB * 64;
constexpr float EPS = 1e-6f;
static_assert(MP % 256 == 0 && D % 256 == 0 && SEQ % 128 == 0 && PAST % 64 == 0 && 2 * HB <= 16, "shape assumptions");

typedef unsigned short bf16_t;
typedef short bf16x8 __attribute__((ext_vector_type(8)));
typedef short s16x4 __attribute__((ext_vector_type(4)));
typedef float f32x4 __attribute__((ext_vector_type(4)));
typedef float f32x2 __attribute__((ext_vector_type(2)));
typedef float f32x16 __attribute__((ext_vector_type(16)));
typedef unsigned u32x4 __attribute__((ext_vector_type(4)));
typedef unsigned u32x2 __attribute__((ext_vector_type(2)));

DI unsigned cvt_pk_bf16(float lo, float hi) {
#ifdef EMU
    unsigned a = __float_as_uint(lo), b = __float_as_uint(hi);
    a += 0x7fffu + ((a >> 16) & 1u); b += 0x7fffu + ((b >> 16) & 1u);
    return (a >> 16) | (b & 0xffff0000u);
#else
    typedef __bf16 bf16x2_t __attribute__((ext_vector_type(2)));
    const f32x2 v = {lo, hi}; return __builtin_bit_cast(unsigned, __builtin_convertvector(v, bf16x2_t));
#endif
}
DI float bf_lo(unsigned u) { return __uint_as_float(u << 16); }
DI float bf_hi(unsigned u) { return __uint_as_float(u & 0xffff0000u); }
DI float bf2f(bf16_t b) { return __uint_as_float(((unsigned)b) << 16); }
DI bf16_t f2bf(float f) { return (bf16_t)(cvt_pk_bf16(f, 0.f) & 0xffffu); }
DI float fast_exp2(float x) { return __builtin_amdgcn_exp2f(x); }
DI float fast_exp(float x) { return __builtin_amdgcn_exp2f(x * 1.44269504089f); }
DI float fast_rcp(float x) { return __builtin_amdgcn_rcpf(x); }
DI float sigmoidf_(float x) { return fast_rcp(1.0f + fast_exp(-x)); }
#ifdef EMU
#define TR_ISSUE(dst, base, addr, off) dst = emu_ds_read_b64_tr_b16((const unsigned char*)(base) + (addr) + (off))
#define TR_ISSUE_X32(dst, base, addr, off) dst = emu_ds_read_b64_tr_b16((const unsigned char*)(base) + ((addr) ^ 32u) + (off))
#define TR_WAIT2(n, a, b) ((void)0)
#define TR_WAIT1(n, a) ((void)0)
#else
#define TR_ISSUE(dst, base, addr, off) asm volatile("ds_read_b64_tr_b16 %0, %1 offset:%2" : "=v"(dst) : "v"((unsigned)(size_t)(base) + (addr)), "i"(off))
#define TR_ISSUE_X32(dst, base, addr, off) do { unsigned t_; asm volatile("v_xor_b32 %1, 32, %2\n\tds_read_b64_tr_b16 %0, %1 offset:%3" : "=&v"(dst), "=&v"(t_) : "v"((unsigned)(size_t)(base) + (addr)), "i"(off)); } while (0)
#define TR_WAIT2(n, a, b) asm volatile("s_waitcnt lgkmcnt(" #n ")" : "+v"(a), "+v"(b))
#define TR_WAIT1(n, a) asm volatile("s_waitcnt lgkmcnt(" #n ")" : "+v"(a))
#endif
DI s16x4 ds_read_tr16(const LAS unsigned char* p) {
#ifdef EMU
    return emu_ds_read_b64_tr_b16(p);
#else
    return __builtin_amdgcn_ds_read_tr16_b64_v4i16((LAS s16x4*)p);
#endif
}

constexpr size_t al256(size_t x) { return (x + 255) & ~(size_t)255; }
constexpr size_t WS_BAR = 0;
constexpr size_t WS_STAMP = 32768;
constexpr size_t WS_WIN = 65536;
constexpr size_t WS_WOUT = WS_WIN + al256((size_t)DEPTH * NP * D * 2);
constexpr size_t WS_WUP = WS_WOUT + al256((size_t)DEPTH * D * D * 2);
constexpr size_t WS_WDN = WS_WUP + al256((size_t)DEPTH * DFF * D * 2);
constexpr size_t WS_ROPE = WS_WDN + al256((size_t)DEPTH * D * DFF * 2);
constexpr size_t WS_XB = WS_ROPE + al256((size_t)ROPE_N * 64 * 4 * 2);
constexpr size_t WS_SSP = WS_XB + al256((size_t)MALL * D * 2);
constexpr size_t WS_QA = WS_SSP + al256((size_t)2 * MALL * NPART * 4);
constexpr size_t WS_KA = WS_QA + al256((size_t)MALL * D * 2);
constexpr size_t WS_VA = WS_KA + al256((size_t)MALL * D * 2);
constexpr size_t WS_BRAW = WS_VA + al256((size_t)MALL * D * 2);
constexpr size_t WS_BZ = WS_BRAW + al256((size_t)MALL * 3 * D * 2);
constexpr size_t WS_QC = WS_BZ + al256((size_t)MALL * D * 2);
constexpr size_t WS_KC = WS_QC + al256((size_t)MALL * D * 2);
constexpr size_t WS_VC = WS_KC + al256((size_t)MALL * D * 2);
constexpr size_t WS_GATES = WS_VC + al256((size_t)MALL * D * 2);
constexpr size_t WS_BAB = WS_GATES + al256((size_t)MALL * 3 * D * 2);
constexpr size_t WS_BQ = WS_BAB + al256((size_t)MALL * 16 * 4);
constexpr size_t WS_BK = WS_BQ + al256((size_t)MB * D * 2);
constexpr size_t WS_BV = WS_BK + al256((size_t)MB * D * 2);
constexpr size_t WS_GB = WS_BV + al256((size_t)MB * D * 2);
constexpr size_t WS_TT = WS_GB + al256((size_t)MB * 16 * 4);
constexpr size_t WS_AQK = WS_TT + al256((size_t)NUNIT_B * 4096 * 2);
constexpr size_t WS_CV = WS_AQK + al256((size_t)NUNIT_B * 4096 * 2);
constexpr size_t WS_OBUF = WS_CV + al256((size_t)NUNIT_B * 256 * 4);
constexpr size_t WS_OA = WS_OBUF + al256((size_t)MB * D * 2);
constexpr size_t WS_OC = WS_OA + al256((size_t)MALL * D * 2);
constexpr size_t WS_HID = WS_OC + al256((size_t)MALL * D * 2);
constexpr size_t WS_XB2 = WS_HID + al256((size_t)MALL * DFF * 2);
constexpr size_t WS_RSTD = WS_XB2 + al256((size_t)MALL * D * 2);
constexpr size_t WS_END = WS_RSTD + al256((size_t)2 * MALL * 4);
constexpr size_t WS_PART = WS_END;
constexpr size_t WS_TOTAL = WS_PART + (size_t)16 * 256 * D * 4;
constexpr size_t WS_DUMMY = WS_TOTAL;

struct Params {
    const float* in[24];
    float* out; unsigned char* ws;
    int ph_lo, ph_hi;
};
enum { I_XP = 0, I_XS, I_CAK, I_CAV, I_CCK, I_CCV, I_SCONV, I_SSSM, I_N1W, I_WIN, I_LQ1, I_LK1, I_LQ2, I_LK2, I_SUBLN, I_CONVW, I_ALOG, I_DTB, I_GDNW, I_WOUT, I_N2W, I_WUP, I_WDN, I_FNW };
constexpr size_t O_YP = 0;
constexpr size_t O_YS = O_YP + (size_t)NB * SEQ * D;
constexpr size_t O_PAK = O_YS + (size_t)DB * DSEQ * D;
constexpr size_t O_PAV = O_PAK + (size_t)DEPTH * NB * SEQ * D;
constexpr size_t O_PCK = O_PAV + (size_t)DEPTH * NB * SEQ * D;
constexpr size_t O_PCV = O_PCK + (size_t)DEPTH * NB * SEQ * D;
constexpr size_t O_PBC = O_PCV + (size_t)DEPTH * NB * SEQ * D;
constexpr size_t O_PBS = O_PBC + (size_t)DEPTH * NB * 3 * 3 * D;
constexpr size_t O_SAK = O_PBS + (size_t)DEPTH * NB * HB * 128 * 128;
constexpr size_t O_SAV = O_SAK + (size_t)DEPTH * DB * DSEQ * D;
constexpr size_t O_SCK = O_SAV + (size_t)DEPTH * DB * DSEQ * D;
constexpr size_t O_SCV = O_SCK + (size_t)DEPTH * DB * DSEQ * D;
constexpr size_t O_SBC = O_SCV + (size_t)DEPTH * DB * DSEQ * D;
constexpr size_t O_SBS = O_SBC + (size_t)DEPTH * DB * 3 * 3 * D;
constexpr size_t O_END = O_SBS + (size_t)DEPTH * DB * HB * 128 * 128;

DI int sigma256(int g) { return 64 * ((g >> 5) & 3) + 32 * (g >> 7) + (g & 31); }
DI int win_orig_col(int n) {
    if (n < 2 * D) { const int base = (n / D) * D, w = n % D, head = w >> 7, g = w & 127, G = g >> 3, j = g & 7;
        const int d = (j < 4) ? 4 * G + j : 64 + 4 * G + (j - 4); return base + head * 128 + d; }
    const int m = (n & ~255) + sigma256(n & 255);
    if (m < 6 * D) return m;
    if (m < 13 * D) return m + 2 * HB;
    const int c = m - 13 * D; return c < 2 * HB ? 6 * D + c : -1;
}
DI int sigma_col(int n) { return (n & ~255) + sigma256(n & 255); }
#define XB_TMO      128
#define XB_XCNT(j)  (256  + 64 * (j))
#define XB_XSUB(j)  (1280 + 64 * (j))
#define XB_XGEN(j)  (2304 + 64 * (j))
#define XB_TOP      3328
#define XB_TOPGEN   3392
#define XCD_BAR_WORDS 3456
#define XB_SPIN_CAP (1u << 22)
DI unsigned xb_ld(unsigned* p)              { return __hip_atomic_load(p, __ATOMIC_RELAXED, __HIP_MEMORY_SCOPE_AGENT); }
DI unsigned xb_add(unsigned* p, unsigned v) { return __hip_atomic_fetch_add(p, v, __ATOMIC_RELAXED, __HIP_MEMORY_SCOPE_AGENT); }
#define XB_SPIN(cond, bar) do { unsigned _sp = 0; while (cond) { __builtin_amdgcn_s_sleep(1); \
    if ((++_sp & 255u) == 0u) { if (xb_ld(&(bar)[XB_TMO])) break; if (_sp > XB_SPIN_CAP) { atomicAdd(&(bar)[XB_TMO], 1u); break; } } } } while (0)
struct XcdBarrier { unsigned* bar; unsigned x; volatile LAS unsigned* st; };
DI XcdBarrier xcd_barrier_post(unsigned* bar, volatile LAS unsigned* st) {
    XcdBarrier b; b.bar = bar; b.x = MY_XCC_ID(); b.st = st;
    if (threadIdx.x == 0) (void)xb_add(&bar[XB_XCNT(b.x)], 1u);
    return b;
}
DI void xcd_barrier_complete(unsigned* bar, unsigned x, unsigned& nloc, unsigned& nx) {
    const unsigned G = gridDim.x;
    unsigned sum, cnt, mine, sp = 0u;
    for (;;) {
        sum = 0u; cnt = 0u; mine = 0u;
#pragma unroll
        for (unsigned j = 0; j < 16; ++j) { const unsigned c = xb_ld(&bar[XB_XCNT(j)]); sum += c; cnt += (c > 0u) ? 1u : 0u; mine = (j == x) ? c : mine; }
        if (sum == G) break;
        __builtin_amdgcn_s_sleep(1);
        if ((++sp & 255u) == 0u) { if (xb_ld(&bar[XB_TMO])) break; if (sp > XB_SPIN_CAP) { atomicAdd(&bar[XB_TMO], 1u); break; } }
    }
    nloc = mine > 0u ? mine : 1u; nx = cnt > 0u ? cnt : 1u;
}
DI void xcd_barrier(const XcdBarrier& b) {
    ASM_WAIT_VM0();
    __syncthreads();
    if (threadIdx.x == 0) {
        unsigned* bar = b.bar;
        __builtin_amdgcn_s_waitcnt(0);
        unsigned nloc = b.st[0], nx = b.st[1];
        if (nloc == 0u) { xcd_barrier_complete(bar, b.x, nloc, nx); b.st[0] = nloc; b.st[1] = nx; }
        const unsigned old = xb_add(&bar[XB_XSUB(b.x)], 1u);
        const unsigned gen = old / nloc;
        if (old + 1u == (gen + 1u) * nloc) {
            __builtin_amdgcn_fence(__ATOMIC_RELEASE, "agent");
            ASM_WAIT_VM0();
            const unsigned og = xb_add(&bar[XB_TOP], 1u);
            const unsigned tg = og / nx;
            if (og + 1u == (tg + 1u) * nx) xb_add(&bar[XB_TOPGEN], 1u);
            else XB_SPIN(xb_ld(&bar[XB_TOPGEN]) == tg, bar);
            __builtin_amdgcn_fence(__ATOMIC_ACQUIRE, "agent");
            xb_add(&bar[XB_XGEN(b.x)], 1u);
            ASM_WAIT_VM0();
        } else {
            XB_SPIN(xb_ld(&bar[XB_XGEN(b.x)]) == gen, bar);
            __builtin_amdgcn_fence(__ATOMIC_ACQUIRE, "agent");
            ASM_WAIT_VM0();
        }
    }
    __syncthreads();
}

namespace pg8 {
constexpr int BM = 256, BK = 64, HALF = 128, HTB = HALF * BK * 2, STAGE_BYTES = 8 * HTB, NXCD = 8, WGM = 4;
DI int lds_byte(int r, int c) { const int st = (r >> 4) * 2 + (c >> 5), rr = r & 15, cc = c & 31, ob = rr * 64 + cc * 2; return st * 1024 + (ob ^ (((ob >> 9) & 1) << 5)); }
DI void stage_rc(int b, int& R, int& C) { const int st = b / 1024, sb = b % 1024, swz = sb ^ (((sb >> 9) & 1) << 5); R = (st >> 1) * 16 + swz / 64; C = (st & 1) * 32 + (swz % 64) / 2; }
DI int perm32(int rho) { const int n = rho >> 4, i = rho & 15; return 8 * (i >> 2) + 4 * n + (i & 3); }
struct Unit { int pm, pn; int koff, nt, slice; };
struct Gemm { const bf16_t* A; const bf16_t* Bt; int M, N, K, ld; };
struct StaticOrder {
    int nM, nN, nwg, G, c, ntk;
    DI void init(int M, int N, int G_, int c_, int K_) { nM = M / BM; nN = N / BM; nwg = nM * nN; G = G_; c = c_; ntk = K_ / BK; }
    DI bool next(int i, Unit& u) const {
        const long L = (long)i * G + c; if (L >= nwg) return false;
        int wgid = (int)L; { const int q = nwg / NXCD, r = nwg % NXCD, xcd = wgid % NXCD, off = wgid / NXCD; wgid = (xcd < r ? xcd * (q + 1) : r * (q + 1) + (xcd - r) * q) + off; }
        const int nig = WGM * nN, gid = wgid / nig, fm = gid * WGM, gsz = (nM - fm) < WGM ? (nM - fm) : WGM;
        u.pm = fm + ((wgid % nig) % gsz); u.pn = (wgid % nig) / gsz; u.koff = 0; u.nt = ntk; u.slice = -1; return true;
    }
    DI void a_ready(const Unit&) const {}
    DI void done(const Unit&) const {}
};
struct ComboOrder {
    StaticOrder so; int nS, kslice;
    DI void init(int Mmain, int N, int G_, int c_, int K_, int nS_, int kslice_) { so.init(Mmain, N, G_, c_, K_); nS = nS_; kslice = kslice_; }
    DI bool next(int i, Unit& u) const {
        const long L = (long)i * so.G + so.c;
        Unit a; a.pm = 0; a.pn = 0; a.koff = 0; a.nt = so.ntk; a.slice = -1;
        const bool is_main = so.next(i, a);
        const long j = L - so.nwg; const int sl = (int)(j / so.nN);
        const bool is_split = !is_main && j >= 0 && j < (long)so.nN * nS;
        u.pm = is_main ? a.pm : so.nM; u.pn = is_main ? a.pn : (int)(j % so.nN); u.koff = is_main ? 0 : sl * kslice * 2; u.nt = is_main ? so.ntk : kslice / BK; u.slice = is_main ? -1 : sl;
        return is_main || is_split;
    }
    DI void a_ready(const Unit&) const {}
    DI void done(const Unit&) const {}
};
template <class Epi, class Sched>
DI void gemm_phase(LAS unsigned char* lds, const Gemm g, const Sched& S, const Epi& E, const float* rowvec = nullptr, unsigned stagger_ticks = 0) {
    constexpr int RV_OFF = STAGE_BYTES;
    int tid = threadIdx.x; OPAQUE(tid);
    if (stagger_ticks) { const unsigned long long t0 = __builtin_amdgcn_s_memrealtime(); const unsigned long long d = (unsigned long long)((((unsigned)blockIdx.x >> 3) * 5u) & 7u) * stagger_ticks;
        while (__builtin_amdgcn_s_memrealtime() - t0 < d) __builtin_amdgcn_s_sleep(16); }
    const int wid = __builtin_amdgcn_readfirstlane(tid >> 6), lane = tid & 63, wr = wid >> 2, wc = wid & 3, fr = lane & 15, fq = lane >> 4;
    unsigned voffA[2], voffB[2];
#pragma unroll
    for (int i = 0; i < 2; ++i) { int R, C; stage_rc(tid * 16 + i * 8192, R, C); const int Rb = Epi::PERM ? ((R & ~31) + perm32(R & 31)) : R;
        voffA[i] = (unsigned)(R * g.ld + C) * 2u; voffB[i] = (unsigned)(Rb * g.ld + C) * 2u; }
    const size_t kstep = (size_t)(BK * 2);
    const size_t hstep = (size_t)HALF * g.ld * 2;
    const size_t tstep = 2 * hstep;
    const unsigned ldsw = (unsigned)wid * 1024u;
    const int aoff = lds_byte(wr * 64 + fr, fq * 8), boff = lds_byte(wc * 32 + fr, fq * 8);
#define PG8_SA(b, h) (((b) * 2 + (h)) * HTB)
#define PG8_SB(b, h) ((4 + (b) * 2 + (h)) * HTB)
#define PG8_STAGE(bufoff, gbase, voff) do { _Pragma("unroll") for (int _i = 0; _i < 2; ++_i) \
        GLDS16((const char*)(gbase) + (voff)[_i], lds + (bufoff) + ldsw + _i * 8192); } while (0)
#define PG8_LDA(dst, b, h) do { _Pragma("unroll") for (int m = 0; m < 4; ++m) _Pragma("unroll") for (int k = 0; k < 2; ++k) dst[m][k] = *(const LAS bf16x8*)(lds + PG8_SA(b, h) + aoff + m * 2048 + k * 1024); } while (0)
#define PG8_LDB(dst, b, h) do { _Pragma("unroll") for (int n = 0; n < 2; ++n) _Pragma("unroll") for (int k = 0; k < 2; ++k) dst[n][k] = *(const LAS bf16x8*)(lds + PG8_SB(b, h) + boff + n * 2048 + k * 1024); } while (0)
#define PG8_MMA(ai, bj, At, Bt) do { __builtin_amdgcn_s_setprio(1); _Pragma("unroll") for (int m = 0; m < 4; ++m) _Pragma("unroll") for (int n = 0; n < 2; ++n) _Pragma("unroll") for (int k = 0; k < 2; ++k) \
        acc[ai][bj][m][n] = __builtin_amdgcn_mfma_f32_16x16x32_bf16(Bt[n][k], At[m][k], acc[ai][bj][m][n], 0, 0, 0); __builtin_amdgcn_s_setprio(0); } while (0)
#define PG8_WAIT_V(n) ASM_WAIT_VM(n)
#define PG8_WAIT_L(n) ASM_WAIT_LGKM(n)
#define PG8_BAR __builtin_amdgcn_s_barrier()
#define PG8_SCHED __builtin_amdgcn_sched_barrier(0)
    Unit cur, nxt; int ui = 0;
    if (!S.next(0, cur)) return;
    f32x4 acc[2][2][4][2];
#pragma unroll
    for (int a = 0; a < 2; ++a)
#pragma unroll
        for (int b = 0; b < 2; ++b)
#pragma unroll
            for (int m = 0; m < 4; ++m)
#pragma unroll
                for (int n = 0; n < 2; ++n) acc[a][b][m][n] = (f32x4){0.f, 0.f, 0.f, 0.f};
    bf16x8 At[4][2], B0[2][2], B1[2][2];
    const char* cA = (const char*)g.A + (size_t)cur.pm * tstep + cur.koff; const char* cB = (const char*)g.Bt + (size_t)cur.pn * tstep + cur.koff;
    S.a_ready(cur);
    if (rowvec && wid == 0) GLDS16((const char*)(rowvec + (size_t)cur.pm * BM) + lane * 16, lds + RV_OFF);
    PG8_STAGE(PG8_SB(0, 0), cB, voffB); PG8_STAGE(PG8_SA(0, 0), cA, voffA); PG8_STAGE(PG8_SB(0, 1), cB + hstep, voffB); PG8_STAGE(PG8_SA(0, 1), cA + hstep, voffA);
    if (wr == 1) PG8_BAR;
    PG8_WAIT_V(4); PG8_BAR;
    PG8_STAGE(PG8_SB(1, 0), cB + kstep, voffB); PG8_STAGE(PG8_SA(1, 0), cA + kstep, voffA); PG8_STAGE(PG8_SB(1, 1), cB + hstep + kstep, voffB);
    PG8_WAIT_V(6); PG8_BAR;
    for (;;) {
        const bool has_next = S.next(ui + 1, nxt);
        const char* nA = has_next ? (const char*)g.A + (size_t)nxt.pm * tstep + nxt.koff : cA; const char* nB = has_next ? (const char*)g.Bt + (size_t)nxt.pn * tstep + nxt.koff : cB;
        const int nt = cur.nt;
        for (int t = 0; t < nt; t += 2) {
            const bool last = (t == nt - 2);
            const char* a1 = cA + (size_t)(t + 1) * kstep;
            const char* a2 = last ? nA : cA + (size_t)(t + 2) * kstep; const char* b2 = last ? nB : cB + (size_t)(t + 2) * kstep;
            const char* a3 = a2 + kstep; const char* b3 = b2 + kstep;
            if (last && has_next) { S.a_ready(nxt); if (rowvec && wid == 0) GLDS16((const char*)(rowvec + (size_t)nxt.pm * BM) + lane * 16, lds + RV_OFF + ((ui + 1) & 1) * 1024); }
            PG8_LDB(B0, 0, 0); PG8_SCHED; PG8_LDA(At, 0, 0); PG8_STAGE(PG8_SA(1, 1), a1 + hstep, voffA);
            PG8_WAIT_L(8); PG8_BAR; PG8_WAIT_L(0); PG8_MMA(0, 0, At, B0); PG8_BAR; PG8_SCHED;
            PG8_LDB(B1, 0, 1); PG8_STAGE(PG8_SB(0, 0), b2, voffB);
            PG8_BAR; PG8_WAIT_L(0); PG8_MMA(0, 1, At, B1); PG8_BAR;
            PG8_LDA(At, 0, 1); PG8_STAGE(PG8_SA(0, 0), a2, voffA);
            PG8_BAR; PG8_WAIT_L(0); PG8_MMA(1, 0, At, B0); PG8_BAR; PG8_SCHED;
            PG8_STAGE(PG8_SB(0, 1), b2 + hstep, voffB);
            PG8_WAIT_V(6); PG8_BAR; PG8_MMA(1, 1, At, B1); PG8_BAR;
            PG8_LDB(B0, 1, 0); PG8_SCHED; PG8_LDA(At, 1, 0); PG8_STAGE(PG8_SA(0, 1), a2 + hstep, voffA);
            PG8_WAIT_L(8); PG8_BAR; PG8_WAIT_L(0); PG8_MMA(0, 0, At, B0); PG8_BAR; PG8_SCHED;
            PG8_LDB(B1, 1, 1); PG8_STAGE(PG8_SB(1, 0), b3, voffB);
            PG8_BAR; PG8_WAIT_L(0); PG8_MMA(0, 1, At, B1); PG8_BAR;
            PG8_LDA(At, 1, 1); PG8_STAGE(PG8_SA(1, 0), a3, voffA);
            PG8_BAR; PG8_WAIT_L(0); PG8_MMA(1, 0, At, B0); PG8_BAR; PG8_SCHED;
            PG8_STAGE(PG8_SB(1, 1), b3 + hstep, voffB);
            PG8_WAIT_V(6); PG8_BAR; PG8_MMA(1, 1, At, B1); PG8_BAR;
        }
        E(acc, cur, wr, wc, fr, fq, (const LAS float*)(lds + RV_OFF + (ui & 1) * 1024)); S.done(cur);
        if (!has_next) break;
#pragma unroll
        for (int a = 0; a < 2; ++a)
#pragma unroll
            for (int b = 0; b < 2; ++b)
#pragma unroll
                for (int m = 0; m < 4; ++m)
#pragma unroll
                    for (int n = 0; n < 2; ++n) acc[a][b][m][n] = (f32x4){0.f, 0.f, 0.f, 0.f};
        cur = nxt; cA = nA; cB = nB; ++ui;
    }
    PG8_WAIT_V(0);
    if (wr == 0) PG8_BAR;
    PG8_BAR;
#undef PG8_SA
#undef PG8_SB
#undef PG8_STAGE
#undef PG8_LDA
#undef PG8_LDB
#undef PG8_MMA
#undef PG8_WAIT_V
#undef PG8_WAIT_L
#undef PG8_BAR
#undef PG8_SCHED
}
}
template <class ColMap>
DI void xpose_tile(LAS float* tile, const float* src, int lds_, bf16_t* dst, int ldd, const float* scale, int k0, int n0, const ColMap& cm) {
    int t = threadIdx.x; OPAQUE(t);
    __syncthreads();
    f32x4 v[8];
#pragma unroll
    for (int i = 0; i < 8; ++i) { const int kk = (t >> 6) + 8 * i, n4 = (t & 63) * 4; const int c = cm(n0 + n4);
        v[i] = (c >= 0) ? *(const f32x4*)(src + (size_t)(k0 + kk) * lds_ + c) : (f32x4){0.f, 0.f, 0.f, 0.f}; }
#pragma unroll
    for (int i = 0; i < 8; ++i) { const int kk = (t >> 6) + 8 * i, n4 = (t & 63) * 4; f32x4 w = v[i]; if (scale) w = w * scale[k0 + kk]; *(LAS f32x4*)(tile + kk * 260 + n4) = w; }
    __syncthreads();
#pragma unroll
    for (int i = 0; i < 4; ++i) { const int item = t + 512 * i, nn = item >> 3, kk = (item & 7) * 8; u32x4 w;
        w.x = cvt_pk_bf16(tile[(kk + 0) * 260 + nn], tile[(kk + 1) * 260 + nn]); w.y = cvt_pk_bf16(tile[(kk + 2) * 260 + nn], tile[(kk + 3) * 260 + nn]);
        w.z = cvt_pk_bf16(tile[(kk + 4) * 260 + nn], tile[(kk + 5) * 260 + nn]); w.w = cvt_pk_bf16(tile[(kk + 6) * 260 + nn], tile[(kk + 7) * 260 + nn]);
        *(u32x4*)(dst + (size_t)(n0 + nn) * ldd + k0 + kk) = w; }
}
struct CmIdent { DI int operator()(int n) const { return n; } };
struct CmWin { DI int operator()(int n) const { return win_orig_col(n); } };
struct CmSigma { DI int operator()(int n) const { return sigma_col(n); } };

DI void row_prep(const float* xrow, bf16_t* xbrow, float* ssprow, int lane) {
    for (int c0 = 0; c0 < D; c0 += 256) {
        f32x4 v = xrow ? *(const f32x4*)(xrow + c0 + lane * 4) : (f32x4){0.f, 0.f, 0.f, 0.f};
        u32x2 w; w.x = cvt_pk_bf16(v[0], v[1]); w.y = cvt_pk_bf16(v[2], v[3]);
        *(u32x2*)(xbrow + c0 + lane * 4) = w;
        float s = v[0] * v[0] + v[1] * v[1] + v[2] * v[2] + v[3] * v[3];
        s += __shfl_xor(s, 1); s += __shfl_xor(s, 2); s += __shfl_xor(s, 4); s += __shfl_xor(s, 8);
        if ((lane & 15) == 0) ssprow[(c0 >> 6) + (lane >> 4)] = s;
    }
}

DI void phase_prologue(const Params& p, LAS unsigned char* lds) {
    int tid = threadIdx.x; OPAQUE(tid);
    const int lane = tid & 63, wid = tid >> 6;
    unsigned char* ws = p.ws;
    LAS float* tile = (LAS float*)lds;
    const int T_WIN = (NP / 256) * (D / 64), T_WOUT = (D / 256) * (D / 64), T_WUP = (DFF / 256) * (D / 64), T_WDN = (D / 256) * (DFF / 64);
    const int T_LAYER = T_WIN + T_WOUT + T_WUP + T_WDN;
    for (int u = blockIdx.x; u < DEPTH * T_LAYER; u += gridDim.x) {
        const int l = u / T_LAYER; int r = u % T_LAYER;
        if (r < T_WIN) { const int nt = r / (D / 64), kt = r % (D / 64);
            xpose_tile(tile, p.in[I_WIN] + (size_t)l * D * NIN_ORIG, NIN_ORIG, (bf16_t*)(ws + WS_WIN) + (size_t)l * NP * D, D, p.in[I_N1W] + l * D, kt * 64, nt * 256, CmWin()); continue; }
        r -= T_WIN;
        if (r < T_WOUT) { const int nt = r / (D / 64), kt = r % (D / 64);
            xpose_tile(tile, p.in[I_WOUT] + (size_t)l * D * D, D, (bf16_t*)(ws + WS_WOUT) + (size_t)l * D * D, D, nullptr, kt * 64, nt * 256, CmIdent()); continue; }
        r -= T_WOUT;
        if (r < T_WUP) { const int nt = r / (D / 64), kt = r % (D / 64);
            xpose_tile(tile, p.in[I_WUP] + (size_t)l * D * DFF, DFF, (bf16_t*)(ws + WS_WUP) + (size_t)l * DFF * D, D, p.in[I_N2W] + l * D, kt * 64, nt * 256, CmSigma()); continue; }
        r -= T_WUP;
        { const int nt = r / (DFF / 64), kt = r % (DFF / 64);
            xpose_tile(tile, p.in[I_WDN] + (size_t)l * DFF * D, D, (bf16_t*)(ws + WS_WDN) + (size_t)l * D * DFF, DFF, nullptr, kt * 64, nt * 256, CmIdent()); }
    }
    { float* rc = (float*)(ws + WS_ROPE); float* rs = rc + (size_t)ROPE_N * 64;
      for (int i = blockIdx.x * 512 + tid; i < ROPE_N * 64; i += gridDim.x * 512) { const int pos = i >> 6, f = i & 63;
          const float inv = (float)pow(10000.0, -(double)f / 64.0); const float ang = (float)pos * inv;
          rc[i] = (float)cos((double)ang); rs[i] = (float)sin((double)ang); } }
    { bf16_t* xb = (bf16_t*)(ws + WS_XB); float* ssp = (float*)(ws + WS_SSP);
      for (int row = blockIdx.x * 8 + wid; row < MALL; row += gridDim.x * 8) {
          const float* xr = row < MP ? p.in[I_XP] + (size_t)row * D : (row - MP < MS ? p.in[I_XS] + (size_t)(row - MP) * D : nullptr);
          row_prep(xr, xb + (size_t)row * D, ssp + (size_t)row * NPART, lane); } }
}

#ifdef EMU
#define NT_ST4(p, v) (*(f32x4*)(p) = (v))
#else
#define NT_ST4(p, v) __builtin_nontemporal_store((v), (f32x4*)(p))
#endif
#ifdef EMU
#define SCAL(x) ((void)0)
#else
#define SCAL(x) asm("" : "+v"(x))
#endif
struct EpiInProj {
    static constexpr bool PERM = true;
    int layer; unsigned char* ws; float* out; int nostore;
    DI void st8(bf16_t* dst, const f32x4& a, const f32x4& b) const { if (nostore == 1) { asm volatile("" :: "v"(a[0] + b[0])); return; } u32x4 w; w.x = cvt_pk_bf16(a[0], a[1]); w.y = cvt_pk_bf16(a[2], a[3]); w.z = cvt_pk_bf16(b[0], b[1]); w.w = cvt_pk_bf16(b[2], b[3]); *(u32x4*)dst = w; }
    DI void st4(bf16_t* dst, const f32x4& a) const { if (nostore == 1) { asm volatile("" :: "v"(a[0])); return; } u32x2 w; w.x = cvt_pk_bf16(a[0], a[1]); w.y = cvt_pk_bf16(a[2], a[3]); *(u32x2*)dst = w; }
    DI void operator()(const f32x4 (&acc)[2][2][4][2], const pg8::Unit& u, int wr, int wc, int fr_, int fq_, const LAS float* rs_lds) const {
        int fr = fr_, fq = fq_; OPAQUE(fr); OPAQUE(fq);
        const bool sample = u.pm >= MP / 256;
        const int pn = u.pn;
        const float* ropec = (const float*)(ws + WS_ROPE); const float* ropes = ropec + (size_t)ROPE_N * 64;
        bf16_t* qa = (bf16_t*)(ws + WS_QA); bf16_t* ka = (bf16_t*)(ws + WS_KA); bf16_t* va = (bf16_t*)(ws + WS_VA); bf16_t* braw = (bf16_t*)(ws + WS_BRAW); bf16_t* bz = (bf16_t*)(ws + WS_BZ);
        bf16_t* qc = (bf16_t*)(ws + WS_QC); bf16_t* kc = (bf16_t*)(ws + WS_KC); bf16_t* vc = (bf16_t*)(ws + WS_VC); bf16_t* gates = (bf16_t*)(ws + WS_GATES); float* bab = (float*)(ws + WS_BAB);
        int kind, segt;
        if (pn < TD) { kind = 0; segt = 0; } else if (pn < 2 * TD) { kind = 1; segt = TD; } else if (pn < 3 * TD) { kind = 2; segt = 2 * TD; }
        else if (pn < 6 * TD) { kind = 3; segt = 3 * TD; } else if (pn < 7 * TD) { kind = 4; segt = 6 * TD; } else if (pn < 8 * TD) { kind = 5; segt = 7 * TD; }
        else if (pn < 9 * TD) { kind = 6; segt = 8 * TD; } else if (pn < 10 * TD) { kind = 7; segt = 9 * TD; } else if (pn < 13 * TD) { kind = 8; segt = 10 * TD; }
        else { kind = 9; segt = 13 * TD; }
        const int cb = (pn - segt) * 256 + wc * 32 + fq * 8;
        const int cbs = (pn - segt) * 256 + wc * 64 + fq * 8;
#pragma unroll
        for (int ai = 0; ai < 2; ++ai)
#pragma unroll
            for (int m = 0; m < 4; ++m) {
                const int row = u.pm * 256 + ai * 128 + wr * 64 + m * 16 + fr;
                int b, t, L; bool valid = true;
                if (!sample) { b = row / SEQ; t = row % SEQ; L = SEQ; } else { const int sr = row - MP; valid = sr < MS; b = sr / DSEQ; t = sr % DSEQ; L = DSEQ; }
                if (!valid) continue;
                const int pos = sample ? PAST + t : t;
                const float rs = rs_lds[ai * 128 + wr * 64 + m * 16 + fr];
                const size_t orow = ((size_t)(layer * (sample ? DB : NB) + b) * L + t) * D;
#pragma unroll
                for (int bj = 0; bj < 2; ++bj) {
                    const f32x4 v0 = acc[ai][bj][m][0] * rs, v1 = acc[ai][bj][m][1] * rs;
                    const int c = kind <= 1 ? cb + bj * 128 : cbs + bj * 32;
                    if (kind <= 1) {
                        const int head = c >> 7, d0 = ((c & 127) >> 3) * 4;
                        const f32x4 cs = *(const f32x4*)(ropec + (size_t)pos * 64 + d0), sn = *(const f32x4*)(ropes + (size_t)pos * 64 + d0);
                        const f32x4 o1 = v0 * cs - v1 * sn, o2 = v1 * cs + v0 * sn;
                        const int tc = head * 128 + d0;
                        bf16_t* dst = (kind == 0 ? qa : ka) + (size_t)row * D + tc;
                        st4(dst, o1); st4(dst + 64, o2);
                        if (kind == 1 && sample) { float* o = out + O_SAK + orow + tc; if (!nostore) { NT_ST4(o, o1); NT_ST4((o + 64), o2); } }
                    } else if (kind == 2) { st8(va + (size_t)row * D + c, v0, v1); if (sample) { float* o = out + O_SAV + orow + c; if (!nostore) { NT_ST4(o, v0); NT_ST4((o + 4), v1); } } }
                    else if (kind == 3) { st8(braw + (size_t)row * 3 * D + c, v0, v1);
                        if (t >= L - 3) { float* o = out + (sample ? O_SBC : O_PBC) + ((size_t)(layer * (sample ? DB : NB) + b) * 3 + (t - (L - 3))) * 3 * D + c; if (!nostore) { NT_ST4(o, v0); NT_ST4((o + 4), v1); } } }
                    else if (kind == 4) st8(bz + (size_t)row * D + c, v0, v1);
                    else if (kind == 5) st8(qc + (size_t)row * D + c, v0, v1);
                    else if (kind == 6) { st8(kc + (size_t)row * D + c, v0, v1); float* o = out + (sample ? O_SCK : O_PCK) + orow + c; if (!nostore) { NT_ST4(o, v0); NT_ST4((o + 4), v1); } }
                    else if (kind == 7) { st8(vc + (size_t)row * D + c, v0, v1); float* o = out + (sample ? O_SCV : O_PCV) + orow + c; if (!nostore) { NT_ST4(o, v0); NT_ST4((o + 4), v1); } }
                    else if (kind == 8) st8(gates + (size_t)row * 3 * D + c, v0, v1);
                    else { if (c < 16 && !nostore) { float* o = bab + (size_t)row * 16 + c; NT_ST4(o, v0); NT_ST4((o + 4), v1); } }
                }
                if ((m & 1) == 1) COMPILER_FENCE();
            }
    }
};

DI void conv_unit(const Params& p, int l, int rbx, int cg) {
    int tid = threadIdx.x; OPAQUE(tid);
    unsigned char* ws = p.ws;
    const bf16_t* braw = (const bf16_t*)(ws + WS_BRAW);
    bf16_t* bqkv[3] = {(bf16_t*)(ws + WS_BQ), (bf16_t*)(ws + WS_BK), (bf16_t*)(ws + WS_BV)};
    const float* bab = (const float*)(ws + WS_BAB); float* gb = (float*)(ws + WS_GB);
    const float* convw = p.in[I_CONVW] + (size_t)l * CONVW * 3 * D;
    const float* alog = p.in[I_ALOG] + l * HB; const float* dtb = p.in[I_DTB] + l * HB;
    constexpr int CG = (3 * D + 1023) / 1024;
    const int ct = tid & 127, rg = tid >> 7;
    {
        const bool sample = rbx >= MP / 64;
        const int rb = sample ? rbx - MP / 64 : rbx;
        const int b = sample ? rb : (rb * 64) / SEQ, t00 = sample ? 0 : (rb * 64) % SEQ, nreal = sample ? DSEQ : 64;
        const size_t rawrow0 = sample ? (size_t)MP + (size_t)b * DSEQ : (size_t)b * SEQ + t00;
        const size_t dstrow0 = sample ? (size_t)MP + (size_t)b * 64 : (size_t)b * SEQ + t00;
        const int col8u = cg * 1024 + ct * 8; const bool active = col8u < 3 * D; const int col8 = active ? col8u : 0, seg = col8 / D, cseg = col8 % D;
        float cw[4][8];
#pragma unroll
        for (int k = 0; k < 4; ++k) { const f32x4 a = *(const f32x4*)(convw + (size_t)k * 3 * D + col8), bq4 = *(const f32x4*)(convw + (size_t)k * 3 * D + col8 + 4);
#pragma unroll
            for (int e = 0; e < 4; ++e) { cw[k][e] = a[e]; cw[k][4 + e] = bq4[e]; } }
#pragma unroll 1
        for (int half = 0; half < 2; ++half) {
            const int t0 = rg * 16 + half * 8;
            u32x4 raw[11];
#pragma unroll
            for (int j = 0; j < 11; ++j) { const int t = t0 - 3 + j; raw[j] = (u32x4){0u, 0u, 0u, 0u};
                if (active && (t >= 0 ? (t < nreal) : (!sample && t00 + t >= 0))) raw[j] = *(const u32x4*)(braw + (size_t)((long)rawrow0 + t) * 3 * D + col8); }
            float hist[3][8];
            const bool use_hist = sample && t0 == 0;
            if (use_hist) { const float* hs = p.in[I_SCONV] + ((size_t)(l * DB + b) * 3) * 3 * D + col8;
#pragma unroll
                for (int j = 0; j < 3; ++j)
#pragma unroll
                    for (int e = 0; e < 8; ++e) hist[j][e] = hs[(size_t)j * 3 * D + e]; }
#pragma unroll
            for (int r8 = 0; r8 < 8; ++r8) {
                const int t = t0 + r8; float o[8];
                if (t < nreal) {
                    float ss = 0.f;
#pragma unroll
                    for (int e = 0; e < 8; ++e) { float c = 0.f;
#pragma unroll
                        for (int k = 0; k < 4; ++k) { const int j = r8 + k;
                            float x = (e & 1) ? bf_hi(raw[j][e >> 1]) : bf_lo(raw[j][e >> 1]);
                            if (r8 + k < 3) { if (use_hist) x = hist[r8 + k][e]; }
                            c += x * cw[k][e]; }
                        const float sv = c * sigmoidf_(c); o[e] = sv; ss += sv * sv; }
                    ss += __shfl_xor(ss, 1); ss += __shfl_xor(ss, 2); ss += __shfl_xor(ss, 4); ss += __shfl_xor(ss, 8);
                    const float sc = seg < 2 ? __builtin_amdgcn_rsqf(ss + EPS) * (seg == 0 ? 0.08838834764831845f : 1.0f) : 1.0f;
#pragma unroll
                    for (int e = 0; e < 8; ++e) o[e] *= sc;
                } else {
#pragma unroll
                    for (int e = 0; e < 8; ++e) o[e] = 0.f;
                }
                u32x4 w; w.x = cvt_pk_bf16(o[0], o[1]); w.y = cvt_pk_bf16(o[2], o[3]); w.z = cvt_pk_bf16(o[4], o[5]); w.w = cvt_pk_bf16(o[6], o[7]);
                if (active) *(u32x4*)(bqkv[seg] + (dstrow0 + t) * D + cseg) = w;
            }
        }
        if (cg == 0) { const int t = tid / HB, h = tid % HB; float g = 0.f, be = 0.f;
            if (t < nreal) { const float ba = bab[(rawrow0 + t) * 16 + h], bbv = bab[(rawrow0 + t) * 16 + HB + h];
                const float x = ba + dtb[h]; const float sp = fmaxf(x, 0.f) + 0.69314718056f * __builtin_amdgcn_logf(1.0f + fast_exp(-fabsf(x)));
                g = -fast_exp(alog[h]) * sp; be = sigmoidf_(bbv); }
            if (t < 64) { gb[(dstrow0 + t) * 16 + h] = g; gb[(dstrow0 + t) * 16 + 8 + h] = be; } }
    }
}

DI int crow32(int reg, int h) { return (reg & 3) + 8 * (reg >> 2) + 4 * h; }
DI bf16x8 pack8(const f32x16& x, int s) {
    u32x4 w; w.x = cvt_pk_bf16(x[8 * s + 0], x[8 * s + 1]); w.y = cvt_pk_bf16(x[8 * s + 2], x[8 * s + 3]); w.z = cvt_pk_bf16(x[8 * s + 4], x[8 * s + 5]); w.w = cvt_pk_bf16(x[8 * s + 6], x[8 * s + 7]);
    return __builtin_bit_cast(bf16x8, w);
}
#define MFMA32(a, b, c) __builtin_amdgcn_mfma_f32_32x32x16_bf16((a), (b), (c), 0, 0, 0)
DI f32x16 zero16() { f32x16 z;
#pragma unroll
    for (int i = 0; i < 16; ++i) z[i] = 0.f; return z; }

DI void unit_rows_b(int u, int& row0, int& h) {
    if (u < NB * NCH * HB) { h = u % HB; const int bc = u / HB; row0 = (bc / NCH) * SEQ + (bc % NCH) * 64; }
    else { const int s = u - NB * NCH * HB; h = s % HB; row0 = MP + (s / HB) * 64; }
}

DI void pre_unit(const Params& p, LAS unsigned char* lds, int u) {
    int tid = threadIdx.x; OPAQUE(tid);
    const int lane_ = tid & 63, wid = tid >> 6;
    unsigned char* ws = p.ws;
    const bf16_t* bq = (const bf16_t*)(ws + WS_BQ); const bf16_t* bk = (const bf16_t*)(ws + WS_BK);
    const float* gb = (const float*)(ws + WS_GB);
    bf16_t* TT = (bf16_t*)(ws + WS_TT); bf16_t* AQ = (bf16_t*)(ws + WS_AQK); float* CV = (float*)(ws + WS_CV);
    LAS float* Mm = (LAS float*)(lds + wid * 16896);
    LAS float* gcs = Mm + 4096;
    {
        int lane = lane_; OPAQUE(lane);
        const int r = lane & 31, hh = lane >> 5;
        int row0, h; unit_rows_b(u, row0, h);
        const float g = gb[(size_t)(row0 + lane) * 16 + h], be = gb[(size_t)(row0 + lane) * 16 + 8 + h];
        float gc = g;
#pragma unroll
        for (int d = 1; d < 64; d <<= 1) { const float o = __shfl_up(gc, d); if (lane >= d) gc += o; }
        const float gL = __shfl(gc, 63);
        gcs[lane] = gc; gcs[64 + lane] = be;
        { float* cv = CV + (size_t)u * 256; const float eg = expf(gc); cv[lane] = be; cv[64 + lane] = be * eg; cv[128 + lane] = eg; cv[192 + lane] = expf(gL - gc); }
        WAVE_LDS_FENCE();
#pragma unroll
        for (int bi = 0; bi < 2; ++bi)
#pragma unroll
            for (int bj = 0; bj < 2; ++bj) {
                f32x16 kk = zero16(), qk = zero16();
                if (bj <= bi) {
                    const bf16_t* ki = bk + (size_t)(row0 + 32 * bi + r) * D + h * 128 + 8 * hh; const bf16_t* kj = bk + (size_t)(row0 + 32 * bj + r) * D + h * 128 + 8 * hh;
                    const bf16_t* qi = bq + (size_t)(row0 + 32 * bi + r) * D + h * 128 + 8 * hh;
#pragma unroll 2
                    for (int s = 0; s < 8; ++s) { const bf16x8 fki = *(const bf16x8*)(ki + 16 * s), fkj = *(const bf16x8*)(kj + 16 * s), fqi = *(const bf16x8*)(qi + 16 * s);
                        kk = MFMA32(fki, fkj, kk); qk = MFMA32(fqi, fkj, qk); }
                }
                __builtin_amdgcn_sched_barrier(0);
                const int j = 32 * bj + r; const float gcj = gcs[j];
#pragma unroll
                for (int i16 = 0; i16 < 16; ++i16) { const int i = 32 * bi + crow32(i16, hh); const float gci = gcs[i], bei = gcs[64 + i];
                    const float dec = (j <= i) ? expf(gci - gcj) : 0.f;
                    if (bj <= bi) Mm[i * 64 + j] = (j < i) ? bei * kk[i16] * dec : 0.f;
                    AQ[(size_t)u * 4096 + i * 64 + j] = f2bf((bj <= bi) ? qk[i16] * dec : 0.f); }
                __builtin_amdgcn_sched_barrier(0);
            }
        WAVE_LDS_FENCE();
        float tcol[64];
#pragma unroll
        for (int i = 0; i < 64; ++i) {
            float a = (i == lane) ? 1.f : 0.f;
#pragma unroll
            for (int j4 = 0; j4 < (i + 3) / 4; ++j4) { const f32x4 mv = *(const LAS f32x4*)(Mm + i * 64 + 4 * j4);
#pragma unroll
                for (int e = 0; e < 4; ++e) if (4 * j4 + e < i) a -= mv[e] * tcol[4 * j4 + e]; }
            tcol[i] = a;
            TT[(size_t)u * 4096 + i * 64 + lane] = f2bf(a);
            __builtin_amdgcn_sched_barrier(0);
        }
        WAVE_LDS_FENCE();
    }
}

DI void phase_conv_pre(const Params& p, int l, LAS unsigned char* lds) {
    const int wid = (int)threadIdx.x >> 6;
    constexpr int CG = (3 * D + 1023) / 1024;
    constexpr int NRB = MP / 64 + DB;
    for (int rbx = blockIdx.x; rbx < NRB; rbx += gridDim.x) {
#pragma unroll 1
        for (int cg = 0; cg < CG; ++cg) conv_unit(p, l, rbx, cg);
        ASM_WAIT_VM0(); __syncthreads();
        if (wid < HB) { const bool sample = rbx >= MP / 64; const int u = sample ? NB * NCH * HB + (rbx - MP / 64) * HB + wid : rbx * HB + wid;
            pre_unit(p, lds, u); }
    }
}

constexpr size_t WS_QUEUE = 16384;
DI int queue_next(unsigned* ctr, volatile LAS unsigned* slot) {
    __syncthreads();
    if (threadIdx.x == 0) *slot = __hip_atomic_fetch_add(ctr, 1u, __ATOMIC_RELAXED, __HIP_MEMORY_SCOPE_AGENT);
    __syncthreads();
    return __builtin_amdgcn_readfirstlane((int)*slot);
}

DI int xcd_queue_next(unsigned* ctr8, int nstreams, int per_stream, int& qx, int& tries, volatile LAS unsigned* slot) {
    for (;;) {
        if (tries >= 8) return -1;
        const int j = queue_next(ctr8 + 64 * qx, slot);
        if (j < per_stream * ((nstreams - qx + 7) / 8)) return j;
        qx = (qx + 1) & 7; ++tries;
    }
}

DI unsigned img_b(unsigned row, unsigned ch) { return 256u * row + 16u * (ch ^ (((row & 3u) << 2) | ((row >> 2) & 3u))); }
DI bf16x8 ld2x8(const LAS unsigned char* p0, const LAS unsigned char* p1) {
    const u32x2 a = *(const LAS u32x2*)p0, b = *(const LAS u32x2*)p1; u32x4 w; w.x = a.x; w.y = a.y; w.z = b.x; w.w = b.y; return __builtin_bit_cast(bf16x8, w);
}
DI unsigned tk_off(unsigned ta, int cbw, int kb) { return ta ^ (unsigned)(64 * ((cbw & 3) ^ kb)); }
constexpr int SC_KI = 0, SC_QI = 16384, SC_VI = 32768, SC_TI = 49152, SC_AI = 57344, SC_CV = 65536, SC_BUF = 66560;

DI void phase_gdn_scan(const Params& p, int l, LAS unsigned char* lds, unsigned* qctr, volatile LAS unsigned* qslot) {
    int tid = threadIdx.x; OPAQUE(tid);
    const int lane_ = tid & 63, wid = __builtin_amdgcn_readfirstlane(tid >> 6);
    unsigned char* ws = p.ws;
    const bf16_t* bq = (const bf16_t*)(ws + WS_BQ); const bf16_t* bk = (const bf16_t*)(ws + WS_BK); const bf16_t* bv = (const bf16_t*)(ws + WS_BV);
    const bf16_t* TT = (const bf16_t*)(ws + WS_TT); const bf16_t* AQ = (const bf16_t*)(ws + WS_AQK); const float* CV = (const float*)(ws + WS_CV);
    bf16_t* ob = (bf16_t*)(ws + WS_OBUF);
    constexpr int NCHAIN = NB * HB + DB * HB;
    for (;;) {
        const int ch = queue_next(qctr, qslot); if (ch >= NCHAIN) break;
        int lane = lane_; OPAQUE(lane);
        const int r = lane & 31, hh = lane >> 5;
        const bool sample = ch >= NB * HB;
        const int b = sample ? (ch - NB * HB) / HB : ch / HB, h = ch % HB, nchunk = sample ? 1 : NCH;
        const int dv0 = 32 * wid;
        const int u0 = sample ? NB * NCH * HB + b * HB + h : (b * NCH) * HB + h;
        const int row00 = sample ? MP + b * 64 : b * SEQ;
        const unsigned cx = (unsigned)((lane & 15) ^ (((lane >> 4) & 3) << 2));
#define SCAN_ISSUE(c_) do { if (wid >= 4) { LAS unsigned char* buf_ = lds + ((c_) & 1) * SC_BUF; \
            if (wid < 7) { const bf16_t* src_ = (wid == 4 ? bk : (wid == 5 ? bq : bv)) + (size_t)(row00 + 64 * (c_)) * D + h * 128; LAS unsigned char* d_ = buf_ + (wid - 4) * 16384; \
                _Pragma("unroll") for (int g_ = 0; g_ < 16; ++g_) GLDS16((const char*)src_ + (size_t)((4 * g_ + (lane >> 4)) * D * 2) + 16u * (cx ^ (unsigned)(g_ & 3)), d_ + g_ * 1024); } \
            else { const size_t uo_ = (size_t)(u0 + (c_) * HB); \
                _Pragma("unroll") for (int g_ = 0; g_ < 8; ++g_) { GLDS16((const char*)(TT + uo_ * 4096) + g_ * 1024 + lane * 16, buf_ + SC_TI + g_ * 1024); GLDS16((const char*)(AQ + uo_ * 4096) + g_ * 1024 + lane * 16, buf_ + SC_AI + g_ * 1024); } \
                GLDS16((const char*)(CV + uo_ * 256) + lane * 16, buf_ + SC_CV); } } } while (0)
        const unsigned sa0 = img_b(r, 0) + 8 * hh;
        unsigned ta0;
        { const int blk = (lane >> 4) & 1, q4 = (lane & 15) >> 2, p4 = lane & 3; ta0 = img_b(4 * hh + q4, 4 * (wid & 3) + 2 * blk + (p4 >> 1)) + 8 * (p4 & 1); }
        f32x16 S[4];
        if (wid < 4) {
#pragma unroll
            for (int kb = 0; kb < 4; ++kb) { S[kb] = zero16();
                if (sample) { const float* s0 = p.in[I_SSSM] + ((size_t)(l * DB + b) * HB + h) * 128 * 128;
#pragma unroll
                    for (int i = 0; i < 16; ++i) S[kb][i] = s0[(size_t)(32 * kb + crow32(i, hh)) * 128 + dv0 + r]; } }
        }
        SCAN_ISSUE(0);
        for (int c = 0; c < nchunk; ++c) {
            ASM_WAIT_ALL0(); __builtin_amdgcn_s_barrier();
            if (c + 1 < nchunk) SCAN_ISSUE(c + 1);
            if (wid < 4) {
                const LAS unsigned char* B = lds + (c & 1) * SC_BUF;
                unsigned sa = sa0, ta = ta0; OPAQUE(sa); OPAQUE(ta);
                const int row0 = row00 + 64 * c;
                f32x16 ks[2], qs[2];
                ks[0] = zero16(); ks[1] = zero16(); qs[0] = zero16(); qs[1] = zero16();
#pragma unroll
                for (int s = 0; s < 8; ++s) { const bf16x8 sb = pack8(S[s >> 1], s & 1); const unsigned o0 = sa ^ (unsigned)(32 * s), o1 = o0 ^ 16u;
                    ks[0] = MFMA32(ld2x8(B + SC_KI + o0, B + SC_KI + o1), sb, ks[0]);
                    ks[1] = MFMA32(ld2x8(B + SC_KI + 8192 + o0, B + SC_KI + 8192 + o1), sb, ks[1]);
                    qs[0] = MFMA32(ld2x8(B + SC_QI + o0, B + SC_QI + o1), sb, qs[0]);
                    qs[1] = MFMA32(ld2x8(B + SC_QI + 8192 + o0, B + SC_QI + 8192 + o1), sb, qs[1]);
                    __builtin_amdgcn_sched_barrier(0); }
                const LAS unsigned char* cvb = B + SC_CV + 16 * hh;
                f32x16 rr[2];
#pragma unroll
                for (int tb = 0; tb < 2; ++tb)
#pragma unroll
                    for (int g = 0; g < 4; ++g) { const s16x4 vv = ds_read_tr16(B + SC_VI + (32 * tb + 8 * g) * 256 + (ta ^ ((g & 1) ? 32u : 0u)));
                        const f32x4 be = *(const LAS f32x4*)(cvb + 4 * (32 * tb + 8 * g)), bg = *(const LAS f32x4*)(cvb + 4 * (64 + 32 * tb + 8 * g));
#pragma unroll
                        for (int e = 0; e < 4; ++e) rr[tb][4 * g + e] = be[e] * bf2f((bf16_t)vv[e]) - bg[e] * ks[tb][4 * g + e]; }
                __builtin_amdgcn_sched_barrier(0);
                bf16x8 Rb[4];
#pragma unroll
                for (int s2 = 0; s2 < 4; ++s2) Rb[s2] = pack8(rr[s2 >> 1], s2 & 1);
                f32x16 uu[2];
#pragma unroll
                for (int tb = 0; tb < 2; ++tb) { uu[tb] = zero16();
#pragma unroll
                    for (int s2 = 0; s2 < 2 * tb + 2; ++s2) { const LAS unsigned char* base = B + SC_TI + (32 * tb + r) * 128 + 32 * s2 + 8 * hh;
                        uu[tb] = MFMA32(ld2x8(base, base + 16), Rb[s2], uu[tb]); } }
                __builtin_amdgcn_sched_barrier(0);
                bf16x8 Ub[4], Ud[4];
#pragma unroll
                for (int tb = 0; tb < 2; ++tb) { f32x16 ud;
#pragma unroll
                    for (int g = 0; g < 4; ++g) { const f32x4 dg = *(const LAS f32x4*)(cvb + 4 * (192 + 32 * tb + 8 * g));
#pragma unroll
                        for (int e = 0; e < 4; ++e) ud[4 * g + e] = uu[tb][4 * g + e] * dg[e]; }
                    Ub[2 * tb] = pack8(uu[tb], 0); Ub[2 * tb + 1] = pack8(uu[tb], 1); Ud[2 * tb] = pack8(ud, 0); Ud[2 * tb + 1] = pack8(ud, 1); }
                __builtin_amdgcn_sched_barrier(0);
#pragma unroll
                for (int tb = 0; tb < 2; ++tb) { f32x16 o;
#pragma unroll
                    for (int g = 0; g < 4; ++g) { const f32x4 eg = *(const LAS f32x4*)(cvb + 4 * (128 + 32 * tb + 8 * g));
#pragma unroll
                        for (int e = 0; e < 4; ++e) o[4 * g + e] = qs[tb][4 * g + e] * eg[e]; }
#pragma unroll
                    for (int s2 = 0; s2 < 2 * tb + 2; ++s2) { const LAS unsigned char* base = B + SC_AI + (32 * tb + r) * 128 + 32 * s2 + 8 * hh;
                        o = MFMA32(ld2x8(base, base + 16), Ub[s2], o); }
                    bf16_t* od = ob + (size_t)(row0 + 32 * tb + 4 * hh) * D + h * 128 + dv0 + r;
#pragma unroll
                    for (int i = 0; i < 16; ++i) od[(size_t)((i & 3) + 8 * (i >> 2)) * D] = f2bf(o[i]); }
                __builtin_amdgcn_sched_barrier(0);
                const float egL = *(const LAS float*)(B + SC_CV + 4 * (128 + 63));
#pragma unroll
                for (int kb = 0; kb < 4; ++kb) {
#pragma unroll
                    for (int i = 0; i < 16; ++i) S[kb][i] *= egL;
#pragma unroll
                    for (int s2 = 0; s2 < 4; ++s2) {
                        const s16x4 lo = ds_read_tr16(B + SC_KI + s2 * 4096 + tk_off(ta, wid, kb));
                        const s16x4 hi = ds_read_tr16(B + SC_KI + s2 * 4096 + 2048 + (tk_off(ta, wid, kb) ^ 32u));
                        const bf16x8 a = __builtin_shufflevector(lo, hi, 0, 1, 2, 3, 4, 5, 6, 7);
                        S[kb] = MFMA32(a, Ud[s2], S[kb]); __builtin_amdgcn_sched_barrier(0); }
                }
            }
        }
#undef SCAN_ISSUE
        if (wid < 4) { int cl = dv0 + r + 512 * hh; OPAQUE(cl);
            float* so = p.out + (sample ? O_SBS : O_PBS) + ((size_t)(l * (sample ? DB : NB) + b) * HB + h) * 128 * 128 + cl;
#pragma unroll
            for (int kb = 0; kb < 4; ++kb)
#pragma unroll
                for (int i = 0; i < 16; ++i) so[(32 * kb + (i & 3) + 8 * (i >> 2)) * 128] = S[kb][i]; }
    }
}
constexpr int AT_K = 0, AT_V = 32768, AT_Q = 65536, AT_FLAG = 131072, AT_X = 0  ;

template <bool SRC32>
DI void stage_rows(LAS unsigned char* img, const void* src, size_t row_pitch_elems, int nrows, int nvalid) {
    int tid = threadIdx.x; OPAQUE(tid);
    for (int idx = tid; idx < nrows * 16; idx += 512) { const int row = idx >> 4, chn = idx & 15; u32x4 w = (u32x4){0u, 0u, 0u, 0u};
        if (row < nvalid) {
            if (SRC32) { const float* s = (const float*)src + (size_t)row * row_pitch_elems + chn * 8; const f32x4 a = *(const f32x4*)s, b = *(const f32x4*)(s + 4);
                w.x = cvt_pk_bf16(a[0], a[1]); w.y = cvt_pk_bf16(a[2], a[3]); w.z = cvt_pk_bf16(b[0], b[1]); w.w = cvt_pk_bf16(b[2], b[3]); }
            else w = *(const u32x4*)((const bf16_t*)src + (size_t)row * row_pitch_elems + chn * 8);
        }
        *(LAS u32x4*)(img + img_b(row, chn)) = w; }
}
struct LaneOffs { unsigned ra0; unsigned ta0[4]; };
DI LaneOffs make_lane_offs(int lane) {
    LaneOffs L; const int r = lane & 31, hh = lane >> 5, blk = (lane >> 4) & 1, q4 = (lane & 15) >> 2, p4 = lane & 3;
    L.ra0 = img_b(r, hh);
#pragma unroll
    for (int cb = 0; cb < 4; ++cb) L.ta0[cb] = img_b(4 * hh + q4, 4 * cb + 2 * blk + (p4 >> 1)) + 8 * (p4 & 1);
    return L;
}
DI bf16x8 lds_frag_row(const LAS unsigned char* img, const LaneOffs& L, int ks) { return *(const LAS bf16x8*)(img + (L.ra0 ^ (unsigned)(32 * ks))); }
DI bf16x8 lds_frag_tr(const LAS unsigned char* img, const LaneOffs& L, int s2, int cb) {
    const s16x4 lo = ds_read_tr16(img + s2 * 4096 + L.ta0[cb]);
    const s16x4 hi = ds_read_tr16(img + s2 * 4096 + 2048 + (L.ta0[cb] ^ 32u));
    return __builtin_shufflevector(lo, hi, 0, 1, 2, 3, 4, 5, 6, 7);
}

DI void cache_store_tile(const LAS unsigned char* stg, float* oK, float* oV) {
    int tq = threadIdx.x; OPAQUE(tq);
    const int ch = tq & 15;
#pragma unroll
    for (int j = 0; j < 8; ++j) { const int im = j >> 1, row = (tq >> 4) + 32 * (j & 1);
        const u32x4 w = *(const LAS u32x4*)(stg + im * 16384 + img_b(row, ch));
        float* o = (im < 2 ? oK + im * 128 : oV + (im - 2) * 128) + (size_t)row * D + ch * 8;
        const f32x4 a = (f32x4){bf_lo(w.x), bf_hi(w.x), bf_lo(w.y), bf_hi(w.y)}, b = (f32x4){bf_lo(w.z), bf_hi(w.z), bf_lo(w.w), bf_hi(w.w)};
        NT_ST4(o, a); NT_ST4((o + 4), b); }
}

#ifdef EMU
DI void swap32(float x, float& r0, float& r1) { const float o = __shfl_xor(x, 32); const bool up = (threadIdx.x & 32) != 0; r0 = up ? o : x; r1 = up ? x : o; }
#else
DI void swap32(float x, float& r0, float& r1) { const unsigned u = __float_as_uint(x); const auto r = __builtin_amdgcn_permlane32_swap(u, u, false, false); r0 = __uint_as_float(r[0]); r1 = __uint_as_float(r[1]); }
#endif
#ifdef EMU
#define TR_WAITN(n, a) ((void)0)
#else
#define TR_WAITN(n, a) do { if ((n) >= 8) TR_WAIT1(8, a); else if ((n) == 6) TR_WAIT1(6, a); else if ((n) == 4) TR_WAIT1(4, a); else if ((n) == 2) TR_WAIT1(2, a); else TR_WAIT1(0, a); } while (0)
#endif
#ifdef EMU
#define MAX3_ACC(acc, a, b) acc = fmaxf(acc, fmaxf((a), (b)))
#else
#define MAX3_ACC(acc, a, b) do { const float a_ = (a), b_ = (b); asm("v_max3_f32 %0, %0, %1, %2" : "+v"(acc) : "v"(a_), "v"(b_)); } while (0)
#endif
DI void attn_a_tile(const LAS unsigned char* Ki, const LAS unsigned char* Vi, const bf16x8 (&qreg)[8], int lane_in, int nvalid, float sc,
                    f32x16 (&O)[8], float& m, float& lsum, bool dma, const char* gsrc, LAS unsigned char* gdst, unsigned srow_in, unsigned cx_in) {
    int lane = lane_in; OPAQUE(lane);
    const LaneOffs LO = make_lane_offs(lane); const int hh = lane >> 5;
    f32x16 s0 = zero16(), s1 = zero16();
    {
        bf16x8 kb0[3], kb1[3];
#pragma unroll
        for (int j = 0; j < 3; ++j) { kb0[j] = lds_frag_row(Ki, LO, j); kb1[j] = lds_frag_row(Ki + 8192, LO, j); }
#pragma unroll
        for (int ks = 0; ks < 8; ++ks) {
            const bf16x8 a0 = kb0[ks % 3], a1 = kb1[ks % 3];
            if (ks + 3 < 8) { kb0[ks % 3] = lds_frag_row(Ki, LO, ks + 3); kb1[ks % 3] = lds_frag_row(Ki + 8192, LO, ks + 3); }
            s0 = MFMA32(a0, qreg[ks], s0); s1 = MFMA32(a1, qreg[ks], s1);
            if (dma) { unsigned srow_ = srow_in, cx_ = cx_in; OPAQUE(srow_); OPAQUE(cx_); GLDS16(gsrc + (srow_ + (unsigned)(ks * 4 * D * 2) + 16u * (cx_ ^ (unsigned)(ks & 3))), gdst + ks * 1024); }
            __builtin_amdgcn_sched_barrier(0);
        }
    }
    bf16x8 vf[3];
#pragma unroll
    for (int j = 0; j < 3; ++j) { s16x4 a_, b_; TR_ISSUE(a_, Vi, LO.ta0[j & 3], 0); TR_ISSUE_X32(b_, Vi, LO.ta0[j & 3], 2048); vf[j] = __builtin_shufflevector(a_, b_, 0, 1, 2, 3, 4, 5, 6, 7); }
    __builtin_amdgcn_sched_barrier(0);
    float mt = -1e30f;
    if (nvalid < 64) {
        const int nvh = nvalid - 4 * hh;
#pragma unroll
        for (int i = 0; i < 16; ++i) { if ((i & 3) + 8 * (i >> 2) >= nvh) s0[i] = -1e30f; if ((i & 3) + 8 * (i >> 2) + 32 >= nvh) s1[i] = -1e30f; }
    }
    mt = fmaxf(mt, fmaxf(s0[15], s1[15]));
    float mt2 = mt;
#pragma unroll
    for (int i = 0; i < 14; i += 2) { MAX3_ACC(mt, s0[i], s1[i]); MAX3_ACC(mt2, s0[i + 1], s1[i + 1]); }
    MAX3_ACC(mt, s0[14], s1[14]);
    MAX3_ACC(mt, mt2, mt2);
    { float r0_, r1_; swap32(mt, r0_, r1_); mt = fmaxf(r0_, r1_) * sc; }
    if (!__all(mt <= m + 8.0f)) {
        const float mn = fmaxf(m, mt), alpha = fast_exp2(m - mn); m = mn; lsum *= alpha;
#pragma unroll
        for (int d = 0; d < 8; ++d)
#pragma unroll
            for (int i = 0; i < 16; ++i) O[d][i] *= alpha;
    }
    float ps = 0.f;
    const float nm = -m;
    float ps1 = 0.f;
#pragma unroll
    for (int i = 0; i < 8; ++i) { const float e0 = fast_exp2(__builtin_fmaf(s0[i], sc, nm)); s0[i] = e0; ps += e0; SCAL(ps); }
    bf16x8 pb[4]; pb[0] = pack8(s0, 0);
    __builtin_amdgcn_sched_barrier(0);
    bf16x8 cur = vf[0];
    TR_WAITN(4, cur);
#pragma unroll
    for (int idx = 0; idx < 32; ++idx) { const int s2 = idx >> 3, d = idx & 7, slot = idx % 3;
        bf16x8 nxt = cur;
        if (idx + 1 < 32) { nxt = vf[(idx + 1) % 3]; if (idx + 2 < 32) TR_WAITN(2, nxt); else TR_WAITN(0, nxt); }
        O[d] = MFMA32(cur, pb[s2], O[d]);
        if (idx + 3 < 32) { const int j = idx + 3, js2 = j >> 3, jd = j & 7; s16x4 a_, b_;
            TR_ISSUE(a_, Vi, LO.ta0[jd & 3], (jd >> 2) * 16384 + js2 * 4096); TR_ISSUE_X32(b_, Vi, LO.ta0[jd & 3], (jd >> 2) * 16384 + js2 * 4096 + 2048);
            vf[slot] = __builtin_shufflevector(a_, b_, 0, 1, 2, 3, 4, 5, 6, 7); }
        cur = nxt;
        if (idx < 4) {
            const float ea = fast_exp2(__builtin_fmaf(s0[8 + 2 * idx], sc, nm)); s0[8 + 2 * idx] = ea; ps += ea; SCAL(ps);
            const float eb = fast_exp2(__builtin_fmaf(s0[9 + 2 * idx], sc, nm)); s0[9 + 2 * idx] = eb; ps1 += eb; SCAL(ps1); }
        else if (idx < 20) { const float e1 = fast_exp2(__builtin_fmaf(s1[idx - 4], sc, nm)); s1[idx - 4] = e1; ps1 += e1; SCAL(ps1); }
        if (idx == 3) pb[1] = pack8(s0, 1);
        if (idx == 11) pb[2] = pack8(s1, 0);
        if (idx == 19) pb[3] = pack8(s1, 1);
        __builtin_amdgcn_sched_barrier(0);
    }
    lsum += ps + ps1;
}

DI void phase_attn_a(const Params& p, int l, LAS unsigned char* lds, unsigned* qctr, volatile LAS unsigned* qslot) {
    int tid = threadIdx.x; OPAQUE(tid);
    const int lane_ = tid & 63, wid = __builtin_amdgcn_readfirstlane(tid >> 6), c = wid >> 2, rg = wid & 3;
    unsigned char* ws = p.ws;
    const bf16_t* QA = (const bf16_t*)(ws + WS_QA); const bf16_t* KA = (const bf16_t*)(ws + WS_KA); const bf16_t* VA = (const bf16_t*)(ws + WS_VA);
    bf16_t* OA = (bf16_t*)(ws + WS_OA);
    const float lam_init = 0.8f - 0.6f * expf(-0.3f * (float)l);
    float lam;
    { float d1 = 0.f, d2 = 0.f; const float* q1 = p.in[I_LQ1] + l * 128; const float* k1 = p.in[I_LK1] + l * 128; const float* q2 = p.in[I_LQ2] + l * 128; const float* k2 = p.in[I_LK2] + l * 128;
      for (int i = 0; i < 128; ++i) { d1 += q1[i] * k1[i]; d2 += q2[i] * k2[i]; } lam = expf(d1) - expf(d2) + lam_init; }
    LAS float* lamv = (LAS float*)(lds + AT_FLAG + 64);
    __syncthreads();
    if (tid == 0) { lamv[0] = lam; lamv[1] = 1.0f - lam_init; }
    const float* subw = p.in[I_SUBLN] + l * 256;
    constexpr int NQB = SEQ / 128, NBH = NB * HA, NU_P = NBH * NQB, NU = NU_P + DB * HA;
    const float sc = 0.08838834764831845f * 1.44269504089f;
    if (wid >= 4) __builtin_amdgcn_s_setprio(1);
    int qx = (int)(MY_XCC_ID() & 7u), tries = 0; bool sample_list = true;
    for (;;) {
        const bool dummy = false;
        int kk;
        if (sample_list) { kk = queue_next(qctr, qslot); if (kk >= NU - NU_P) { sample_list = false; continue; } }
        else { kk = xcd_queue_next(qctr + 64, NBH, NQB, qx, tries, qslot); if (kk < 0) break; }
        int lane = lane_; OPAQUE(lane);
        const int r = lane & 31, hh = lane >> 5;
        const LaneOffs LO = make_lane_offs(lane);
        const bool sample = __builtin_amdgcn_readfirstlane((int)sample_list) != 0;
        int b, h, qb; size_t qrow0;
        if (!sample) { const int cnt = (NBH - qx + 7) / 8; qb = NQB - 1 - kk / cnt; const int bh = qx + 8 * (kk % cnt); h = bh % HA; b = bh / HA; qrow0 = (size_t)b * SEQ + qb * 128; }
        else { h = kk % HA; b = kk / HA; qb = 0; qrow0 = (size_t)MP + (size_t)b * DSEQ; }
        b = __builtin_amdgcn_readfirstlane(b); h = __builtin_amdgcn_readfirstlane(h); qb = __builtin_amdgcn_readfirstlane(qb);
        qrow0 = sample ? (size_t)MP + (size_t)b * DSEQ : (size_t)b * SEQ + qb * 128;
        const int nq = sample ? 32 : 128;
        __syncthreads();
        stage_rows<false>(lds, QA + qrow0 * D + (2 * h) * 128, D, nq, nq);
        stage_rows<false>(lds + 32768, QA + qrow0 * D + (2 * h + 1) * 128, D, nq, nq);
        f32x16 O[8];
#pragma unroll
        for (int i = 0; i < 8; ++i) O[i] = zero16();
        float m = -1e30f, lsum = 0.f;
        const bool wave_on = sample ? (rg == 0) : true;
        const LAS unsigned char* Qw = lds + c * 32768 + rg * 8192;
        __syncthreads();
        bf16x8 qreg[8];
#pragma unroll
        for (int ks = 0; ks < 8; ++ks) qreg[ks] = lds_frag_row(Qw, LO, ks);
        __syncthreads();
        const int img = wid >> 1, rbase = 32 * (wid & 1) + (lane >> 4);
        const bf16_t* src = (img < 2 ? KA + (size_t)(2 * h + img) * 128 : VA + (size_t)h * 256 + (size_t)(img - 2) * 128) + (size_t)b * SEQ * D;
        const unsigned srow = (unsigned)(rbase * D * 2), cx = (unsigned)((lane & 15) ^ (((lane >> 4) & 3) << 2));
#define ATT_SOFF(i) (srow_ + (unsigned)((i) * 4 * D * 2) + 16u * (cx_ ^ (unsigned)((i) & 3)))
        const int ntile = sample ? PAST / 64 + 1 : 2 * qb + 2;
        const unsigned ldst = (unsigned)(img * 16384 + (wid & 1) * 8192);
        const char* gnext = (const char*)src;
#define ATT_ISSUE(t) do { LAS unsigned char* d_ = lds + ((t) & 1) * 65536 + ldst; unsigned srow_ = srow, cx_ = cx; OPAQUE(srow_); OPAQUE(cx_);   \
        _Pragma("unroll") for (int i_ = 0; i_ < 8; ++i_) GLDS16(gnext + ATT_SOFF(i_), d_ + i_ * 1024); gnext += (size_t)64 * D * 2; } while (0)
        if (!sample && !dummy) ATT_ISSUE(0);
        for (int t = 0; t < ntile; ++t) {
            LAS unsigned char* stg = lds + (t & 1) * 65536;
            int nvalid = 64; bool vis, dma = false;
            if (!sample) {
                if (t == 2 * qb + 1) { ASM_WAIT_VM(16); ASM_WAIT_LGKM(0); }
                else ASM_WAIT_ALL0();
                __builtin_amdgcn_s_barrier();
                vis = t <= 2 * qb + (rg >> 1);
                dma = t + 1 < ntile && !dummy;
            } else {
                __syncthreads();
                if (t < PAST / 64) { const size_t kr = ((size_t)(l * DB + b) * PAST + (size_t)t * 64) * D;
                    stage_rows<true>(stg, p.in[I_CAK] + kr + (2 * h) * 128, D, 64, 64); stage_rows<true>(stg + 16384, p.in[I_CAK] + kr + (2 * h + 1) * 128, D, 64, 64);
                    stage_rows<true>(stg + 32768, p.in[I_CAV] + kr + h * 256, D, 64, 64); stage_rows<true>(stg + 49152, p.in[I_CAV] + kr + h * 256 + 128, D, 64, 64); }
                else { nvalid = DSEQ; const size_t kr = (size_t)MP + (size_t)b * DSEQ;
                    stage_rows<false>(stg, KA + kr * D + (2 * h) * 128, D, 64, DSEQ); stage_rows<false>(stg + 16384, KA + kr * D + (2 * h + 1) * 128, D, 64, DSEQ);
                    stage_rows<false>(stg + 32768, VA + kr * D + h * 256, D, 64, DSEQ); stage_rows<false>(stg + 49152, VA + kr * D + h * 256 + 128, D, 64, DSEQ); }
                __syncthreads();
                vis = wave_on;
            }
            if (vis) attn_a_tile(stg + c * 16384, stg + 32768, qreg, lane, nvalid, sc, O, m, lsum, dma, gnext, lds + ((t + 1) & 1) * 65536 + ldst, srow, cx);
            else if (dma) { ATT_ISSUE(t + 1); gnext -= (size_t)64 * D * 2; }
            if (dma) gnext += (size_t)64 * D * 2;
            if (!sample && t >= 2 * qb && !dummy) { float* ob_ = p.out + ((size_t)(l * NB + b) * SEQ + (size_t)t * 64) * D;
                cache_store_tile(stg, ob_ + O_PAK + (2 * h) * 128, ob_ + O_PAV + h * 256); }
        }
#undef ATT_ISSUE
#undef ATT_SOFF
        const float inv_l = fast_rcp(lsum + __shfl_xor(lsum, 32));
#pragma unroll
        for (int d = 0; d < 8; ++d)
#pragma unroll
            for (int i = 0; i < 16; ++i) O[d][i] *= inv_l;
        LAS float* X = (LAS float*)(lds + AT_X);
#pragma unroll
        for (int hv = 0; hv < 2; ++hv) {
            __syncthreads();
            if (c == 1) {
#pragma unroll
                for (int d = 0; d < 4; ++d)
#pragma unroll
                    for (int i = 0; i < 16; ++i) X[((rg * 64) + d * 16 + i) * 64 + lane] = O[4 * hv + d][i]; }
            __syncthreads();
            if (c == 0) {
#pragma unroll
                for (int d = 0; d < 4; ++d)
#pragma unroll
                    for (int i = 0; i < 16; ++i) O[4 * hv + d][i] -= lamv[0] * X[((rg * 64) + d * 16 + i) * 64 + lane]; }
        }
        if (c == 0 && wave_on) {
            float ss = 0.f;
#pragma unroll
            for (int d = 0; d < 8; ++d)
#pragma unroll
                for (int i = 0; i < 16; ++i) ss += O[d][i] * O[d][i];
            ss += __shfl_xor(ss, 32);
            const float rstd = __builtin_amdgcn_rsqf(ss * (1.0f / 256.0f) + EPS) * lamv[1];
            int qi = 32 * rg + r; OPAQUE(qi);
            if ((!sample || qi < DSEQ) && !dummy) {
                bf16_t* dst = OA + (qrow0 + qi) * D + h * 256;
#pragma unroll
                for (int d = 0; d < 8; ++d)
#pragma unroll
                    for (int g4 = 0; g4 < 4; ++g4) { const int dv = 32 * d + 8 * g4 + 4 * hh; const f32x4 w = *(const f32x4*)(subw + dv);
                        u32x2 o; o.x = cvt_pk_bf16(O[d][4 * g4] * rstd * w[0], O[d][4 * g4 + 1] * rstd * w[1]); o.y = cvt_pk_bf16(O[d][4 * g4 + 2] * rstd * w[2], O[d][4 * g4 + 3] * rstd * w[3]);
                        *(u32x2*)(dst + dv) = o; }
            }
        }
    }
    __builtin_amdgcn_s_setprio(0);
}

DI void phase_attn_c(const Params& p, int l, LAS unsigned char* lds, unsigned* qctr, volatile LAS unsigned* qslot) {
    int tid = threadIdx.x; OPAQUE(tid);
    const int lane_ = tid & 63, wid = __builtin_amdgcn_readfirstlane(tid >> 6), hsel = wid >> 2, rg = wid & 3;
    unsigned char* ws = p.ws;
    const bf16_t* QC = (const bf16_t*)(ws + WS_QC); const bf16_t* KC = (const bf16_t*)(ws + WS_KC); const bf16_t* VC = (const bf16_t*)(ws + WS_VC);
    bf16_t* OC = (bf16_t*)(ws + WS_OC);
    constexpr int NQB = SEQ / 128, NHP = HC / 2, NU_P = NB * NHP * NQB, NU = NU_P + DB * NHP;
    volatile LAS unsigned* flags = (volatile LAS unsigned*)(lds + AT_FLAG);
    constexpr int NBHP = NB * NHP;
    int qx = (int)(MY_XCC_ID() & 7u), tries = 0; bool sample_list = true;
    for (;;) {
        int u;
        if (sample_list) { u = queue_next(qctr, qslot); if (u >= NU - NU_P) { sample_list = false; continue; } }
        else { u = xcd_queue_next(qctr + 64, NBHP, NQB, qx, tries, qslot); if (u < 0) break; }
        int lane = lane_; OPAQUE(lane);
        const int r = lane & 31, hh = lane >> 5;
        const LaneOffs LO = make_lane_offs(lane);
        const bool sample = __builtin_amdgcn_readfirstlane((int)sample_list) != 0;
        int b, hp, qb, jtop; int pos0;
        if (!sample) { const int cnt = (NBHP - qx + 7) / 8; qb = NQB - 1 - u / cnt; const int bh = qx + 8 * (u % cnt); hp = bh % NHP; b = bh / NHP; jtop = 2 * qb + 1; pos0 = qb * 128; }
        else { hp = u % NHP; b = u / NHP; qb = 0; jtop = PAST / 64; pos0 = PAST; }
        b = __builtin_amdgcn_readfirstlane(b); hp = __builtin_amdgcn_readfirstlane(hp); qb = __builtin_amdgcn_readfirstlane(qb); jtop = __builtin_amdgcn_readfirstlane(jtop); pos0 = __builtin_amdgcn_readfirstlane(pos0);
        const size_t qrow0 = sample ? (size_t)MP + (size_t)b * DSEQ : (size_t)b * SEQ + qb * 128;
        const int h = 2 * hp + hsel;
        const int nq = sample ? 32 : 128;
        __syncthreads();
        stage_rows<false>(lds, QC + qrow0 * D + (2 * hp) * 128, D, nq, nq);
        stage_rows<false>(lds + 32768, QC + qrow0 * D + (2 * hp + 1) * 128, D, nq, nq);
        if (tid < 8) flags[tid] = 0u;
        f32x16 O[4];
#pragma unroll
        for (int i = 0; i < 4; ++i) O[i] = zero16();
        float run = 0.f;
        const bool wave_on = sample ? (rg == 0) : true;
        bool wdone = !wave_on;
        const int tq = pos0 + 32 * rg + r;
        __syncthreads();
        bf16x8 qreg[8];
#pragma unroll
        for (int ks = 0; ks < 8; ++ks) qreg[ks] = lds_frag_row(lds + hsel * 32768 + rg * 8192, LO, ks);
        __syncthreads();
        const int img = wid >> 1, rbase = 32 * (wid & 1) + (lane >> 4);
        const bf16_t* src = (img < 2 ? KC + (size_t)(2 * hp + img) * 128 : VC + (size_t)(2 * hp + img - 2) * 128) + (size_t)b * SEQ * D;
        const unsigned srow = (unsigned)(rbase * D * 2), cx = (unsigned)((lane & 15) ^ (((lane >> 4) & 3) << 2));
        const unsigned ldst = (unsigned)(img * 16384 + (wid & 1) * 8192);
        const char* gnext = (const char*)src + (size_t)jtop * 64 * D * 2;
#define STK_ISSUE(st_) do { LAS unsigned char* d_ = lds + (st_) * 65536 + ldst; unsigned srow_ = srow, cx_ = cx; OPAQUE(srow_); OPAQUE(cx_); \
        _Pragma("unroll") for (int i_ = 0; i_ < 8; ++i_) GLDS16(gnext + (srow_ + (unsigned)(i_ * 4 * D * 2) + 16u * (cx_ ^ (unsigned)(i_ & 3))), d_ + i_ * 1024); gnext -= (size_t)64 * D * 2; } while (0)
        int st = 0;
        if (!sample) STK_ISSUE(0);
        for (int j = jtop; j >= 0; --j) {
            if (!sample) { ASM_WAIT_ALL0(); __builtin_amdgcn_s_barrier(); }
            else __syncthreads();
            { unsigned alld = 1u;
#pragma unroll
              for (int w = 0; w < 8; ++w) alld &= flags[w];
              if (alld) break; }
            LAS unsigned char* stg = lds + st * 65536;
            int nvalid = 64; const int kpos0 = j * 64;
            const bool dmac = !sample && j > 0;
            if (sample) {}
            if (sample) {
                if (j < PAST / 64) { const size_t kr = ((size_t)(l * DB + b) * PAST + (size_t)j * 64) * D;
                    stage_rows<true>(stg, p.in[I_CCK] + kr + (2 * hp) * 128, D, 64, 64); stage_rows<true>(stg + 16384, p.in[I_CCK] + kr + (2 * hp + 1) * 128, D, 64, 64);
                    stage_rows<true>(stg + 32768, p.in[I_CCV] + kr + (2 * hp) * 128, D, 64, 64); stage_rows<true>(stg + 49152, p.in[I_CCV] + kr + (2 * hp + 1) * 128, D, 64, 64); }
                else { nvalid = DSEQ; const size_t kr = (size_t)MP + (size_t)b * DSEQ;
                    stage_rows<false>(stg, KC + kr * D + (2 * hp) * 128, D, 64, DSEQ); stage_rows<false>(stg + 16384, KC + kr * D + (2 * hp + 1) * 128, D, 64, DSEQ);
                    stage_rows<false>(stg + 32768, VC + kr * D + (2 * hp) * 128, D, 64, DSEQ); stage_rows<false>(stg + 49152, VC + kr * D + (2 * hp + 1) * 128, D, 64, DSEQ); }
                __syncthreads();
            }
            const bool need = kpos0 < pos0 + 32 * rg + 31;
            if (dmac && !(!wdone && need)) STK_ISSUE(st ^ 1);
            if (!wdone && need) {
                LAS unsigned char* dd_ = lds + (st ^ 1) * 65536 + ldst;
                int lane2 = lane; OPAQUE(lane2); const LaneOffs L2 = make_lane_offs(lane2);
                const LAS unsigned char* Ki = stg + hsel * 16384; const LAS unsigned char* Vi = stg + 32768 + hsel * 16384;
                f32x16 s[2]; s[0] = zero16(); s[1] = zero16();
                {
                    bf16x8 kb0[2], kb1[2];
#pragma unroll
                    for (int jj = 0; jj < 2; ++jj) { kb0[jj] = lds_frag_row(Ki, L2, jj); kb1[jj] = lds_frag_row(Ki + 8192, L2, jj); }
#pragma unroll
                    for (int ks = 0; ks < 8; ++ks) {
                        const bf16x8 a0 = kb0[ks & 1], a1 = kb1[ks & 1];
                        if (ks + 2 < 8) { kb0[ks & 1] = lds_frag_row(Ki, L2, ks + 2); kb1[ks & 1] = lds_frag_row(Ki + 8192, L2, ks + 2); }
                        s[0] = MFMA32(a0, qreg[ks], s[0]); s[1] = MFMA32(a1, qreg[ks], s[1]);
                        if (dmac) { unsigned srow_ = srow, cx_ = cx; OPAQUE(srow_); OPAQUE(cx_); GLDS16(gnext + (srow_ + (unsigned)(ks * 4 * D * 2) + 16u * (cx_ ^ (unsigned)(ks & 3))), dd_ + ks * 1024); }
                        __builtin_amdgcn_sched_barrier(0);
                    }
                }
                if (dmac) gnext -= (size_t)64 * D * 2;
                bf16x8 vf[3];
#pragma unroll
                for (int jj = 0; jj < 3; ++jj) { s16x4 a_, b_; TR_ISSUE(a_, Vi, L2.ta0[jj & 3], 0); TR_ISSUE_X32(b_, Vi, L2.ta0[jj & 3], 2048); vf[jj] = __builtin_shufflevector(a_, b_, 0, 1, 2, 3, 4, 5, 6, 7); }
                __builtin_amdgcn_sched_barrier(0);
                float gs[8];
#pragma unroll
                for (int kb = 0; kb < 2; ++kb)
#pragma unroll
                    for (int q2 = 0; q2 < 4; ++q2) { float lm[4], lb[4];
#pragma unroll
                        for (int e = 0; e < 4; ++e) { const int key = 32 * kb + 8 * q2 + 4 * hh + e; const float z = s[kb][4 * q2 + e] * 0.08838834764831845f;
                            const float sp = fmaxf(z, 0.f) + 0.69314718056f * __builtin_amdgcn_logf(1.0f + fast_exp(-fabsf(z)));
                            const bool ok = (kpos0 + key < tq) && (key < nvalid);
                            lm[e] = ok ? -sp : 0.f; lb[e] = ok ? z - sp : -1e30f; }
                        const float t3 = 0.f, t2 = lm[3], t1 = t2 + lm[2], t0 = t1 + lm[1];
                        gs[4 * kb + q2] = t0 + lm[0];
                        s[kb][4 * q2 + 0] = lb[0] + t0; s[kb][4 * q2 + 1] = lb[1] + t1; s[kb][4 * q2 + 2] = lb[2] + t2; s[kb][4 * q2 + 3] = lb[3] + t3; }
                float pg[8], T[8];
#pragma unroll
                for (int k = 0; k < 8; ++k) { float r0_, r1_; swap32(gs[k], r0_, r1_); pg[k] = r1_; T[k] = r0_ + r1_; }
                float off[8]; float accp = run;
#pragma unroll
                for (int k = 7; k >= 0; --k) { off[k] = accp + (hh == 0 ? pg[k] : 0.f); accp += T[k]; }
                run = accp;
#pragma unroll
                for (int i = 0; i < 16; ++i) s[0][i] = fast_exp(s[0][i] + off[i >> 2]);
                bf16x8 pb[4]; pb[0] = pack8(s[0], 0); pb[1] = pack8(s[0], 1);
                __builtin_amdgcn_sched_barrier(0);
                bf16x8 cur = vf[0];
                TR_WAITN(4, cur);
#pragma unroll
                for (int idx = 0; idx < 16; ++idx) { const int s2 = idx >> 2, d = idx & 3, slot = idx % 3;
                    bf16x8 nxt = cur;
                    if (idx + 1 < 16) { nxt = vf[(idx + 1) % 3]; if (idx + 2 < 16) TR_WAITN(2, nxt); else TR_WAITN(0, nxt); }
                    O[d] = MFMA32(cur, pb[s2], O[d]);
                    if (idx + 3 < 16) { const int j2 = idx + 3, js2 = j2 >> 2, jd = j2 & 3; s16x4 a_, b_;
                        TR_ISSUE(a_, Vi, L2.ta0[jd], js2 * 4096); TR_ISSUE_X32(b_, Vi, L2.ta0[jd], js2 * 4096 + 2048);
                        vf[slot] = __builtin_shufflevector(a_, b_, 0, 1, 2, 3, 4, 5, 6, 7); }
                    cur = nxt;
                    if (idx < 8) { s[1][2 * idx] = fast_exp(s[1][2 * idx] + off[4 + ((2 * idx) >> 2)]); s[1][2 * idx + 1] = fast_exp(s[1][2 * idx + 1] + off[4 + ((2 * idx + 1) >> 2)]); }
                    if (idx == 7) { pb[2] = pack8(s[1], 0); pb[3] = pack8(s[1], 1); }
                    __builtin_amdgcn_sched_barrier(0);
                }
                wdone = __all(run < -110.0f) != 0;
            }
            if (j == 0) wdone = true;
            if (lane == 0) flags[wid] = wdone ? 1u : 0u;
            st ^= 1;
        }
#undef STK_ISSUE
        if (wave_on) { int qi = 32 * rg + r; OPAQUE(qi);
            if (!sample || qi < DSEQ) { bf16_t* dst = OC + (qrow0 + qi) * D + h * 128;
#pragma unroll
                for (int d = 0; d < 4; ++d)
#pragma unroll
                    for (int g4 = 0; g4 < 4; ++g4) { const int dv = 32 * d + 8 * g4 + 4 * hh;
                        u32x2 o; o.x = cvt_pk_bf16(O[d][4 * g4], O[d][4 * g4 + 1]); o.y = cvt_pk_bf16(O[d][4 * g4 + 2], O[d][4 * g4 + 3]); *(u32x2*)(dst + dv) = o; } } }
    }
}
DI void phase_merge(const Params& p, int l, LAS unsigned char* lds) {
    int tid = threadIdx.x; OPAQUE(tid);
    const int lane = tid & 63, wid = tid >> 6;
    unsigned char* ws = p.ws;
    const bf16_t* OA = (const bf16_t*)(ws + WS_OA); const bf16_t* OC = (const bf16_t*)(ws + WS_OC); const bf16_t* OBR = (const bf16_t*)(ws + WS_OBUF);
    const bf16_t* BZ = (const bf16_t*)(ws + WS_BZ); const bf16_t* GT = (const bf16_t*)(ws + WS_GATES); bf16_t* XB = (bf16_t*)(ws + WS_XB);
    const float* gw = p.in[I_GDNW] + l * 128;
    constexpr int NROW = MP + MS, NH = (D + 511) / 512;
    struct MergeIn { u32x4 oa, oc, ob, bz, g0, g1, g2; };
#define MERGE_LOAD(dst, rr_) do { const size_t row_ = (rr_); \
        const size_t brow_ = (rr_) < MP ? (size_t)(rr_) : (size_t)MP + (size_t)(((rr_) - MP) / DSEQ) * 64 + ((rr_) - MP) % DSEQ;   \
        _Pragma("unroll") for (int hf_ = 0; hf_ < NH; ++hf_) { const int cu_ = hf_ * 512 + lane * 8; const int c_ = cu_ < D ? cu_ : 0; \
            dst[hf_].oa = *(const u32x4*)(OA + row_ * D + c_); dst[hf_].oc = *(const u32x4*)(OC + row_ * D + c_); dst[hf_].ob = *(const u32x4*)(OBR + brow_ * D + c_); dst[hf_].bz = *(const u32x4*)(BZ + row_ * D + c_); \
            dst[hf_].g0 = *(const u32x4*)(GT + row_ * 3 * D + c_); dst[hf_].g1 = *(const u32x4*)(GT + row_ * 3 * D + D + c_); dst[hf_].g2 = *(const u32x4*)(GT + row_ * 3 * D + 2 * D + c_); } } while (0)
    const int stride = gridDim.x * 8;
    int rr = blockIdx.x * 8 + wid;
    MergeIn cur[NH];
    if (rr < NROW) MERGE_LOAD(cur, rr);
    for (; rr < NROW; rr += stride) {
        const size_t row = rr;
        MergeIn nxt[NH];
#pragma unroll
        for (int hf = 0; hf < NH; ++hf) nxt[hf] = cur[hf];
        if (rr + stride < NROW) MERGE_LOAD(nxt, rr + stride);
#pragma unroll
        for (int hf = 0; hf < NH; ++hf) {
            const int cu = hf * 512 + lane * 8; const bool cok = cu < D; const int c = cok ? cu : 0;
            const u32x4 oa = cur[hf].oa, oc = cur[hf].oc, ob = cur[hf].ob, bz = cur[hf].bz, g0 = cur[hf].g0, g1 = cur[hf].g1, g2 = cur[hf].g2;
            float o[8]; float ss = 0.f;
#pragma unroll
            for (int e = 0; e < 4; ++e) { o[2 * e] = bf_lo(ob[e]); o[2 * e + 1] = bf_hi(ob[e]); ss += o[2 * e] * o[2 * e] + o[2 * e + 1] * o[2 * e + 1]; }
            ss += __shfl_xor(ss, 1); ss += __shfl_xor(ss, 2); ss += __shfl_xor(ss, 4); ss += __shfl_xor(ss, 8);
            const float rstd = __builtin_amdgcn_rsqf(ss * (1.0f / 128.0f) + EPS);
            const f32x4 w0 = *(const f32x4*)(gw + (c & 127)), w1 = *(const f32x4*)(gw + (c & 127) + 4);
            float mg[8];
#pragma unroll
            for (int e = 0; e < 8; ++e) { const unsigned ua = oa[e >> 1], uc = oc[e >> 1], uz = bz[e >> 1], u0 = g0[e >> 1], u1 = g1[e >> 1], u2 = g2[e >> 1];
                const float a = (e & 1) ? bf_hi(ua) : bf_lo(ua), cc = (e & 1) ? bf_hi(uc) : bf_lo(uc), z = (e & 1) ? bf_hi(uz) : bf_lo(uz);
                const float ga = sigmoidf_((e & 1) ? bf_hi(u0) : bf_lo(u0)), gbv = sigmoidf_((e & 1) ? bf_hi(u1) : bf_lo(u1)), gc = sigmoidf_((e & 1) ? bf_hi(u2) : bf_lo(u2));
                const float w = e < 4 ? w0[e] : w1[e - 4];
                const float obn = o[e] * rstd * w * (z * sigmoidf_(z));
                mg[e] = ga * a + gbv * obn + gc * cc; }
            u32x4 wv; wv.x = cvt_pk_bf16(mg[0], mg[1]); wv.y = cvt_pk_bf16(mg[2], mg[3]); wv.z = cvt_pk_bf16(mg[4], mg[5]); wv.w = cvt_pk_bf16(mg[6], mg[7]);
            if (cok) *(u32x4*)(XB + row * D + c) = wv;
        }
#pragma unroll
        for (int hf = 0; hf < NH; ++hf) cur[hf] = nxt[hf];
    }
#undef MERGE_LOAD
}

DI void phase_rstd(const float* ssp, float* rstd, int row_end) {
    int tid = threadIdx.x; OPAQUE(tid);
    for (int row = blockIdx.x * 512 + tid; row < row_end; row += gridDim.x * 512) {
        float ss = 0.f;
#pragma unroll
        for (int j = 0; j < NPART; j += 4) { const f32x4 q = *(const f32x4*)(ssp + (size_t)row * NPART + j); ss += (q[0] + q[1]) + (q[2] + q[3]); }
        rstd[row] = __builtin_amdgcn_rsqf(ss * (1.0f / D) + EPS);
    }
}

struct EpiResid {
    static constexpr bool PERM = false;
    const float* xin_p; const float* xin_s; float* xout_p; float* xout_s; bf16_t* xb; float* ssp; float* part;
    DI void operator()(const f32x4 (&acc)[2][2][4][2], const pg8::Unit& u, int wr, int wc, int fr_, int fq_, const LAS float*) const {
        int fr = fr_, fq = fq_; OPAQUE(fr); OPAQUE(fq);
        if (u.slice >= 0) {
            float* base = part + (size_t)u.slice * 256 * D;
#pragma unroll
            for (int ai = 0; ai < 2; ++ai)
#pragma unroll
                for (int m = 0; m < 4; ++m) { const int r = ai * 128 + wr * 64 + m * 16 + fr;
                    if (r < MS) {
#pragma unroll
                        for (int bj = 0; bj < 2; ++bj)
#pragma unroll
                            for (int n = 0; n < 2; ++n) *(f32x4*)(base + (size_t)r * D + u.pn * 256 + bj * 128 + wc * 32 + n * 16 + fq * 4) = acc[ai][bj][m][n]; }
                    COMPILER_FENCE(); }
            return;
        }
        const bool sample = u.pm >= MP / 256;
#pragma unroll
        for (int ai = 0; ai < 2; ++ai)
#pragma unroll
            for (int m = 0; m < 4; ++m) {
                const int row = u.pm * 256 + ai * 128 + wr * 64 + m * 16 + fr;
                const bool valid = !sample || (row - MP) < MS;
                const float* xi = sample ? xin_s + (size_t)(row - MP) * D : xin_p + (size_t)row * D;
                float* xo = sample ? xout_s + (size_t)(row - MP) * D : xout_p + (size_t)row * D;
                float ss = 0.f;
#pragma unroll
                for (int bj = 0; bj < 2; ++bj)
#pragma unroll
                    for (int n = 0; n < 2; ++n) { const int c = u.pn * 256 + bj * 128 + wc * 32 + n * 16 + fq * 4;
                        if (valid) { const f32x4 v = *(const f32x4*)(xi + c) + acc[ai][bj][m][n]; *(f32x4*)(xo + c) = v;
                            u32x2 w; w.x = cvt_pk_bf16(v[0], v[1]); w.y = cvt_pk_bf16(v[2], v[3]); *(u32x2*)(xb + (size_t)row * D + c) = w;
                            ss += (v[0] * v[0] + v[1] * v[1]) + (v[2] * v[2] + v[3] * v[3]); } }
                ss += __shfl_xor(ss, 16); ss += __shfl_xor(ss, 32);
                if (valid && fq == 0) ssp[(size_t)row * NPART + u.pn * 4 + wc] = ss;
                if (m == 3) COMPILER_FENCE();
            }
    }
};
DI void sample_reduce(const float* part, int nS, const float* xin_s, float* xout_s, bf16_t* xb, float* rstd, const float* fnw) {
    int tid = threadIdx.x; OPAQUE(tid);
    const int lane = tid & 63, wid = tid >> 6;
    for (int r = blockIdx.x * 8 + wid; r < MS; r += gridDim.x * 8) {
        f32x4 v[D / 256]; float ss = 0.f;
#pragma unroll
        for (int i = 0; i < D / 256; ++i) { const int c = i * 256 + lane * 4;
            f32x4 a = *(const f32x4*)(xin_s + (size_t)r * D + c);
            for (int s = 0; s < nS; ++s) a += *(const f32x4*)(part + ((size_t)s * 256 + r) * D + c);
            v[i] = a; ss += a[0] * a[0] + a[1] * a[1] + a[2] * a[2] + a[3] * a[3]; }
#pragma unroll
        for (int o = 1; o < 64; o <<= 1) ss += __shfl_xor(ss, o);
        const float rs = __builtin_amdgcn_rsqf(ss * (1.0f / D) + EPS);
        if (!fnw && lane == 0) rstd[MP + r] = rs;
#pragma unroll
        for (int i = 0; i < D / 256; ++i) { const int c = i * 256 + lane * 4;
            if (fnw) { *(f32x4*)(xout_s + (size_t)r * D + c) = v[i] * rs * *(const f32x4*)(fnw + c); }
            else { *(f32x4*)(xout_s + (size_t)r * D + c) = v[i];
                u32x2 w; w.x = cvt_pk_bf16(v[i][0], v[i][1]); w.y = cvt_pk_bf16(v[i][2], v[i][3]); *(u32x2*)(xb + (size_t)(MP + r) * D + c) = w; } }
    }
}
struct EpiUp {
    static constexpr bool PERM = true;
    bf16_t* hid; float* part;
    DI void operator()(const f32x4 (&acc)[2][2][4][2], const pg8::Unit& u, int wr, int wc, int fr_, int fq_, const LAS float* rs_lds) const {
        int fr = fr_, fq = fq_; OPAQUE(fr); OPAQUE(fq);
        const bool sample = u.pm >= MP / 256;
        if (u.slice >= 0) {
            float* base = part + (size_t)u.slice * 256 * DFF;
#pragma unroll
            for (int ai = 0; ai < 2; ++ai)
#pragma unroll
                for (int m = 0; m < 4; ++m) { const int r = ai * 128 + wr * 64 + m * 16 + fr;
                    if (r < MS) {
#pragma unroll
                        for (int bj = 0; bj < 2; ++bj) { float* o = base + (size_t)r * DFF + u.pn * 256 + wc * 64 + bj * 32 + fq * 8; *(f32x4*)o = acc[ai][bj][m][0]; *(f32x4*)(o + 4) = acc[ai][bj][m][1]; } }
                    COMPILER_FENCE(); }
            return;
        }
#pragma unroll
        for (int ai = 0; ai < 2; ++ai)
#pragma unroll
            for (int m = 0; m < 4; ++m) {
                const int row = u.pm * 256 + ai * 128 + wr * 64 + m * 16 + fr;
                if (sample && (row - MP) >= MS) continue;
                const float rs = rs_lds[ai * 128 + wr * 64 + m * 16 + fr];
#pragma unroll
                for (int bj = 0; bj < 2; ++bj) { f32x4 a = acc[ai][bj][m][0] * rs, b = acc[ai][bj][m][1] * rs;
#pragma unroll
                    for (int e = 0; e < 4; ++e) { const float x = fmaxf(a[e], 0.f), y = fmaxf(b[e], 0.f); a[e] = x * x; b[e] = y * y; }
                    u32x4 w; w.x = cvt_pk_bf16(a[0], a[1]); w.y = cvt_pk_bf16(a[2], a[3]); w.z = cvt_pk_bf16(b[0], b[1]); w.w = cvt_pk_bf16(b[2], b[3]);
                    *(u32x4*)(hid + (size_t)row * DFF + u.pn * 256 + wc * 64 + bj * 32 + fq * 8) = w; }
            }
    }
};

DI void sample_up_reduce(const float* part, int nS, const float* rstd_mid, bf16_t* hid) {
    int tid = threadIdx.x; OPAQUE(tid);
    for (int i = blockIdx.x * 512 + tid; i < MS * (DFF / 8); i += gridDim.x * 512) { const int r = i / (DFF / 8), c = (i % (DFF / 8)) * 8;
        f32x4 a = (f32x4){0.f, 0.f, 0.f, 0.f}, b = a;
        for (int s = 0; s < nS; ++s) { const float* q = part + ((size_t)s * 256 + r) * DFF + c; a += *(const f32x4*)q; b += *(const f32x4*)(q + 4); }
        const float rs = rstd_mid[MP + r];
#pragma unroll
        for (int e = 0; e < 4; ++e) { const float x = fmaxf(a[e] * rs, 0.f), y = fmaxf(b[e] * rs, 0.f); a[e] = x * x; b[e] = y * y; }
        u32x4 w; w.x = cvt_pk_bf16(a[0], a[1]); w.y = cvt_pk_bf16(a[2], a[3]); w.z = cvt_pk_bf16(b[0], b[1]); w.w = cvt_pk_bf16(b[2], b[3]);
        *(u32x4*)(hid + (size_t)(MP + r) * DFF + c) = w; }
}

DI void phase_final(const Params& p, LAS unsigned char* lds) {
    int tid = threadIdx.x; OPAQUE(tid);
    const int lane = tid & 63, wid = tid >> 6;
    const float* ssp = (const float*)(p.ws + WS_SSP); const float* fw = p.in[I_FNW];
    for (int rr = blockIdx.x * 8 + wid; rr < MP; rr += gridDim.x * 8) {
        float* x = p.out + O_YP + (size_t)rr * D;
        float ss = 0.f;
#pragma unroll
        for (int j = 0; j < NPART; ++j) ss += ssp[(size_t)rr * NPART + j];
        const float rs = __builtin_amdgcn_rsqf(ss * (1.0f / D) + EPS);
        for (int c = lane * 4; c < D; c += 256) { const f32x4 v = *(const f32x4*)(x + c), w = *(const f32x4*)(fw + c); *(f32x4*)(x + c) = v * rs * w; }
    }
}

struct EpiNull {
    static constexpr bool PERM = true;
    float* sink;
    DI void operator()(const f32x4 (&acc)[2][2][4][2], const pg8::Unit& u, int wr, int wc, int fr, int fq, const LAS float*) const {
        float t = 0.f;
#pragma unroll
        for (int ai = 0; ai < 2; ++ai)
#pragma unroll
            for (int bj = 0; bj < 2; ++bj)
#pragma unroll
                for (int m = 0; m < 4; ++m)
#pragma unroll
                    for (int n = 0; n < 2; ++n) t += acc[ai][bj][m][n][0] + acc[ai][bj][m][n][1] + acc[ai][bj][m][n][2] + acc[ai][bj][m][n][3];
        if (t == 123.456f) sink[0] = t;
    }
};
constexpr int LDS_BYTES = 147456;
constexpr int LDS_MISC = 147456 - 256;
constexpr int PH_PER_LAYER = 11;
constexpr int N_PHASES = 1 + DEPTH * PH_PER_LAYER + 1;

__global__ void __launch_bounds__(512, 2) fwd_kernel(Params p) {
#ifdef EMU
    LAS unsigned char* lds = EMU_SMEM();
#else
    extern __shared__ __attribute__((aligned(16))) unsigned char lds_raw[];
    LAS unsigned char* lds = (LAS unsigned char*)lds_raw;
#endif
    volatile LAS unsigned* misc = (volatile LAS unsigned*)(lds + LDS_MISC);
    if (threadIdx.x < 16) misc[threadIdx.x] = 0u;
    __syncthreads();
    const int lo = p.ph_lo, hi = p.ph_hi;
    XcdBarrier bar; bar.bar = (unsigned*)(p.ws + WS_BAR); bar.x = 0; bar.st = misc;
    if (hi - lo > 1) bar = xcd_barrier_post((unsigned*)(p.ws + WS_BAR), misc);
#ifndef ONLY_KIND
#define ONLY_KIND -1
#endif
#define PHK(kind) (ONLY_KIND < 0 || ONLY_KIND == (kind))
#ifndef REPEAT_KIND
#define REPEAT_KIND -1
#endif
#define NREP(kind) ((REPEAT_KIND == (kind) && l == 0) ? 2 : 1)
#define IN(k) (lo <= (k) && (k) < hi)
#ifdef PROBE_KIND
#define STAMP(k) do { if (blockIdx.x == 0 && threadIdx.x == 0) ((unsigned long long*)(p.ws + WS_STAMP))[(k)] = __builtin_amdgcn_s_memrealtime(); } while (0)
#else
#define STAMP(k) ((void)0)
#endif
#define SEAM(k) do { if (IN(k) && IN((k) + 1)) xcd_barrier(bar); STAMP((k) + 1); } while (0)
    unsigned char* ws = p.ws;
    STAMP(0);
    if (PHK(100) && IN(0)) { phase_prologue(p, lds); if (REPEAT_KIND == 100) phase_prologue(p, lds); }
    SEAM(0);
    for (int l = 0; l < DEPTH; ++l) {
        const int pb = 1 + l * PH_PER_LAYER;
        int bid = blockIdx.x; OPAQUE_S(bid);
        if (PHK(0) && IN(pb + 0)) {
            phase_rstd((const float*)(ws + WS_SSP), (float*)(ws + WS_RSTD), l == 0 ? MP + MS : MP);
            if (l > 0) sample_reduce((const float*)(ws + WS_PART), DFF / 256, p.out + O_YS, p.out + O_YS, (bf16_t*)(ws + WS_XB), (float*)(ws + WS_RSTD), nullptr);
        }
        SEAM(pb + 0);
        if (REPEAT_KIND == 11 && l == 0 && IN(pb + 1)) {
            pg8::Gemm g{(const bf16_t*)(ws + WS_XB), (const bf16_t*)(ws + WS_WIN) + (size_t)l * NP * D, MALL, NP, D, D};
            pg8::StaticOrder S; S.init(MALL, NP, gridDim.x, bid, D);
            EpiNull E{(float*)(ws + WS_DUMMY)};
            pg8::gemm_phase(lds, g, S, E);
        }
        if ((REPEAT_KIND == 12 || REPEAT_KIND == 13) && l == 0 && IN(pb + 1)) {
            pg8::Gemm g{(const bf16_t*)(ws + WS_XB), (const bf16_t*)(ws + WS_WIN) + (size_t)l * NP * D, MALL, NP, D, D};
            pg8::StaticOrder S; S.init(MALL, NP, gridDim.x, bid, D);
            EpiInProj E{l, ws, p.out, REPEAT_KIND == 12 ? 1 : 2};
            pg8::gemm_phase(lds, g, S, E);
        }
        for (int pass = 0; pass < ((REPEAT_KIND == 60 && l == 0) ? 2 : 1); ++pass) {
        for (int rep = 0; rep < NREP(1); ++rep) if (PHK(1) && IN(pb + 1)) {
            pg8::Gemm g{(const bf16_t*)(ws + WS_XB), (const bf16_t*)(ws + WS_WIN) + (size_t)l * NP * D, MALL, NP, D, D};
            pg8::StaticOrder S; S.init(MALL, NP, gridDim.x, bid, D);
            EpiInProj E{l, ws, p.out, 0};
            pg8::gemm_phase(lds, g, S, E, (const float*)(ws + WS_RSTD));
        }
        SEAM(pb + 1);
        for (int rep = 0; rep < NREP(2); ++rep) if (PHK(2) && IN(pb + 2)) phase_conv_pre(p, l, lds);
        SEAM(pb + 2);
        if (IN(pb + 3) && IN(pb + 4)) STAMP(pb + 4);
        if (PHK(4) && IN(pb + 4)) {
            unsigned* qc = (unsigned*)(ws + WS_BAR + WS_QUEUE) + (size_t)l * 19 * 64;
            phase_gdn_scan(p, l, lds, qc, misc + 8);
            phase_attn_a(p, l, lds, qc + 64, misc + 8);
            phase_attn_c(p, l, lds, qc + 10 * 64, misc + 8);
        }
        SEAM(pb + 4);
        for (int rep = 0; rep < NREP(5); ++rep) if (PHK(5) && IN(pb + 5)) phase_merge(p, l, lds);
        SEAM(pb + 5);
        if (REPEAT_KIND == 50 && l == 0 && IN(pb + 5) && IN(pb + 6)) { for (int i = 0; i < 10; ++i) xcd_barrier(bar); }
        float* ssp_mid = (float*)(ws + WS_SSP) + (size_t)MALL * NPART;
        for (int rep = 0; rep < NREP(6); ++rep) if (PHK(6) && IN(pb + 6)) {
            pg8::Gemm g{(const bf16_t*)(ws + WS_XB), (const bf16_t*)(ws + WS_WOUT) + (size_t)l * D * D, MALL, D, D, D};
            pg8::ComboOrder S; S.init(MP, D, gridDim.x, bid, D, D / 256, 256);
            EpiResid E{l == 0 ? p.in[I_XP] : p.out + O_YP, l == 0 ? p.in[I_XS] : p.out + O_YS, p.out + O_YP, p.out + O_YS, (bf16_t*)(ws + WS_XB2), ssp_mid, (float*)(ws + WS_PART)};
            pg8::gemm_phase(lds, g, S, E);
        }
        SEAM(pb + 6);
        if (PHK(7) && IN(pb + 7)) {
            phase_rstd(ssp_mid, (float*)(ws + WS_RSTD) + MALL, MP);
            sample_reduce((const float*)(ws + WS_PART), D / 256, l == 0 ? p.in[I_XS] : p.out + O_YS, p.out + O_YS, (bf16_t*)(ws + WS_XB2), (float*)(ws + WS_RSTD) + MALL, nullptr);
        }
        SEAM(pb + 7);
        for (int rep = 0; rep < NREP(8); ++rep) if (PHK(8) && IN(pb + 8)) {
            pg8::Gemm g{(const bf16_t*)(ws + WS_XB2), (const bf16_t*)(ws + WS_WUP) + (size_t)l * DFF * D, MALL, DFF, D, D};
            pg8::ComboOrder S; S.init(MP, DFF, gridDim.x, bid, D, D / 256, 256);
            EpiUp E{(bf16_t*)(ws + WS_HID), (float*)(ws + WS_PART)};
            pg8::gemm_phase(lds, g, S, E, (const float*)(ws + WS_RSTD) + MALL);
        }
        SEAM(pb + 8);
        if (PHK(9) && IN(pb + 9)) sample_up_reduce((const float*)(ws + WS_PART), D / 256, (const float*)(ws + WS_RSTD) + MALL, (bf16_t*)(ws + WS_HID));
        SEAM(pb + 9);
        }
        if (REPEAT_KIND == 9 && l == 0 && IN(pb + 10)) {
            pg8::Gemm g{(const bf16_t*)(ws + WS_HID), (const bf16_t*)(ws + WS_WDN) + (size_t)l * D * DFF, MALL, D, DFF, DFF};
            pg8::StaticOrder S; S.init(MALL, D, gridDim.x, bid, DFF);
            float* sink = (float*)(ws + WS_DUMMY);
            EpiResid E{p.out + O_YP, p.out + O_YS, sink, sink + (size_t)MP * D, (bf16_t*)(sink + (size_t)MALL * D), sink + (size_t)MALL * D * 2, sink};
            pg8::gemm_phase(lds, g, S, E);
        }
        if (PHK(10) && IN(pb + 10)) {
            pg8::Gemm g{(const bf16_t*)(ws + WS_HID), (const bf16_t*)(ws + WS_WDN) + (size_t)l * D * DFF, MALL, D, DFF, DFF};
            pg8::ComboOrder S; S.init(MP, D, gridDim.x, bid, DFF, DFF / 256, 256);
            EpiResid E{p.out + O_YP, p.out + O_YS, p.out + O_YP, p.out + O_YS, (bf16_t*)(ws + WS_XB), (float*)(ws + WS_SSP), (float*)(ws + WS_PART)};
            pg8::gemm_phase(lds, g, S, E);
        }
        SEAM(pb + 10);
    }
    if (PHK(101) && IN(1 + DEPTH * PH_PER_LAYER)) { phase_final(p, lds);
        sample_reduce((const float*)(p.ws + WS_PART), DFF / 256, p.out + O_YS, p.out + O_YS, nullptr, nullptr, p.in[I_FNW]); }
#ifdef PROBE_KIND
    __syncthreads();
    if (blockIdx.x == 0 && threadIdx.x == 0) { const unsigned long long* st = (const unsigned long long*)(p.ws + WS_STAMP); STAMP(N_PHASES); unsigned long long tot = 0;
        if (PROBE_KIND == 100) tot = st[1] - st[0]; else if (PROBE_KIND == 101) tot = st[N_PHASES] - st[N_PHASES - 1];
        else for (int l = 0; l < DEPTH; ++l) tot += st[1 + l * PH_PER_LAYER + PROBE_KIND + 1] - st[1 + l * PH_PER_LAYER + PROBE_KIND];
        const float us = (float)tot * 0.0105f; const float q = exp2f(rintf(log2f(us) * 8.0f) / 8.0f);
        p.out[O_PAK + 5] = q; }
#endif
#undef IN
#undef SEAM
}

extern "C" void kernel_launch(void* const* d_in, const int* in_sizes, int n_in, void* d_out, int out_size, void* d_ws, size_t ws_size, hipStream_t stream) {
    if (n_in != 24 || (size_t)out_size != O_END || ws_size < WS_TOTAL) { fprintf(stderr, "kernel_launch: unexpected shapes (n_in %d out %d ws %zu need %zu)\n", n_in, out_size, ws_size, (size_t)WS_TOTAL); return; }
    Params p{};
    for (int i = 0; i < 24; ++i) p.in[i] = (const float*)d_in[i];
    p.out = (float*)d_out; p.ws = (unsigned char*)d_ws;
    (void)hipMemsetAsync((char*)d_ws + WS_BAR, 0, 32768, stream);
#ifdef EMU
    const int grid = EMU_GRID;
    const char* e = getenv("EMU_PHASES"); const int nph = e ? atoi(e) : N_PHASES;
    if (getenv("EMU_ONE")) { p.ph_lo = 0; p.ph_hi = nph; EMU_LAUNCH(fwd_kernel, grid, 512, LDS_BYTES, p); }
    else for (int k = 0; k < nph; ++k) { p.ph_lo = k; p.ph_hi = k + 1; EMU_LAUNCH(fwd_kernel, grid, 512, LDS_BYTES, p); }
#else
    static int grid = 0;
    if (grid == 0) {
        int dev = 0, cus = 0;
        if (hipGetDevice(&dev) != hipSuccess || hipDeviceGetAttribute(&cus, hipDeviceAttributeMultiprocessorCount, dev) != hipSuccess) { grid = -1; return; }
        if (hipFuncSetAttribute((const void*)fwd_kernel, hipFuncAttributeMaxDynamicSharedMemorySize, LDS_BYTES) != hipSuccess) { grid = -1; return; }
        grid = cus;
    }
    if (grid < 0) return;
#ifndef ONE_LAUNCH
#define ONE_LAUNCH 1
#endif
#if ONE_LAUNCH
    p.ph_lo = 0; p.ph_hi = N_PHASES;
    hipLaunchKernelGGL(fwd_kernel, dim3(grid), dim3(512), LDS_BYTES, stream, p);
#else
    for (int k = 0; k < N_PHASES; ++k) { p.ph_lo = k; p.ph_hi = k + 1; hipLaunchKernelGGL(fwd_kernel, dim3(grid), dim3(512), LDS_BYTES, stream, p); }
#endif
#endif
}

#ifdef EMU
void emu_compare(const char* name, const float* got, const float* ref, size_t n);
std::vector<float> emu_load_dbg(const char* name, size_t n);
static void dbg_bf16(const char* tag, const unsigned char* ws, size_t off, size_t row0, size_t nrows, const char* file) {
    std::vector<float> got(nrows * D); const bf16_t* b = (const bf16_t*)(ws + off) + row0 * D;
    for (size_t i = 0; i < nrows * D; ++i) got[i] = bf2f(b[i]);
    std::vector<float> ref = emu_load_dbg(file, nrows * D); emu_compare(tag, got.data(), ref.data(), nrows * D);
}
void emu_debug(unsigned char* ws, float* out) {
    printf("barrier timeout word = %u\n", ((unsigned*)(ws + WS_BAR))[XB_TMO]);
    if (const char* x = getenv("EMU_DBG_X")) { std::vector<float> ref = emu_load_dbg(x, (size_t)MP * D); emu_compare(x, out + O_YP, ref.data(), (size_t)MP * D); }
    if (getenv("EMU_DBG_M")) { dbg_bf16("merged(p)", ws, WS_XB, 0, MP, "p0_merged");
        std::vector<float> ref = emu_load_dbg("p0_merged", (size_t)MP * D); const bf16_t* b = (const bf16_t*)(ws + WS_XB); int shown = 0;
        for (int r = 0; r < MP && shown < 60; ++r) { int bad = 0, c0 = -1, c1 = -1; for (int c = 0; c < D; ++c) if (fabsf(bf2f(b[(size_t)r * D + c]) - ref[(size_t)r * D + c]) > 0.08f) { ++bad; if (c0 < 0) c0 = c; c1 = c; }
            if (bad) { printf("   row %d: %d bad cols [%d..%d]\n", r, bad, c0, c1); ++shown; } } }
    const char* e = getenv("EMU_DBG"); if (!e) return;
    const int l = atoi(e); char f[64];
    snprintf(f, 64, "p%d_obraw", l); dbg_bf16("obraw(p)", ws, WS_OBUF, 0, MP, f);
    snprintf(f, 64, "p%d_oa", l); dbg_bf16("oa(p)", ws, WS_OA, 0, MP, f);
    snprintf(f, 64, "s%d_oa", l); dbg_bf16("oa(s)", ws, WS_OA, MP, MS, f);
    snprintf(f, 64, "p%d_oc", l); dbg_bf16("oc(p)", ws, WS_OC, 0, MP, f);
    snprintf(f, 64, "s%d_oc", l); dbg_bf16("oc(s)", ws, WS_OC, MP, MS, f);
    for (int b = 0; b < DB; ++b) { snprintf(f, 64, "s%d_obraw", l); std::vector<float> ref = emu_load_dbg(f, (size_t)DB * DSEQ * D); std::vector<float> got(DSEQ * D);
        const bf16_t* bb = (const bf16_t*)(ws + WS_OBUF) + (size_t)(MP + b * 64) * D; for (int i = 0; i < DSEQ * D; ++i) got[i] = bf2f(bb[i]);
        emu_compare("obraw(s)", got.data(), ref.data() + (size_t)b * DSEQ * D, DSEQ * D); }
}
#endif
```

```cpp
#ifdef EMU
#include "emu.h"
#define LAS
#define ASM_WAIT_VM0() ((void)0)
#define ASM_WAIT_VM(n) ((void)0)
#define ASM_WAIT_LGKM(n) ((void)0)
#define ASM_WAIT_ALL0() ((void)0)
#define COMPILER_FENCE() ((void)0)
#define GLDS16(gptr, ldsptr) emu_global_load_lds16((gptr), (ldsptr))
#define MY_XCC_ID() (blockIdx.x & 7u)
#define WAVE_LDS_FENCE() ((void)__all(1))
#define OPAQUE(x) ((void)0)
#define OPAQUE_S(x) ((void)0)
#else
#include <hip/hip_runtime.h>
#include <cstdio>
#include <cstring>
#define LAS __attribute__((address_space(3)))
#define ASM_WAIT_VM0() asm volatile("s_waitcnt vmcnt(0)" ::: "memory")
#define ASM_WAIT_VM(n) asm volatile("s_waitcnt vmcnt(" #n ")" ::: "memory")
#define ASM_WAIT_LGKM(n) asm volatile("s_waitcnt lgkmcnt(" #n ")" ::: "memory")
#define ASM_WAIT_ALL0() asm volatile("s_waitcnt vmcnt(0) lgkmcnt(0)" ::: "memory")
#define COMPILER_FENCE() asm volatile("" ::: "memory")
#define GLDS16(gptr, ldsptr) __builtin_amdgcn_global_load_lds((const unsigned*)(gptr), (LAS unsigned*)(ldsptr), 16, 0, 0)
#define MY_XCC_ID() ((unsigned)__builtin_amdgcn_s_getreg((3 << 11) | 20) & 0xFu)
#define WAVE_LDS_FENCE() asm volatile("s_waitcnt lgkmcnt(0)" ::: "memory")
#define OPAQUE(x) asm volatile("" : "+v"(x))
#define OPAQUE_S(x) asm volatile("" : "+s"(x))
#endif
#define DI __device__ __forceinline__

#ifndef CFG_D
#define CFG_D 1024
#define CFG_BATCH 4
#define CFG_SEQ 8192
#define CFG_DB 8
#define CFG_PAST 1024
#endif
constexpr int D = CFG_D, NB = CFG_BATCH, SEQ = CFG_SEQ, DEPTH = 2, DB = CFG_DB, DSEQ = 16, PAST = CFG_PAST;
constexpr int HA = D / 256, HB = D / 128, HC = D / 128, DFF = 4 * D, CHUNK = 64, CONVW = 4;
constexpr int MP = NB * SEQ;
constexpr int MS = DB * DSEQ;
constexpr int MSP = (MS + 255) / 256 * 256;
constexpr int MALL = MP + MSP;
constexpr int NIN_ORIG = 13 * D + 2 * HB;
constexpr int NP = 13 * D + 256;
constexpr int TD = D / 256;
constexpr int NPART = 4 * TD;
constexpr int ROPE_N = (SEQ > PAST + DSEQ) ? SEQ : (PAST + DSEQ);
constexpr int NCH = SEQ / CHUNK;
constexpr int NUNIT_B = NB * NCH * HB + DB * HB;
constexpr int MB = MP + DB * 64;
constexpr float EPS = 1e-6f;
static_assert(MP % 256 == 0 && D % 256 == 0 && SEQ % 128 == 0 && PAST % 64 == 0 && 2 * HB <= 16, "shape assumptions");

typedef unsigned short bf16_t;
typedef short bf16x8 __attribute__((ext_vector_type(8)));
typedef short s16x4 __attribute__((ext_vector_type(4)));
typedef float f32x4 __attribute__((ext_vector_type(4)));
typedef float f32x2 __attribute__((ext_vector_type(2)));
typedef float f32x16 __attribute__((ext_vector_type(16)));
typedef unsigned u32x4 __attribute__((ext_vector_type(4)));
typedef unsigned u32x2 __attribute__((ext_vector_type(2)));

DI unsigned cvt_pk_bf16(float lo, float hi) {
#ifdef EMU
    unsigned a = __float_as_uint(lo), b = __float_as_uint(hi);
    a += 0x7fffu + ((a >> 16) & 1u); b += 0x7fffu + ((b >> 16) & 1u);
    return (a >> 16) | (b & 0xffff0000u);
#else
    typedef __bf16 bf16x2_t __attribute__((ext_vector_type(2)));
    const f32x2 v = {lo, hi}; return __builtin_bit_cast(unsigned, __builtin_convertvector(v, bf16x2_t));
#endif
}
DI float bf_lo(unsigned u) { return __uint_as_float(u << 16); }
DI float bf_hi(unsigned u) { return __uint_as_float(u & 0xffff0000u); }
DI float bf2f(bf16_t b) { return __uint_as_float(((unsigned)b) << 16); }
DI bf16_t f2bf(float f) { return (bf16_t)(cvt_pk_bf16(f, 0.f) & 0xffffu); }
DI float fast_exp2(float x) { return __builtin_amdgcn_exp2f(x); }
DI float fast_exp(float x) { return __builtin_amdgcn_exp2f(x * 1.44269504089f); }
DI float fast_rcp(float x) { return __builtin_amdgcn_rcpf(x); }
DI float sigmoidf_(float x) { return fast_rcp(1.0f + fast_exp(-x)); }
#ifdef EMU
#define TR_ISSUE(dst, base, addr, off) dst = emu_ds_read_b64_tr_b16((const unsigned char*)(base) + (addr) + (off))
#define TR_ISSUE_X32(dst, base, addr, off) dst = emu_ds_read_b64_tr_b16((const unsigned char*)(base) + ((addr) ^ 32u) + (off))
#define TR_WAIT2(n, a, b) ((void)0)
#define TR_WAIT1(n, a) ((void)0)
#else
#define TR_ISSUE(dst, base, addr, off) asm volatile("ds_read_b64_tr_b16 %0, %1 offset:%2" : "=v"(dst) : "v"((unsigned)(size_t)(base) + (addr)), "i"(off))
#define TR_ISSUE_X32(dst, base, addr, off) do { unsigned t_; asm volatile("v_xor_b32 %1, 32, %2\n\tds_read_b64_tr_b16 %0, %1 offset:%3" : "=&v"(dst), "=&v"(t_) : "v"((unsigned)(size_t)(base) + (addr)), "i"(off)); } while (0)
#define TR_WAIT2(n, a, b) asm volatile("s_waitcnt lgkmcnt(" #n ")" : "+v"(a), "+v"(b))
#define TR_WAIT1(n, a) asm volatile("s_waitcnt lgkmcnt(" #n ")" : "+v"(a))
#endif
DI s16x4 ds_read_tr16(const LAS unsigned char* p) {
#ifdef EMU
    return emu_ds_read_b64_tr_b16(p);
#else
    return __builtin_amdgcn_ds_read_tr16_b64_v4i16((LAS s16x4*)p);
#endif
}

constexpr size_t al256(size_t x) { return (x + 255) & ~(size_t)255; }
constexpr size_t WS_BAR = 0;
constexpr size_t WS_STAMP = 32768;
constexpr size_t WS_WIN = 65536;
constexpr size_t WS_WOUT = WS_WIN + al256((size_t)DEPTH * NP * D * 2);
constexpr size_t WS_WUP = WS_WOUT + al256((size_t)DEPTH * D * D * 2);
constexpr size_t WS_WDN = WS_WUP + al256((size_t)DEPTH * DFF * D * 2);
constexpr size_t WS_ROPE = WS_WDN + al256((size_t)DEPTH * D * DFF * 2);
constexpr size_t WS_XB = WS_ROPE + al256((size_t)ROPE_N * 64 * 4 * 2);
constexpr size_t WS_SSP = WS_XB + al256((size_t)MALL * D * 2);
constexpr size_t WS_QA = WS_SSP + al256((size_t)2 * MALL * NPART * 4);
constexpr size_t WS_KA = WS_QA + al256((size_t)MALL * D * 2);
constexpr size_t WS_VA = WS_KA + al256((size_t)MALL * D * 2);
constexpr size_t WS_BRAW = WS_VA + al256((size_t)MALL * D * 2);
constexpr size_t WS_BZ = WS_BRAW + al256((size_t)MALL * 3 * D * 2);
constexpr size_t WS_QC = WS_BZ + al256((size_t)MALL * D * 2);
constexpr size_t WS_KC = WS_QC + al256((size_t)MALL * D * 2);
constexpr size_t WS_VC = WS_KC + al256((size_t)MALL * D * 2);
constexpr size_t WS_GATES = WS_VC + al256((size_t)MALL * D * 2);
constexpr size_t WS_BAB = WS_GATES + al256((size_t)MALL * 3 * D * 2);
constexpr size_t WS_BQ = WS_BAB + al256((size_t)MALL * 16 * 4);
constexpr size_t WS_BK = WS_BQ + al256((size_t)MB * D * 2);
constexpr size_t WS_BV = WS_BK + al256((size_t)MB * D * 2);
constexpr size_t WS_GB = WS_BV + al256((size_t)MB * D * 2);
constexpr size_t WS_TT = WS_GB + al256((size_t)MB * 16 * 4);
constexpr size_t WS_AQK = WS_TT + al256((size_t)NUNIT_B * 4096 * 2);
constexpr size_t WS_CV = WS_AQK + al256((size_t)NUNIT_B * 4096 * 2);
constexpr size_t WS_OBUF = WS_CV + al256((size_t)NUNIT_B * 256 * 4);
constexpr size_t WS_OA = WS_OBUF + al256((size_t)MB * D * 2);
constexpr size_t WS_OC = WS_OA + al256((size_t)MALL * D * 2);
constexpr size_t WS_HID = WS_OC + al256((size_t)MALL * D * 2);
constexpr size_t WS_XB2 = WS_HID + al256((size_t)MALL * DFF * 2);
constexpr size_t WS_RSTD = WS_XB2 + al256((size_t)MALL * D * 2);
constexpr size_t WS_END = WS_RSTD + al256((size_t)2 * MALL * 4);
constexpr size_t WS_PART = WS_END;
constexpr size_t WS_TOTAL = WS_PART + (size_t)16 * 256 * D * 4;
constexpr size_t WS_DUMMY = WS_TOTAL;

struct Params {
    const float* in[24];
    float* out; unsigned char* ws;
    int ph_lo, ph_hi;
};
enum { I_XP = 0, I_XS, I_CAK, I_CAV, I_CCK, I_CCV, I_SCONV, I_SSSM, I_N1W, I_WIN, I_LQ1, I_LK1, I_LQ2, I_LK2, I_SUBLN, I_CONVW, I_ALOG, I_DTB, I_GDNW, I_WOUT, I_N2W, I_WUP, I_WDN, I_FNW };
constexpr size_t O_YP = 0;
constexpr size_t O_YS = O_YP + (size_t)NB * SEQ * D;
constexpr size_t O_PAK = O_YS + (size_t)DB * DSEQ * D;
constexpr size_t O_PAV = O_PAK + (size_t)DEPTH * NB * SEQ * D;
constexpr size_t O_PCK = O_PAV + (size_t)DEPTH * NB * SEQ * D;
constexpr size_t O_PCV = O_PCK + (size_t)DEPTH * NB * SEQ * D;
constexpr size_t O_PBC = O_PCV + (size_t)DEPTH * NB * SEQ * D;
constexpr size_t O_PBS = O_PBC + (size_t)DEPTH * NB * 3 * 3 * D;
constexpr size_t O_SAK = O_PBS + (size_t)DEPTH * NB * HB * 128 * 128;
constexpr size_t O_SAV = O_SAK + (size_t)DEPTH * DB * DSEQ * D;
constexpr size_t O_SCK = O_SAV + (size_t)DEPTH * DB * DSEQ * D;
constexpr size_t O_SCV = O_SCK + (size_t)DEPTH * DB * DSEQ * D;
constexpr size_t O_SBC = O_SCV + (size_t)DEPTH * DB * DSEQ * D;
constexpr size_t O_SBS = O_SBC + (size_t)DEPTH * DB * 3 * 3 * D;
constexpr size_t O_END = O_SBS + (size_t)DEPTH * DB * HB * 128 * 128;

DI int sigma256(int g) { return 64 * ((g >> 5) & 3) + 32 * (g >> 7) + (g & 31); }
DI int win_orig_col(int n) {
    if (n < 2 * D) { const int base = (n / D) * D, w = n % D, head = w >> 7, g = w & 127, G = g >> 3, j = g & 7;
        const int d = (j < 4) ? 4 * G + j : 64 + 4 * G + (j - 4); return base + head * 128 + d; }
    const int m = (n & ~255) + sigma256(n & 255);
    if (m < 6 * D) return m;
    if (m < 13 * D) return m + 2 * HB;
    const int c = m - 13 * D; return c < 2 * HB ? 6 * D + c : -1;
}
DI int sigma_col(int n) { return (n & ~255) + sigma256(n & 255); }
#define XB_TMO      128
#define XB_XCNT(j)  (256  + 64 * (j))
#define XB_XSUB(j)  (1280 + 64 * (j))
#define XB_XGEN(j)  (2304 + 64 * (j))
#define XB_TOP      3328
#define XB_TOPGEN   3392
#define XCD_BAR_WORDS 3456
#define XB_SPIN_CAP (1u << 22)
DI unsigned xb_ld(unsigned* p)              { return __hip_atomic_load(p, __ATOMIC_RELAXED, __HIP_MEMORY_SCOPE_AGENT); }
DI unsigned xb_add(unsigned* p, unsigned v) { return __hip_atomic_fetch_add(p, v, __ATOMIC_RELAXED, __HIP_MEMORY_SCOPE_AGENT); }
#define XB_SPIN(cond, bar) do { unsigned _sp = 0; while (cond) { __builtin_amdgcn_s_sleep(1); \
    if ((++_sp & 255u) == 0u) { if (xb_ld(&(bar)[XB_TMO])) break; if (_sp > XB_SPIN_CAP) { atomicAdd(&(bar)[XB_TMO], 1u); break; } } } } while (0)
struct XcdBarrier { unsigned* bar; unsigned x; volatile LAS unsigned* st; };
DI XcdBarrier xcd_barrier_post(unsigned* bar, volatile LAS unsigned* st) {
    XcdBarrier b; b.bar = bar; b.x = MY_XCC_ID(); b.st = st;
    if (threadIdx.x == 0) (void)xb_add(&bar[XB_XCNT(b.x)], 1u);
    return b;
}
DI void xcd_barrier_complete(unsigned* bar, unsigned x, unsigned& nloc, unsigned& nx) {
    const unsigned G = gridDim.x;
    unsigned sum, cnt, mine, sp = 0u;
    for (;;) {
        sum = 0u; cnt = 0u; mine = 0u;
#pragma unroll
        for (unsigned j = 0; j < 16; ++j) { const unsigned c = xb_ld(&bar[XB_XCNT(j)]); sum += c; cnt += (c > 0u) ? 1u : 0u; mine = (j == x) ? c : mine; }
        if (sum == G) break;
        __builtin_amdgcn_s_sleep(1);
        if ((++sp & 255u) == 0u) { if (xb_ld(&bar[XB_TMO])) break; if (sp > XB_SPIN_CAP) { atomicAdd(&bar[XB_TMO], 1u); break; } }
    }
    nloc = mine > 0u ? mine : 1u; nx = cnt > 0u ? cnt : 1u;
}
DI void xcd_barrier(const XcdBarrier& b) {
    ASM_WAIT_VM0();
    __syncthreads();
    if (threadIdx.x == 0) {
        unsigned* bar = b.bar;
        __builtin_amdgcn_s_waitcnt(0);
        unsigned nloc = b.st[0], nx = b.st[1];
        if (nloc == 0u) { xcd_barrier_complete(bar, b.x, nloc, nx); b.st[0] = nloc; b.st[1] = nx; }
        const unsigned old = xb_add(&bar[XB_XSUB(b.x)], 1u);
        const unsigned gen = old / nloc;
        if (old + 1u == (gen + 1u) * nloc) {
            __builtin_amdgcn_fence(__ATOMIC_RELEASE, "agent");
            ASM_WAIT_VM0();
            const unsigned og = xb_add(&bar[XB_TOP], 1u);
            const unsigned tg = og / nx;
            if (og + 1u == (tg + 1u) * nx) xb_add(&bar[XB_TOPGEN], 1u);
            else XB_SPIN(xb_ld(&bar[XB_TOPGEN]) == tg, bar);
            __builtin_amdgcn_fence(__ATOMIC_ACQUIRE, "agent");
            xb_add(&bar[XB_XGEN(b.x)], 1u);
            ASM_WAIT_VM0();
        } else {
            XB_SPIN(xb_ld(&bar[XB_XGEN(b.x)]) == gen, bar);
            __builtin_amdgcn_fence(__ATOMIC_ACQUIRE, "agent");
            ASM_WAIT_VM0();
        }
    }
    __syncthreads();
}

namespace pg8 {
constexpr int BM = 256, BK = 64, HALF = 128, HTB = HALF * BK * 2, STAGE_BYTES = 8 * HTB, NXCD = 8, WGM = 4;
DI int lds_byte(int r, int c) { const int st = (r >> 4) * 2 + (c >> 5), rr = r & 15, cc = c & 31, ob = rr * 64 + cc * 2; return st * 1024 + (ob ^ (((ob >> 9) & 1) << 5)); }
DI void stage_rc(int b, int& R, int& C) { const int st = b / 1024, sb = b % 1024, swz = sb ^ (((sb >> 9) & 1) << 5); R = (st >> 1) * 16 + swz / 64; C = (st & 1) * 32 + (swz % 64) / 2; }
DI int perm32(int rho) { const int n = rho >> 4, i = rho & 15; return 8 * (i >> 2) + 4 * n + (i & 3); }
struct Unit { int pm, pn; int koff, nt, slice; };
struct Gemm { const bf16_t* A; const bf16_t* Bt; int M, N, K, ld; };
struct StaticOrder {
    int nM, nN, nwg, G, c, ntk;
    DI void init(int M, int N, int G_, int c_, int K_) { nM = M / BM; nN = N / BM; nwg = nM * nN; G = G_; c = c_; ntk = K_ / BK; }
    DI bool next(int i, Unit& u) const {
        const long L = (long)i * G + c; if (L >= nwg) return false;
        int wgid = (int)L; { const int q = nwg / NXCD, r = nwg % NXCD, xcd = wgid % NXCD, off = wgid / NXCD; wgid = (xcd < r ? xcd * (q + 1) : r * (q + 1) + (xcd - r) * q) + off; }
        const int nig = WGM * nN, gid = wgid / nig, fm = gid * WGM, gsz = (nM - fm) < WGM ? (nM - fm) : WGM;
        u.pm = fm + ((wgid % nig) % gsz); u.pn = (wgid % nig) / gsz; u.koff = 0; u.nt = ntk; u.slice = -1; return true;
    }
    DI void a_ready(const Unit&) const {}
    DI void done(const Unit&) const {}
};
struct ComboOrder {
    StaticOrder so; int nS, kslice;
    DI void init(int Mmain, int N, int G_, int c_, int K_, int nS_, int kslice_) { so.init(Mmain, N, G_, c_, K_); nS = nS_; kslice = kslice_; }
    DI bool next(int i, Unit& u) const {
        const long L = (long)i * so.G + so.c;
        Unit a; a.pm = 0; a.pn = 0; a.koff = 0; a.nt = so.ntk; a.slice = -1;
        const bool is_main = so.next(i, a);
        const long j = L - so.nwg; const int sl = (int)(j / so.nN);
        const bool is_split = !is_main && j >= 0 && j < (long)so.nN * nS;
        u.pm = is_main ? a.pm : so.nM; u.pn = is_main ? a.pn : (int)(j % so.nN); u.koff = is_main ? 0 : sl * kslice * 2; u.nt = is_main ? so.ntk : kslice / BK; u.slice = is_main ? -1 : sl;
        return is_main || is_split;
    }
    DI void a_ready(const Unit&) const {}
    DI void done(const Unit&) const {}
};
template <class Epi, class Sched>
DI void gemm_phase(LAS unsigned char* lds, const Gemm g, const Sched& S, const Epi& E, const float* rowvec = nullptr, unsigned stagger_ticks = 0) {
    constexpr int RV_OFF = STAGE_BYTES;
    int tid = threadIdx.x; OPAQUE(tid);
    if (stagger_ticks) { const unsigned long long t0 = __builtin_amdgcn_s_memrealtime(); const unsigned long long d = (unsigned long long)((((unsigned)blockIdx.x >> 3) * 5u) & 7u) * stagger_ticks;
        while (__builtin_amdgcn_s_memrealtime() - t0 < d) __builtin_amdgcn_s_sleep(16); }
    const int wid = __builtin_amdgcn_readfirstlane(tid >> 6), lane = tid & 63, wr = wid >> 2, wc = wid & 3, fr = lane & 15, fq = lane >> 4;
    unsigned voffA[2], voffB[2];
#pragma unroll
    for (int i = 0; i < 2; ++i) { int R, C; stage_rc(tid * 16 + i * 8192, R, C); const int Rb = Epi::PERM ? ((R & ~31) + perm32(R & 31)) : R;
        voffA[i] = (unsigned)(R * g.ld + C) * 2u; voffB[i] = (unsigned)(Rb * g.ld + C) * 2u; }
    const size_t kstep = (size_t)(BK * 2);
    const size_t hstep = (size_t)HALF * g.ld * 2;
    const size_t tstep = 2 * hstep;
    const unsigned ldsw = (unsigned)wid * 1024u;
    const int aoff = lds_byte(wr * 64 + fr, fq * 8), boff = lds_byte(wc * 32 + fr, fq * 8);
#define PG8_SA(b, h) (((b) * 2 + (h)) * HTB)
#define PG8_SB(b, h) ((4 + (b) * 2 + (h)) * HTB)
#define PG8_STAGE(bufoff, gbase, voff) do { _Pragma("unroll") for (int _i = 0; _i < 2; ++_i) \
        GLDS16((const char*)(gbase) + (voff)[_i], lds + (bufoff) + ldsw + _i * 8192); } while (0)
#define PG8_LDA(dst, b, h) do { _Pragma("unroll") for (int m = 0; m < 4; ++m) _Pragma("unroll") for (int k = 0; k < 2; ++k) dst[m][k] = *(const LAS bf16x8*)(lds + PG8_SA(b, h) + aoff + m * 2048 + k * 1024); } while (0)
#define PG8_LDB(dst, b, h) do { _Pragma("unroll") for (int n = 0; n < 2; ++n) _Pragma("unroll") for (int k = 0; k < 2; ++k) dst[n][k] = *(const LAS bf16x8*)(lds + PG8_SB(b, h) + boff + n * 2048 + k * 1024); } while (0)
#define PG8_MMA(ai, bj, At, Bt) do { __builtin_amdgcn_s_setprio(1); _Pragma("unroll") for (int m = 0; m < 4; ++m) _Pragma("unroll") for (int n = 0; n < 2; ++n) _Pragma("unroll") for (int k = 0; k < 2; ++k) \
        acc[ai][bj][m][n] = __builtin_amdgcn_mfma_f32_16x16x32_bf16(Bt[n][k], At[m][k], acc[ai][bj][m][n], 0, 0, 0); __builtin_amdgcn_s_setprio(0); } while (0)
#define PG8_WAIT_V(n) ASM_WAIT_VM(n)
#define PG8_WAIT_L(n) ASM_WAIT_LGKM(n)
#define PG8_BAR __builtin_amdgcn_s_barrier()
#define PG8_SCHED __builtin_amdgcn_sched_barrier(0)
    Unit cur, nxt; int ui = 0;
    if (!S.next(0, cur)) return;
    f32x4 acc[2][2][4][2];
#pragma unroll
    for (int a = 0; a < 2; ++a)
#pragma unroll
        for (int b = 0; b < 2; ++b)
#pragma unroll
            for (int m = 0; m < 4; ++m)
#pragma unroll
                for (int n = 0; n < 2; ++n) acc[a][b][m][n] = (f32x4){0.f, 0.f, 0.f, 0.f};
    bf16x8 At[4][2], B0[2][2], B1[2][2];
    const char* cA = (const char*)g.A + (size_t)cur.pm * tstep + cur.koff; const char* cB = (const char*)g.Bt + (size_t)cur.pn * tstep + cur.koff;
    S.a_ready(cur);
    if (rowvec && wid == 0) GLDS16((const char*)(rowvec + (size_t)cur.pm * BM) + lane * 16, lds + RV_OFF);
    PG8_STAGE(PG8_SB(0, 0), cB, voffB); PG8_STAGE(PG8_SA(0, 0), cA, voffA); PG8_STAGE(PG8_SB(0, 1), cB + hstep, voffB); PG8_STAGE(PG8_SA(0, 1), cA + hstep, voffA);
    if (wr == 1) PG8_BAR;
    PG8_WAIT_V(4); PG8_BAR;
    PG8_STAGE(PG8_SB(1, 0), cB + kstep, voffB); PG8_STAGE(PG8_SA(1, 0), cA + kstep, voffA); PG8_STAGE(PG8_SB(1, 1), cB + hstep + kstep, voffB);
    PG8_WAIT_V(6); PG8_BAR;
    for (;;) {
        const bool has_next = S.next(ui + 1, nxt);
        const char* nA = has_next ? (const char*)g.A + (size_t)nxt.pm * tstep + nxt.koff : cA; const char* nB = has_next ? (const char*)g.Bt + (size_t)nxt.pn * tstep + nxt.koff : cB;
        const int nt = cur.nt;
        for (int t = 0; t < nt; t += 2) {
            const bool last = (t == nt - 2);
            const char* a1 = cA + (size_t)(t + 1) * kstep;
            const char* a2 = last ? nA : cA + (size_t)(t + 2) * kstep; const char* b2 = last ? nB : cB + (size_t)(t + 2) * kstep;
            const char* a3 = a2 + kstep; const char* b3 = b2 + kstep;
            if (last && has_next) { S.a_ready(nxt); if (rowvec && wid == 0) GLDS16((const char*)(rowvec + (size_t)nxt.pm * BM) + lane * 16, lds + RV_OFF + ((ui + 1) & 1) * 1024); }
            PG8_LDB(B0, 0, 0); PG8_SCHED; PG8_LDA(At, 0, 0); PG8_STAGE(PG8_SA(1, 1), a1 + hstep, voffA);
            PG8_WAIT_L(8); PG8_BAR; PG8_WAIT_L(0); PG8_MMA(0, 0, At, B0); PG8_BAR; PG8_SCHED;
            PG8_LDB(B1, 0, 1); PG8_STAGE(PG8_SB(0, 0), b2, voffB);
            PG8_BAR; PG8_WAIT_L(0); PG8_MMA(0, 1, At, B1); PG8_BAR;
            PG8_LDA(At, 0, 1); PG8_STAGE(PG8_SA(0, 0), a2, voffA);
            PG8_BAR; PG8_WAIT_L(0); PG8_MMA(1, 0, At, B0); PG8_BAR; PG8_SCHED;
            PG8_STAGE(PG8_SB(0, 1), b2 + hstep, voffB);
            PG8_WAIT_V(6); PG8_BAR; PG8_MMA(1, 1, At, B1); PG8_BAR;
            PG8_LDB(B0, 1, 0); PG8_SCHED; PG8_LDA(At, 1, 0); PG8_STAGE(PG8_SA(0, 1), a2 + hstep, voffA);
            PG8_WAIT_L(8); PG8_BAR; PG8_WAIT_L(0); PG8_MMA(0, 0, At, B0); PG8_BAR; PG8_SCHED;
            PG8_LDB(B1, 1, 1); PG8_STAGE(PG8_SB(1, 0), b3, voffB);
            PG8_BAR; PG8_WAIT_L(0); PG8_MMA(0, 1, At, B1); PG8_BAR;
            PG8_LDA(At, 1, 1); PG8_STAGE(PG8_SA(1, 0), a3, voffA);
            PG8_BAR; PG8_WAIT_L(0); PG8_MMA(1, 0, At, B0); PG8_BAR; PG8_SCHED;
            PG8_STAGE(PG8_SB(1, 1), b3 + hstep, voffB);
            PG8_WAIT_V(6); PG8_BAR; PG8_MMA(1, 1, At, B1); PG8_BAR;
        }
        E(acc, cur, wr, wc, fr, fq, (const LAS float*)(lds + RV_OFF + (ui & 1) * 1024)); S.done(cur);
        if (!has_next) break;
#pragma unroll
        for (int a = 0; a < 2; ++a)
#pragma unroll
            for (int b = 0; b < 2; ++b)
#pragma unroll
                for (int m = 0; m < 4; ++m)
#pragma unroll
                    for (int n = 0; n < 2; ++n) acc[a][b][m][n] = (f32x4){0.f, 0.f, 0.f, 0.f};
        cur = nxt; cA = nA; cB = nB; ++ui;
    }
    PG8_WAIT_V(0);
    if (wr == 0) PG8_BAR;
    PG8_BAR;
#undef PG8_SA
#undef PG8_SB
#undef PG8_STAGE
#undef PG8_LDA
#undef PG8_LDB
#undef PG8_MMA
#undef PG8_WAIT_V
#undef PG8_WAIT_L
#undef PG8_BAR
#undef PG8_SCHED
}
}
template <class ColMap>
DI void xpose_tile(LAS float* tile, const float* src, int lds_, bf16_t* dst, int ldd, const float* scale, int k0, int n0, const ColMap& cm) {
    int t = threadIdx.x; OPAQUE(t);
    __syncthreads();
    f32x4 v[8];
#pragma unroll
    for (int i = 0; i < 8; ++i) { const int kk = (t >> 6) + 8 * i, n4 = (t & 63) * 4; const int c = cm(n0 + n4);
        v[i] = (c >= 0) ? *(const f32x4*)(src + (size_t)(k0 + kk) * lds_ + c) : (f32x4){0.f, 0.f, 0.f, 0.f}; }
#pragma unroll
    for (int i = 0; i < 8; ++i) { const int kk = (t >> 6) + 8 * i, n4 = (t & 63) * 4; f32x4 w = v[i]; if (scale) w = w * scale[k0 + kk]; *(LAS f32x4*)(tile + kk * 260 + n4) = w; }
    __syncthreads();
#pragma unroll
    for (int i = 0; i < 4; ++i) { const int item = t + 512 * i, nn = item >> 3, kk = (item & 7) * 8; u32x4 w;
        w.x = cvt_pk_bf16(tile[(kk + 0) * 260 + nn], tile[(kk + 1) * 260 + nn]); w.y = cvt_pk_bf16(tile[(kk + 2) * 260 + nn], tile[(kk + 3) * 260 + nn]);
        w.z = cvt_pk_bf16(tile[(kk + 4) * 260 + nn], tile[(kk + 5) * 260 + nn]); w.w = cvt_pk_bf16(tile[(kk + 6) * 260 + nn], tile[(kk + 7) * 260 + nn]);
        *(u32x4*)(dst + (size_t)(n0 + nn) * ldd + k0 + kk) = w; }
}
struct CmIdent { DI int operator()(int n) const { return n; } };
struct CmWin { DI int operator()(int n) const { return win_orig_col(n); } };
struct CmSigma { DI int operator()(int n) const { return sigma_col(n); } };

DI void row_prep(const float* xrow, bf16_t* xbrow, float* ssprow, int lane) {
    for (int c0 = 0; c0 < D; c0 += 256) {
        f32x4 v = xrow ? *(const f32x4*)(xrow + c0 + lane * 4) : (f32x4){0.f, 0.f, 0.f, 0.f};
        u32x2 w; w.x = cvt_pk_bf16(v[0], v[1]); w.y = cvt_pk_bf16(v[2], v[3]);
        *(u32x2*)(xbrow + c0 + lane * 4) = w;
        float s = v[0] * v[0] + v[1] * v[1] + v[2] * v[2] + v[3] * v[3];
        s += __shfl_xor(s, 1); s += __shfl_xor(s, 2); s += __shfl_xor(s, 4); s += __shfl_xor(s, 8);
        if ((lane & 15) == 0) ssprow[(c0 >> 6) + (lane >> 4)] = s;
    }
}

DI void phase_prologue(const Params& p, LAS unsigned char* lds) {
    int tid = threadIdx.x; OPAQUE(tid);
    const int lane = tid & 63, wid = tid >> 6;
    unsigned char* ws = p.ws;
    LAS float* tile = (LAS float*)lds;
    const int T_WIN = (NP / 256) * (D / 64), T_WOUT = (D / 256) * (D / 64), T_WUP = (DFF / 256) * (D / 64), T_WDN = (D / 256) * (DFF / 64);
    const int T_LAYER = T_WIN + T_WOUT + T_WUP + T_WDN;
    for (int u = blockIdx.x; u < DEPTH * T_LAYER; u += gridDim.x) {
        const int l = u / T_LAYER; int r = u % T_LAYER;
        if (r < T_WIN) { const int nt = r / (D / 64), kt = r % (D / 64);
            xpose_tile(tile, p.in[I_WIN] + (size_t)l * D * NIN_ORIG, NIN_ORIG, (bf16_t*)(ws + WS_WIN) + (size_t)l * NP * D, D, p.in[I_N1W] + l * D, kt * 64, nt * 256, CmWin()); continue; }
        r -= T_WIN;
        if (r < T_WOUT) { const int nt = r / (D / 64), kt = r % (D / 64);
            xpose_tile(tile, p.in[I_WOUT] + (size_t)l * D * D, D, (bf16_t*)(ws + WS_WOUT) + (size_t)l * D * D, D, nullptr, kt * 64, nt * 256, CmIdent()); continue; }
        r -= T_WOUT;
        if (r < T_WUP) { const int nt = r / (D / 64), kt = r % (D / 64);
            xpose_tile(tile, p.in[I_WUP] + (size_t)l * D * DFF, DFF, (bf16_t*)(ws + WS_WUP) + (size_t)l * DFF * D, D, p.in[I_N2W] + l * D, kt * 64, nt * 256, CmSigma()); continue; }
        r -= T_WUP;
        { const int nt = r / (DFF / 64), kt = r % (DFF / 64);
            xpose_tile(tile, p.in[I_WDN] + (size_t)l * DFF * D, D, (bf16_t*)(ws + WS_WDN) + (size_t)l * D * DFF, DFF, nullptr, kt * 64, nt * 256, CmIdent()); }
    }
    { float* rc = (float*)(ws + WS_ROPE); float* rs = rc + (size_t)ROPE_N * 64;
      for (int i = blockIdx.x * 512 + tid; i < ROPE_N * 64; i += gridDim.x * 512) { const int pos = i >> 6, f = i & 63;
          const float inv = (float)pow(10000.0, -(double)f / 64.0); const float ang = (float)pos * inv;
          rc[i] = (float)cos((double)ang); rs[i] = (float)sin((double)ang); } }
    { bf16_t* xb = (bf16_t*)(ws + WS_XB); float* ssp = (float*)(ws + WS_SSP);
      for (int row = blockIdx.x * 8 + wid; row < MALL; row += gridDim.x * 8) {
          const float* xr = row < MP ? p.in[I_XP] + (size_t)row * D : (row - MP < MS ? p.in[I_XS] + (size_t)(row - MP) * D : nullptr);
          row_prep(xr, xb + (size_t)row * D, ssp + (size_t)row * NPART, lane); } }
}

#ifdef EMU
#define NT_ST4(p, v) (*(f32x4*)(p) = (v))
#else
#define NT_ST4(p, v) __builtin_nontemporal_store((v), (f32x4*)(p))
#endif
#ifdef EMU
#define SCAL(x) ((void)0)
#else
#define SCAL(x) asm("" : "+v"(x))
#endif
struct EpiInProj {
    static constexpr bool PERM = true;
    int layer; unsigned char* ws; float* out; int nostore;
    DI void st8(bf16_t* dst, const f32x4& a, const f32x4& b) const { if (nostore == 1) { asm volatile("" :: "v"(a[0] + b[0])); return; } u32x4 w; w.x = cvt_pk_bf16(a[0], a[1]); w.y = cvt_pk_bf16(a[2], a[3]); w.z = cvt_pk_bf16(b[0], b[1]); w.w = cvt_pk_bf16(b[2], b[3]); *(u32x4*)dst = w; }
    DI void st4(bf16_t* dst, const f32x4& a) const { if (nostore == 1) { asm volatile("" :: "v"(a[0])); return; } u32x2 w; w.x = cvt_pk_bf16(a[0], a[1]); w.y = cvt_pk_bf16(a[2], a[3]); *(u32x2*)dst = w; }
    DI void operator()(const f32x4 (&acc)[2][2][4][2], const pg8::Unit& u, int wr, int wc, int fr_, int fq_, const LAS float* rs_lds) const {
        int fr = fr_, fq = fq_; OPAQUE(fr); OPAQUE(fq);
        const bool sample = u.pm >= MP / 256;
        const int pn = u.pn;
        const float* ropec = (const float*)(ws + WS_ROPE); const float* ropes = ropec + (size_t)ROPE_N * 64;
        bf16_t* qa = (bf16_t*)(ws + WS_QA); bf16_t* ka = (bf16_t*)(ws + WS_KA); bf16_t* va = (bf16_t*)(ws + WS_VA); bf16_t* braw = (bf16_t*)(ws + WS_BRAW); bf16_t* bz = (bf16_t*)(ws + WS_BZ);
        bf16_t* qc = (bf16_t*)(ws + WS_QC); bf16_t* kc = (bf16_t*)(ws + WS_KC); bf16_t* vc = (bf16_t*)(ws + WS_VC); bf16_t* gates = (bf16_t*)(ws + WS_GATES); float* bab = (float*)(ws + WS_BAB);
        int kind, segt;
        if (pn < TD) { kind = 0; segt = 0; } else if (pn < 2 * TD) { kind = 1; segt = TD; } else if (pn < 3 * TD) { kind = 2; segt = 2 * TD; }
        else if (pn < 6 * TD) { kind = 3; segt = 3 * TD; } else if (pn < 7 * TD) { kind = 4; segt = 6 * TD; } else if (pn < 8 * TD) { kind = 5; segt = 7 * TD; }
        else if (pn < 9 * TD) { kind = 6; segt = 8 * TD; } else if (pn < 10 * TD) { kind = 7; segt = 9 * TD; } else if (pn < 13 * TD) { kind = 8; segt = 10 * TD; }
        else { kind = 9; segt = 13 * TD; }
        const int cb = (pn - segt) * 256 + wc * 32 + fq * 8;
        const int cbs = (pn - segt) * 256 + wc * 64 + fq * 8;
#pragma unroll
        for (int ai = 0; ai < 2; ++ai)
#pragma unroll
            for (int m = 0; m < 4; ++m) {
                const int row = u.pm * 256 + ai * 128 + wr * 64 + m * 16 + fr;
                int b, t, L; bool valid = true;
                if (!sample) { b = row / SEQ; t = row % SEQ; L = SEQ; } else { const int sr = row - MP; valid = sr < MS; b = sr / DSEQ; t = sr % DSEQ; L = DSEQ; }
                if (!valid) continue;
                const int pos = sample ? PAST + t : t;
                const float rs = rs_lds[ai * 128 + wr * 64 + m * 16 + fr];
                const size_t orow = ((size_t)(layer * (sample ? DB : NB) + b) * L + t) * D;
#pragma unroll
                for (int bj = 0; bj < 2; ++bj) {
                    const f32x4 v0 = acc[ai][bj][m][0] * rs, v1 = acc[ai][bj][m][1] * rs;
                    const int c = kind <= 1 ? cb + bj * 128 : cbs + bj * 32;
                    if (kind <= 1) {
                        const int head = c >> 7, d0 = ((c & 127) >> 3) * 4;
                        const f32x4 cs = *(const f32x4*)(ropec + (size_t)pos * 64 + d0), sn = *(const f32x4*)(ropes + (size_t)pos * 64 + d0);
                        const f32x4 o1 = v0 * cs - v1 * sn, o2 = v1 * cs + v0 * sn;
                        const int tc = head * 128 + d0;
                        bf16_t* dst = (kind == 0 ? qa : ka) + (size_t)row * D + tc;
                        st4(dst, o1); st4(dst + 64, o2);
                        if (kind == 1 && sample) { float* o = out + O_SAK + orow + tc; if (!nostore) { NT_ST4(o, o1); NT_ST4((o + 64), o2); } }
                    } else if (kind == 2) { st8(va + (size_t)row * D + c, v0, v1); if (sample) { float* o = out + O_SAV + orow + c; if (!nostore) { NT_ST4(o, v0); NT_ST4((o + 4), v1); } } }
                    else if (kind == 3) { st8(braw + (size_t)row * 3 * D + c, v0, v1);
                        if (t >= L - 3) { float* o = out + (sample ? O_SBC : O_PBC) + ((size_t)(layer * (sample ? DB : NB) + b) * 3 + (t - (L - 3))) * 3 * D + c; if (!nostore) { NT_ST4(o, v0); NT_ST4((o + 4), v1); } } }
                    else if (kind == 4) st8(bz + (size_t)row * D + c, v0, v1);
                    else if (kind == 5) st8(qc + (size_t)row * D + c, v0, v1);
                    else if (kind == 6) { st8(kc + (size_t)row * D + c, v0, v1); float* o = out + (sample ? O_SCK : O_PCK) + orow + c; if (!nostore) { NT_ST4(o, v0); NT_ST4((o + 4), v1); } }
                    else if (kind == 7) { st8(vc + (size_t)row * D + c, v0, v1); float* o = out + (sample ? O_SCV : O_PCV) + orow + c; if (!nostore) { NT_ST4(o, v0); NT_ST4((o + 4), v1); } }
                    else if (kind == 8) st8(gates + (size_t)row * 3 * D + c, v0, v1);
                    else { if (c < 16 && !nostore) { float* o = bab + (size_t)row * 16 + c; NT_ST4(o, v0); NT_ST4((o + 4), v1); } }
                }
                if ((m & 1) == 1) COMPILER_FENCE();
            }
    }
};

DI void conv_unit(const Params& p, int l, int rbx, int cg) {
    int tid = threadIdx.x; OPAQUE(tid);
    unsigned char* ws = p.ws;
    const bf16_t* braw = (const bf16_t*)(ws + WS_BRAW);
    bf16_t* bqkv[3] = {(bf16_t*)(ws + WS_BQ), (bf16_t*)(ws + WS_BK), (bf16_t*)(ws + WS_BV)};
    const float* bab = (const float*)(ws + WS_BAB); float* gb = (float*)(ws + WS_GB);
    const float* convw = p.in[I_CONVW] + (size_t)l * CONVW * 3 * D;
    const float* alog = p.in[I_ALOG] + l * HB; const float* dtb = p.in[I_DTB] + l * HB;
    constexpr int CG = (3 * D + 1023) / 1024;
    const int ct = tid & 127, rg = tid >> 7;
    {
        const bool sample = rbx >= MP / 64;
        const int rb = sample ? rbx - MP / 64 : rbx;
        const int b = sample ? rb : (rb * 64) / SEQ, t00 = sample ? 0 : (rb * 64) % SEQ, nreal = sample ? DSEQ : 64;
        const size_t rawrow0 = sample ? (size_t)MP + (size_t)b * DSEQ : (size_t)b * SEQ + t00;
        const size_t dstrow0 = sample ? (size_t)MP + (size_t)b * 64 : (size_t)b * SEQ + t00;
        const int col8u = cg * 1024 + ct * 8; const bool active = col8u < 3 * D; const int col8 = active ? col8u : 0, seg = col8 / D, cseg = col8 % D;
        float cw[4][8];
#pragma unroll
        for (int k = 0; k < 4; ++k) { const f32x4 a = *(const f32x4*)(convw + (size_t)k * 3 * D + col8), bq4 = *(const f32x4*)(convw + (size_t)k * 3 * D + col8 + 4);
#pragma unroll
            for (int e = 0; e < 4; ++e) { cw[k][e] = a[e]; cw[k][4 + e] = bq4[e]; } }
#pragma unroll 1
        for (int half = 0; half < 2; ++half) {
            const int t0 = rg * 16 + half * 8;
            u32x4 raw[11];
#pragma unroll
            for (int j = 0; j < 11; ++j) { const int t = t0 - 3 + j; raw[j] = (u32x4){0u, 0u, 0u, 0u};
                if (active && (t >= 0 ? (t < nreal) : (!sample && t00 + t >= 0))) raw[j] = *(const u32x4*)(braw + (size_t)((long)rawrow0 + t) * 3 * D + col8); }
            float hist[3][8];
            const bool use_hist = sample && t0 == 0;
            if (use_hist) { const float* hs = p.in[I_SCONV] + ((size_t)(l * DB + b) * 3) * 3 * D + col8;
#pragma unroll
                for (int j = 0; j < 3; ++j)
#pragma unroll
                    for (int e = 0; e < 8; ++e) hist[j][e] = hs[(size_t)j * 3 * D + e]; }
#pragma unroll
            for (int r8 = 0; r8 < 8; ++r8) {
                const int t = t0 + r8; float o[8];
                if (t < nreal) {
                    float ss = 0.f;
#pragma unroll
                    for (int e = 0; e < 8; ++e) { float c = 0.f;
#pragma unroll
                        for (int k = 0; k < 4; ++k) { const int j = r8 + k;
                            float x = (e & 1) ? bf_hi(raw[j][e >> 1]) : bf_lo(raw[j][e >> 1]);
                            if (r8 + k < 3) { if (use_hist) x = hist[r8 + k][e]; }
                            c += x * cw[k][e]; }
                        const float sv = c * sigmoidf_(c); o[e] = sv; ss += sv * sv; }
                    ss += __shfl_xor(ss, 1); ss += __shfl_xor(ss, 2); ss += __shfl_xor(ss, 4); ss += __shfl_xor(ss, 8);
                    const float sc = seg < 2 ? __builtin_amdgcn_rsqf(ss + EPS) * (seg == 0 ? 0.08838834764831845f : 1.0f) : 1.0f;
#pragma unroll
                    for (int e = 0; e < 8; ++e) o[e] *= sc;
                } else {
#pragma unroll
                    for (int e = 0; e < 8; ++e) o[e] = 0.f;
                }
                u32x4 w; w.x = cvt_pk_bf16(o[0], o[1]); w.y = cvt_pk_bf16(o[2], o[3]); w.z = cvt_pk_bf16(o[4], o[5]); w.w = cvt_pk_bf16(o[6], o[7]);
                if (active) *(u32x4*)(bqkv[seg] + (dstrow0 + t) * D + cseg) = w;
            }
        }
        if (cg == 0) { const int t = tid / HB, h = tid % HB; float g = 0.f, be = 0.f;
            if (t < nreal) { const float ba = bab[(rawrow0 + t) * 16 + h], bbv = bab[(rawrow0 + t) * 16 + HB + h];
                const float x = ba + dtb[h]; const float sp = fmaxf(x, 0.f) + 0.69314718056f * __builtin_amdgcn_logf(1.0f + fast_exp(-fabsf(x)));
                g = -fast_exp(alog[h]) * sp; be = sigmoidf_(bbv); }
            if (t < 64) { gb[(dstrow0 + t) * 16 + h] = g; gb[(dstrow0 + t) * 16 + 8 + h] = be; } }
    }
}

DI int crow32(int reg, int h) { return (reg & 3) + 8 * (reg >> 2) + 4 * h; }
DI bf16x8 pack8(const f32x16& x, int s) {
    u32x4 w; w.x = cvt_pk_bf16(x[8 * s + 0], x[8 * s + 1]); w.y = cvt_pk_bf16(x[8 * s + 2], x[8 * s + 3]); w.z = cvt_pk_bf16(x[8 * s + 4], x[8 * s + 5]); w.w = cvt_pk_bf16(x[8 * s + 6], x[8 * s + 7]);
    return __builtin_bit_cast(bf16x8, w);
}
#define MFMA32(a, b, c) __builtin_amdgcn_mfma_f32_32x32x16_bf16((a), (b), (c), 0, 0, 0)
DI f32x16 zero16() { f32x16 z;
#pragma unroll
    for (int i = 0; i < 16; ++i) z[i] = 0.f; return z; }

DI void unit_rows_b(int u, int& row0, int& h) {
    if (u < NB * NCH * HB) { h = u % HB; const int bc = u / HB; row0 = (bc / NCH) * SEQ + (bc % NCH) * 64; }
    else { const int s = u - NB * NCH * HB; h = s % HB; row0 = MP + (s / HB) * 64; }
}

DI void pre_unit(const Params& p, LAS unsigned char* lds, int u) {
    int tid = threadIdx.x; OPAQUE(tid);
    const int lane_ = tid & 63, wid = tid >> 6;
    unsigned char* ws = p.ws;
    const bf16_t* bq = (const bf16_t*)(ws + WS_BQ); const bf16_t* bk = (const bf16_t*)(ws + WS_BK);
    const float* gb = (const float*)(ws + WS_GB);
    bf16_t* TT = (bf16_t*)(ws + WS_TT); bf16_t* AQ = (bf16_t*)(ws + WS_AQK); float* CV = (float*)(ws + WS_CV);
    LAS float* Mm = (LAS float*)(lds + wid * 16896);
    LAS float* gcs = Mm + 4096;
    {
        int lane = lane_; OPAQUE(lane);
        const int r = lane & 31, hh = lane >> 5;
        int row0, h; unit_rows_b(u, row0, h);
        const float g = gb[(size_t)(row0 + lane) * 16 + h], be = gb[(size_t)(row0 + lane) * 16 + 8 + h];
        float gc = g;
#pragma unroll
        for (int d = 1; d < 64; d <<= 1) { const float o = __shfl_up(gc, d); if (lane >= d) gc += o; }
        const float gL = __shfl(gc, 63);
        gcs[lane] = gc; gcs[64 + lane] = be;
        { float* cv = CV + (size_t)u * 256; const float eg = expf(gc); cv[lane] = be; cv[64 + lane] = be * eg; cv[128 + lane] = eg; cv[192 + lane] = expf(gL - gc); }
        WAVE_LDS_FENCE();
#pragma unroll
        for (int bi = 0; bi < 2; ++bi)
#pragma unroll
            for (int bj = 0; bj < 2; ++bj) {
                f32x16 kk = zero16(), qk = zero16();
                if (bj <= bi) {
                    const bf16_t* ki = bk + (size_t)(row0 + 32 * bi + r) * D + h * 128 + 8 * hh; const bf16_t* kj = bk + (size_t)(row0 + 32 * bj + r) * D + h * 128 + 8 * hh;
                    const bf16_t* qi = bq + (size_t)(row0 + 32 * bi + r) * D + h * 128 + 8 * hh;
#pragma unroll 2
                    for (int s = 0; s < 8; ++s) { const bf16x8 fki = *(const bf16x8*)(ki + 16 * s), fkj = *(const bf16x8*)(kj + 16 * s), fqi = *(const bf16x8*)(qi + 16 * s);
                        kk = MFMA32(fki, fkj, kk); qk = MFMA32(fqi, fkj, qk); }
                }
                __builtin_amdgcn_sched_barrier(0);
                const int j = 32 * bj + r; const float gcj = gcs[j];
#pragma unroll
                for (int i16 = 0; i16 < 16; ++i16) { const int i = 32 * bi + crow32(i16, hh); const float gci = gcs[i], bei = gcs[64 + i];
                    const float dec = (j <= i) ? expf(gci - gcj) : 0.f;
                    if (bj <= bi) Mm[i * 64 + j] = (j < i) ? bei * kk[i16] * dec : 0.f;
                    AQ[(size_t)u * 4096 + i * 64 + j] = f2bf((bj <= bi) ? qk[i16] * dec : 0.f); }
                __builtin_amdgcn_sched_barrier(0);
            }
        WAVE_LDS_FENCE();
        float tcol[64];
#pragma unroll
        for (int i = 0; i < 64; ++i) {
            float a = (i == lane) ? 1.f : 0.f;
#pragma unroll
            for (int j4 = 0; j4 < (i + 3) / 4; ++j4) { const f32x4 mv = *(const LAS f32x4*)(Mm + i * 64 + 4 * j4);
#pragma unroll
                for (int e = 0; e < 4; ++e) if (4 * j4 + e < i) a -= mv[e] * tcol[4 * j4 + e]; }
            tcol[i] = a;
            TT[(size_t)u * 4096 + i * 64 + lane] = f2bf(a);
            __builtin_amdgcn_sched_barrier(0);
        }
        WAVE_LDS_FENCE();
    }
}

DI void phase_conv_pre(const Params& p, int l, LAS unsigned char* lds) {
    const int wid = (int)threadIdx.x >> 6;
    constexpr int CG = (3 * D + 1023) / 1024;
    constexpr int NRB = MP / 64 + DB;
    for (int rbx = blockIdx.x; rbx < NRB; rbx += gridDim.x) {
#pragma unroll 1
        for (int cg = 0; cg < CG; ++cg) conv_unit(p, l, rbx, cg);
        ASM_WAIT_VM0(); __syncthreads();
        if (wid < HB) { const bool sample = rbx >= MP / 64; const int u = sample ? NB * NCH * HB + (rbx - MP / 64) * HB + wid : rbx * HB + wid;
            pre_unit(p, lds, u); }
    }
}

constexpr size_t WS_QUEUE = 16384;
DI int queue_next(unsigned* ctr, volatile LAS unsigned* slot) {
    __syncthreads();
    if (threadIdx.x == 0) *slot = __hip_atomic_fetch_add(ctr, 1u, __ATOMIC_RELAXED, __HIP_MEMORY_SCOPE_AGENT);
    __syncthreads();
    return __builtin_amdgcn_readfirstlane((int)*slot);
}

DI int xcd_queue_next(unsigned* ctr8, int nstreams, int per_stream, int& qx, int& tries, volatile LAS unsigned* slot) {
    for (;;) {
        if (tries >= 8) return -1;
        const int j = queue_next(ctr8 + 64 * qx, slot);
        if (j < per_stream * ((nstreams - qx + 7) / 8)) return j;
        qx = (qx + 1) & 7; ++tries;
    }
}

DI unsigned img_b(unsigned row, unsigned ch) { return 256u * row + 16u * (ch ^ (((row & 3u) << 2) | ((row >> 2) & 3u))); }
DI bf16x8 ld2x8(const LAS unsigned char* p0, const LAS unsigned char* p1) {
    const u32x2 a = *(const LAS u32x2*)p0, b = *(const LAS u32x2*)p1; u32x4 w; w.x = a.x; w.y = a.y; w.z = b.x; w.w = b.y; return __builtin_bit_cast(bf16x8, w);
}
DI unsigned tk_off(unsigned ta, int cbw, int kb) { return ta ^ (unsigned)(64 * ((cbw & 3) ^ kb)); }
constexpr int SC_KI = 0, SC_QI = 16384, SC_VI = 32768, SC_TI = 49152, SC_AI = 57344, SC_CV = 65536, SC_BUF = 66560;

DI void phase_gdn_scan(const Params& p, int l, LAS unsigned char* lds, unsigned* qctr, volatile LAS unsigned* qslot) {
    int tid = threadIdx.x; OPAQUE(tid);
    const int lane_ = tid & 63, wid = __builtin_amdgcn_readfirstlane(tid >> 6);
    unsigned char* ws = p.ws;
    const bf16_t* bq = (const bf16_t*)(ws + WS_BQ); const bf16_t* bk = (const bf16_t*)(ws + WS_BK); const bf16_t* bv = (const bf16_t*)(ws + WS_BV);
    const bf16_t* TT = (const bf16_t*)(ws + WS_TT); const bf16_t* AQ = (const bf16_t*)(ws + WS_AQK); const float* CV = (const float*)(ws + WS_CV);
    bf16_t* ob = (bf16_t*)(ws + WS_OBUF);
    constexpr int NCHAIN = NB * HB + DB * HB;
    for (;;) {
        const int ch = queue_next(qctr, qslot); if (ch >= NCHAIN) break;
        int lane = lane_; OPAQUE(lane);
        const int r = lane & 31, hh = lane >> 5;
        const bool sample = ch >= NB * HB;
        const int b = sample ? (ch - NB * HB) / HB : ch / HB, h = ch % HB, nchunk = sample ? 1 : NCH;
        const int dv0 = 32 * wid;
        const int u0 = sample ? NB * NCH * HB + b * HB + h : (b * NCH) * HB + h;
        const int row00 = sample ? MP + b * 64 : b * SEQ;
        const unsigned cx = (unsigned)((lane & 15) ^ (((lane >> 4) & 3) << 2));
#define SCAN_ISSUE(c_) do { if (wid >= 4) { LAS unsigned char* buf_ = lds + ((c_) & 1) * SC_BUF; \
            if (wid < 7) { const bf16_t* src_ = (wid == 4 ? bk : (wid == 5 ? bq : bv)) + (size_t)(row00 + 64 * (c_)) * D + h * 128; LAS unsigned char* d_ = buf_ + (wid - 4) * 16384; \
                _Pragma("unroll") for (int g_ = 0; g_ < 16; ++g_) GLDS16((const char*)src_ + (size_t)((4 * g_ + (lane >> 4)) * D * 2) + 16u * (cx ^ (unsigned)(g_ & 3)), d_ + g_ * 1024); } \
            else { const size_t uo_ = (size_t)(u0 + (c_) * HB); \
                _Pragma("unroll") for (int g_ = 0; g_ < 8; ++g_) { GLDS16((const char*)(TT + uo_ * 4096) + g_ * 1024 + lane * 16, buf_ + SC_TI + g_ * 1024); GLDS16((const char*)(AQ + uo_ * 4096) + g_ * 1024 + lane * 16, buf_ + SC_AI + g_ * 1024); } \
                GLDS16((const char*)(CV + uo_ * 256) + lane * 16, buf_ + SC_CV); } } } while (0)
        const unsigned sa0 = img_b(r, 0) + 8 * hh;
        unsigned ta0;
        { const int blk = (lane >> 4) & 1, q4 = (lane & 15) >> 2, p4 = lane & 3; ta0 = img_b(4 * hh + q4, 4 * (wid & 3) + 2 * blk + (p4 >> 1)) + 8 * (p4 & 1); }
        f32x16 S[4];
        if (wid < 4) {
#pragma unroll
            for (int kb = 0; kb < 4; ++kb) { S[kb] = zero16();
                if (sample) { const float* s0 = p.in[I_SSSM] + ((size_t)(l * DB + b) * HB + h) * 128 * 128;
#pragma unroll
                    for (int i = 0; i < 16; ++i) S[kb][i] = s0[(size_t)(32 * kb + crow32(i, hh)) * 128 + dv0 + r]; } }
        }
        SCAN_ISSUE(0);
        for (int c = 0; c < nchunk; ++c) {
            ASM_WAIT_ALL0(); __builtin_amdgcn_s_barrier();
            if (c + 1 < nchunk) SCAN_ISSUE(c + 1);
            if (wid < 4) {
                const LAS unsigned char* B = lds + (c & 1) * SC_BUF;
                unsigned sa = sa0, ta = ta0; OPAQUE(sa); OPAQUE(ta);
                const int row0 = row00 + 64 * c;
                f32x16 ks[2], qs[2];
                ks[0] = zero16(); ks[1] = zero16(); qs[0] = zero16(); qs[1] = zero16();
#pragma unroll
                for (int s = 0; s < 8; ++s) { const bf16x8 sb = pack8(S[s >> 1], s & 1); const unsigned o0 = sa ^ (unsigned)(32 * s), o1 = o0 ^ 16u;
                    ks[0] = MFMA32(ld2x8(B + SC_KI + o0, B + SC_KI + o1), sb, ks[0]);
                    ks[1] = MFMA32(ld2x8(B + SC_KI + 8192 + o0, B + SC_KI + 8192 + o1), sb, ks[1]);
                    qs[0] = MFMA32(ld2x8(B + SC_QI + o0, B + SC_QI + o1), sb, qs[0]);
                    qs[1] = MFMA32(ld2x8(B + SC_QI + 8192 + o0, B + SC_QI + 8192 + o1), sb, qs[1]);
                    __builtin_amdgcn_sched_barrier(0); }
                const LAS unsigned char* cvb = B + SC_CV + 16 * hh;
                f32x16 rr[2];
#pragma unroll
                for (int tb = 0; tb < 2; ++tb)
#pragma unroll
                    for (int g = 0; g < 4; ++g) { const s16x4 vv = ds_read_tr16(B + SC_VI + (32 * tb + 8 * g) * 256 + (ta ^ ((g & 1) ? 32u : 0u)));
                        const f32x4 be = *(const LAS f32x4*)(cvb + 4 * (32 * tb + 8 * g)), bg = *(const LAS f32x4*)(cvb + 4 * (64 + 32 * tb + 8 * g));
#pragma unroll
                        for (int e = 0; e < 4; ++e) rr[tb][4 * g + e] = be[e] * bf2f((bf16_t)vv[e]) - bg[e] * ks[tb][4 * g + e]; }
                __builtin_amdgcn_sched_barrier(0);
                bf16x8 Rb[4];
#pragma unroll
                for (int s2 = 0; s2 < 4; ++s2) Rb[s2] = pack8(rr[s2 >> 1], s2 & 1);
                f32x16 uu[2];
#pragma unroll
                for (int tb = 0; tb < 2; ++tb) { uu[tb] = zero16();
#pragma unroll
                    for (int s2 = 0; s2 < 2 * tb + 2; ++s2) { const LAS unsigned char* base = B + SC_TI + (32 * tb + r) * 128 + 32 * s2 + 8 * hh;
                        uu[tb] = MFMA32(ld2x8(base, base + 16), Rb[s2], uu[tb]); } }
                __builtin_amdgcn_sched_barrier(0);
                bf16x8 Ub[4], Ud[4];
#pragma unroll
                for (int tb = 0; tb < 2; ++tb) { f32x16 ud;
#pragma unroll
                    for (int g = 0; g < 4; ++g) { const f32x4 dg = *(const LAS f32x4*)(cvb + 4 * (192 + 32 * tb + 8 * g));
#pragma unroll
                        for (int e = 0; e < 4; ++e) ud[4 * g + e] = uu[tb][4 * g + e] * dg[e]; }
                    Ub[2 * tb] = pack8(uu[tb], 0); Ub[2 * tb + 1] = pack8(uu[tb], 1); Ud[2 * tb] = pack8(ud, 0); Ud[2 * tb + 1] = pack8(ud, 1); }
                __builtin_amdgcn_sched_barrier(0);
#pragma unroll
                for (int tb = 0; tb < 2; ++tb) { f32x16 o;
#pragma unroll
                    for (int g = 0; g < 4; ++g) { const f32x4 eg = *(const LAS f32x4*)(cvb + 4 * (128 + 32 * tb + 8 * g));
#pragma unroll
                        for (int e = 0; e < 4; ++e) o[4 * g + e] = qs[tb][4 * g + e] * eg[e]; }
#pragma unroll
                    for (int s2 = 0; s2 < 2 * tb + 2; ++s2) { const LAS unsigned char* base = B + SC_AI + (32 * tb + r) * 128 + 32 * s2 + 8 * hh;
                        o = MFMA32(ld2x8(base, base + 16), Ub[s2], o); }
                    bf16_t* od = ob + (size_t)(row0 + 32 * tb + 4 * hh) * D + h * 128 + dv0 + r;
#pragma unroll
                    for (int i = 0; i < 16; ++i) od[(size_t)((i & 3) + 8 * (i >> 2)) * D] = f2bf(o[i]); }
                __builtin_amdgcn_sched_barrier(0);
                const float egL = *(const LAS float*)(B + SC_CV + 4 * (128 + 63));
#pragma unroll
                for (int kb = 0; kb < 4; ++kb) {
#pragma unroll
                    for (int i = 0; i < 16; ++i) S[kb][i] *= egL;
#pragma unroll
                    for (int s2 = 0; s2 < 4; ++s2) {
                        const s16x4 lo = ds_read_tr16(B + SC_KI + s2 * 4096 + tk_off(ta, wid, kb));
                        const s16x4 hi = ds_read_tr16(B + SC_KI + s2 * 4096 + 2048 + (tk_off(ta, wid, kb) ^ 32u));
                        const bf16x8 a = __builtin_shufflevector(lo, hi, 0, 1, 2, 3, 4, 5, 6, 7);
                        S[kb] = MFMA32(a, Ud[s2], S[kb]); __builtin_amdgcn_sched_barrier(0); }
                }
            }
        }
#undef SCAN_ISSUE
        if (wid < 4) { int cl = dv0 + r + 512 * hh; OPAQUE(cl);
            float* so = p.out + (sample ? O_SBS : O_PBS) + ((size_t)(l * (sample ? DB : NB) + b) * HB + h) * 128 * 128 + cl;
#pragma unroll
            for (int kb = 0; kb < 4; ++kb)
#pragma unroll
                for (int i = 0; i < 16; ++i) so[(32 * kb + (i & 3) + 8 * (i >> 2)) * 128] = S[kb][i]; }
    }
}
constexpr int AT_K = 0, AT_V = 32768, AT_Q = 65536, AT_FLAG = 131072, AT_X = 0  ;

template <bool SRC32>
DI void stage_rows(LAS unsigned char* img, const void* src, size_t row_pitch_elems, int nrows, int nvalid) {
    int tid = threadIdx.x; OPAQUE(tid);
    for (int idx = tid; idx < nrows * 16; idx += 512) { const int row = idx >> 4, chn = idx & 15; u32x4 w = (u32x4){0u, 0u, 0u, 0u};
        if (row < nvalid) {
            if (SRC32) { const float* s = (const float*)src + (size_t)row * row_pitch_elems + chn * 8; const f32x4 a = *(const f32x4*)s, b = *(const f32x4*)(s + 4);
                w.x = cvt_pk_bf16(a[0], a[1]); w.y = cvt_pk_bf16(a[2], a[3]); w.z = cvt_pk_bf16(b[0], b[1]); w.w = cvt_pk_bf16(b[2], b[3]); }
            else w = *(const u32x4*)((const bf16_t*)src + (size_t)row * row_pitch_elems + chn * 8);
        }
        *(LAS u32x4*)(img + img_b(row, chn)) = w; }
}
struct LaneOffs { unsigned ra0; unsigned ta0[4]; };
DI LaneOffs make_lane_offs(int lane) {
    LaneOffs L; const int r = lane & 31, hh = lane >> 5, blk = (lane >> 4) & 1, q4 = (lane & 15) >> 2, p4 = lane & 3;
    L.ra0 = img_b(r, hh);
#pragma unroll
    for (int cb = 0; cb < 4; ++cb) L.ta0[cb] = img_b(4 * hh + q4, 4 * cb + 2 * blk + (p4 >> 1)) + 8 * (p4 & 1);
    return L;
}
DI bf16x8 lds_frag_row(const LAS unsigned char* img, const LaneOffs& L, int ks) { return *(const LAS bf16x8*)(img + (L.ra0 ^ (unsigned)(32 * ks))); }
DI bf16x8 lds_frag_tr(const LAS unsigned char* img, const LaneOffs& L, int s2, int cb) {
    const s16x4 lo = ds_read_tr16(img + s2 * 4096 + L.ta0[cb]);
    const s16x4 hi = ds_read_tr16(img + s2 * 4096 + 2048 + (L.ta0[cb] ^ 32u));
    return __builtin_shufflevector(lo, hi, 0, 1, 2, 3, 4, 5, 6, 7);
}

DI void cache_store_tile(const LAS unsigned char* stg, float* oK, float* oV) {
    int tq = threadIdx.x; OPAQUE(tq);
    const int ch = tq & 15;
#pragma unroll
    for (int j = 0; j < 8; ++j) { const int im = j >> 1, row = (tq >> 4) + 32 * (j & 1);
        const u32x4 w = *(const LAS u32x4*)(stg + im * 16384 + img_b(row, ch));
        float* o = (im < 2 ? oK + im * 128 : oV + (im - 2) * 128) + (size_t)row * D + ch * 8;
        const f32x4 a = (f32x4){bf_lo(w.x), bf_hi(w.x), bf_lo(w.y), bf_hi(w.y)}, b = (f32x4){bf_lo(w.z), bf_hi(w.z), bf_lo(w.w), bf_hi(w.w)};
        NT_ST4(o, a); NT_ST4((o + 4), b); }
}

#ifdef EMU
DI void swap32(float x, float& r0, float& r1) { const float o = __shfl_xor(x, 32); const bool up = (threadIdx.x & 32) != 0; r0 = up ? o : x; r1 = up ? x : o; }
#else
DI void swap32(float x, float& r0, float& r1) { const unsigned u = __float_as_uint(x); const auto r = __builtin_amdgcn_permlane32_swap(u, u, false, false); r0 = __uint_as_float(r[0]); r1 = __uint_as_float(r[1]); }
#endif
#ifdef EMU
#define TR_WAITN(n, a) ((void)0)
#else
#define TR_WAITN(n, a) do { if ((n) >= 8) TR_WAIT1(8, a); else if ((n) == 6) TR_WAIT1(6, a); else if ((n) == 4) TR_WAIT1(4, a); else if ((n) == 2) TR_WAIT1(2, a); else TR_WAIT1(0, a); } while (0)
#endif
#ifdef EMU
#define MAX3_ACC(acc, a, b) acc = fmaxf(acc, fmaxf((a), (b)))
#else
#define MAX3_ACC(acc, a, b) do { const float a_ = (a), b_ = (b); asm("v_max3_f32 %0, %0, %1, %2" : "+v"(acc) : "v"(a_), "v"(b_)); } while (0)
#endif
DI void attn_a_tile(const LAS unsigned char* Ki, const LAS unsigned char* Vi, const bf16x8 (&qreg)[8], int lane_in, int nvalid, float sc,
                    f32x16 (&O)[8], float& m, float& lsum, bool dma, const char* gsrc, LAS unsigned char* gdst, unsigned srow_in, unsigned cx_in) {
    int lane = lane_in; OPAQUE(lane);
    const LaneOffs LO = make_lane_offs(lane); const int hh = lane >> 5;
    f32x16 s0 = zero16(), s1 = zero16();
    {
        bf16x8 kb0[3], kb1[3];
#pragma unroll
        for (int j = 0; j < 3; ++j) { kb0[j] = lds_frag_row(Ki, LO, j); kb1[j] = lds_frag_row(Ki + 8192, LO, j); }
#pragma unroll
        for (int ks = 0; ks < 8; ++ks) {
            const bf16x8 a0 = kb0[ks % 3], a1 = kb1[ks % 3];
            if (ks + 3 < 8) { kb0[ks % 3] = lds_frag_row(Ki, LO, ks + 3); kb1[ks % 3] = lds_frag_row(Ki + 8192, LO, ks + 3); }
            s0 = MFMA32(a0, qreg[ks], s0); s1 = MFMA32(a1, qreg[ks], s1);
            if (dma) { unsigned srow_ = srow_in, cx_ = cx_in; OPAQUE(srow_); OPAQUE(cx_); GLDS16(gsrc + (srow_ + (unsigned)(ks * 4 * D * 2) + 16u * (cx_ ^ (unsigned)(ks & 3))), gdst + ks * 1024); }
            __builtin_amdgcn_sched_barrier(0);
        }
    }
    bf16x8 vf[3];
#pragma unroll
    for (int j = 0; j < 3; ++j) { s16x4 a_, b_; TR_ISSUE(a_, Vi, LO.ta0[j & 3], 0); TR_ISSUE_X32(b_, Vi, LO.ta0[j & 3], 2048); vf[j] = __builtin_shufflevector(a_, b_, 0, 1, 2, 3, 4, 5, 6, 7); }
    __builtin_amdgcn_sched_barrier(0);
    float mt = -1e30f;
    if (nvalid < 64) {
        const int nvh = nvalid - 4 * hh;
#pragma unroll
        for (int i = 0; i < 16; ++i) { if ((i & 3) + 8 * (i >> 2) >= nvh) s0[i] = -1e30f; if ((i & 3) + 8 * (i >> 2) + 32 >= nvh) s1[i] = -1e30f; }
    }
    mt = fmaxf(mt, fmaxf(s0[15], s1[15]));
#pragma unroll
    for (int i = 0; i < 15; ++i) MAX3_ACC(mt, s0[i], s1[i]);
    { float r0_, r1_; swap32(mt, r0_, r1_); mt = fmaxf(r0_, r1_) * sc; }
    if (!__all(mt <= m + 8.0f)) {
        const float mn = fmaxf(m, mt), alpha = fast_exp2(m - mn); m = mn; lsum *= alpha;
#pragma unroll
        for (int d = 0; d < 8; ++d)
#pragma unroll
            for (int i = 0; i < 16; ++i) O[d][i] *= alpha;
    }
    float ps = 0.f;
    const float nm = -m;
    float ps1 = 0.f;
#pragma unroll
    for (int i = 0; i < 8; ++i) { const float e0 = fast_exp2(__builtin_fmaf(s0[i], sc, nm)); s0[i] = e0; ps += e0; SCAL(ps); }
    bf16x8 pb[4]; pb[0] = pack8(s0, 0);
    __builtin_amdgcn_sched_barrier(0);
    bf16x8 cur = vf[0];
    TR_WAITN(4, cur);
#pragma unroll
    for (int idx = 0; idx < 32; ++idx) { const int s2 = idx >> 3, d = idx & 7, slot = idx % 3;
        bf16x8 nxt = cur;
        if (idx + 1 < 32) { nxt = vf[(idx + 1) % 3]; if (idx + 2 < 32) TR_WAITN(2, nxt); else TR_WAITN(0, nxt); }
        O[d] = MFMA32(cur, pb[s2], O[d]);
        if (idx + 3 < 32) { const int j = idx + 3, js2 = j >> 3, jd = j & 7; s16x4 a_, b_;
            TR_ISSUE(a_, Vi, LO.ta0[jd & 3], (jd >> 2) * 16384 + js2 * 4096); TR_ISSUE_X32(b_, Vi, LO.ta0[jd & 3], (jd >> 2) * 16384 + js2 * 4096 + 2048);
            vf[slot] = __builtin_shufflevector(a_, b_, 0, 1, 2, 3, 4, 5, 6, 7); }
        cur = nxt;
        if (idx < 4) {
            const float ea = fast_exp2(__builtin_fmaf(s0[8 + 2 * idx], sc, nm)); s0[8 + 2 * idx] = ea; ps += ea; SCAL(ps);
            const float eb = fast_exp2(__builtin_fmaf(s0[9 + 2 * idx], sc, nm)); s0[9 + 2 * idx] = eb; ps1 += eb; SCAL(ps1); }
        else if (idx < 20) { const float e1 = fast_exp2(__builtin_fmaf(s1[idx - 4], sc, nm)); s1[idx - 4] = e1; ps1 += e1; SCAL(ps1); }
        if (idx == 3) pb[1] = pack8(s0, 1);
        if (idx == 11) pb[2] = pack8(s1, 0);
        if (idx == 19) pb[3] = pack8(s1, 1);
        __builtin_amdgcn_sched_barrier(0);
    }
    lsum += ps + ps1;
}

DI void phase_attn_a(const Params& p, int l, LAS unsigned char* lds, unsigned* qctr, volatile LAS unsigned* qslot) {
    int tid = threadIdx.x; OPAQUE(tid);
    const int lane_ = tid & 63, wid = __builtin_amdgcn_readfirstlane(tid >> 6), c = wid >> 2, rg = wid & 3;
    unsigned char* ws = p.ws;
    const bf16_t* QA = (const bf16_t*)(ws + WS_QA); const bf16_t* KA = (const bf16_t*)(ws + WS_KA); const bf16_t* VA = (const bf16_t*)(ws + WS_VA);
    bf16_t* OA = (bf16_t*)(ws + WS_OA);
    const float lam_init = 0.8f - 0.6f * expf(-0.3f * (float)l);
    float lam;
    { float d1 = 0.f, d2 = 0.f; const float* q1 = p.in[I_LQ1] + l * 128; const float* k1 = p.in[I_LK1] + l * 128; const float* q2 = p.in[I_LQ2] + l * 128; const float* k2 = p.in[I_LK2] + l * 128;
      for (int i = 0; i < 128; ++i) { d1 += q1[i] * k1[i]; d2 += q2[i] * k2[i]; } lam = expf(d1) - expf(d2) + lam_init; }
    LAS float* lamv = (LAS float*)(lds + AT_FLAG + 64);
    __syncthreads();
    if (tid == 0) { lamv[0] = lam; lamv[1] = 1.0f - lam_init; }
    const float* subw = p.in[I_SUBLN] + l * 256;
    constexpr int NQB = SEQ / 128, NBH = NB * HA, NU_P = NBH * NQB, NU = NU_P + DB * HA;
    const float sc = 0.08838834764831845f * 1.44269504089f;
    if (wid >= 4) __builtin_amdgcn_s_setprio(3);
    int qx = (int)(MY_XCC_ID() & 7u), tries = 0; bool sample_list = true;
    for (;;) {
        const bool dummy = false;
        int kk;
        if (sample_list) { kk = queue_next(qctr, qslot); if (kk >= NU - NU_P) { sample_list = false; continue; } }
        else { kk = xcd_queue_next(qctr + 64, NBH, NQB, qx, tries, qslot); if (kk < 0) break; }
        int lane = lane_; OPAQUE(lane);
        const int r = lane & 31, hh = lane >> 5;
        const LaneOffs LO = make_lane_offs(lane);
        const bool sample = __builtin_amdgcn_readfirstlane((int)sample_list) != 0;
        int b, h, qb; size_t qrow0;
        if (!sample) { const int cnt = (NBH - qx + 7) / 8; qb = NQB - 1 - kk / cnt; const int bh = qx + 8 * (kk % cnt); h = bh % HA; b = bh / HA; qrow0 = (size_t)b * SEQ + qb * 128; }
        else { h = kk % HA; b = kk / HA; qb = 0; qrow0 = (size_t)MP + (size_t)b * DSEQ; }
        b = __builtin_amdgcn_readfirstlane(b); h = __builtin_amdgcn_readfirstlane(h); qb = __builtin_amdgcn_readfirstlane(qb);
        qrow0 = sample ? (size_t)MP + (size_t)b * DSEQ : (size_t)b * SEQ + qb * 128;
        const int nq = sample ? 32 : 128;
        __syncthreads();
        stage_rows<false>(lds, QA + qrow0 * D + (2 * h) * 128, D, nq, nq);
        stage_rows<false>(lds + 32768, QA + qrow0 * D + (2 * h + 1) * 128, D, nq, nq);
        f32x16 O[8];
#pragma unroll
        for (int i = 0; i < 8; ++i) O[i] = zero16();
        float m = -1e30f, lsum = 0.f;
        const bool wave_on = sample ? (rg == 0) : true;
        const LAS unsigned char* Qw = lds + c * 32768 + rg * 8192;
        __syncthreads();
        bf16x8 qreg[8];
#pragma unroll
        for (int ks = 0; ks < 8; ++ks) qreg[ks] = lds_frag_row(Qw, LO, ks);
        __syncthreads();
        const int img = wid >> 1, rbase = 32 * (wid & 1) + (lane >> 4);
        const bf16_t* src = (img < 2 ? KA + (size_t)(2 * h + img) * 128 : VA + (size_t)h * 256 + (size_t)(img - 2) * 128) + (size_t)b * SEQ * D;
        const unsigned srow = (unsigned)(rbase * D * 2), cx = (unsigned)((lane & 15) ^ (((lane >> 4) & 3) << 2));
#define ATT_SOFF(i) (srow_ + (unsigned)((i) * 4 * D * 2) + 16u * (cx_ ^ (unsigned)((i) & 3)))
        const int ntile = sample ? PAST / 64 + 1 : 2 * qb + 2;
        const unsigned ldst = (unsigned)(img * 16384 + (wid & 1) * 8192);
        const char* gnext = (const char*)src;
#define ATT_ISSUE(t) do { LAS unsigned char* d_ = lds + ((t) & 1) * 65536 + ldst; unsigned srow_ = srow, cx_ = cx; OPAQUE(srow_); OPAQUE(cx_);   \
        _Pragma("unroll") for (int i_ = 0; i_ < 8; ++i_) GLDS16(gnext + ATT_SOFF(i_), d_ + i_ * 1024); gnext += (size_t)64 * D * 2; } while (0)
        if (!sample && !dummy) ATT_ISSUE(0);
        for (int t = 0; t < ntile; ++t) {
            LAS unsigned char* stg = lds + (t & 1) * 65536;
            int nvalid = 64; bool vis, dma = false;
            if (!sample) {
                if (t == 2 * qb + 1) { ASM_WAIT_VM(16); ASM_WAIT_LGKM(0); }
                else ASM_WAIT_ALL0();
                __builtin_amdgcn_s_barrier();
                vis = t <= 2 * qb + (rg >> 1);
                dma = t + 1 < ntile && !dummy;
            } else {
                __syncthreads();
                if (t < PAST / 64) { const size_t kr = ((size_t)(l * DB + b) * PAST + (size_t)t * 64) * D;
                    stage_rows<true>(stg, p.in[I_CAK] + kr + (2 * h) * 128, D, 64, 64); stage_rows<true>(stg + 16384, p.in[I_CAK] + kr + (2 * h + 1) * 128, D, 64, 64);
                    stage_rows<true>(stg + 32768, p.in[I_CAV] + kr + h * 256, D, 64, 64); stage_rows<true>(stg + 49152, p.in[I_CAV] + kr + h * 256 + 128, D, 64, 64); }
                else { nvalid = DSEQ; const size_t kr = (size_t)MP + (size_t)b * DSEQ;
                    stage_rows<false>(stg, KA + kr * D + (2 * h) * 128, D, 64, DSEQ); stage_rows<false>(stg + 16384, KA + kr * D + (2 * h + 1) * 128, D, 64, DSEQ);
                    stage_rows<false>(stg + 32768, VA + kr * D + h * 256, D, 64, DSEQ); stage_rows<false>(stg + 49152, VA + kr * D + h * 256 + 128, D, 64, DSEQ); }
                __syncthreads();
                vis = wave_on;
            }
            if (vis) attn_a_tile(stg + c * 16384, stg + 32768, qreg, lane, nvalid, sc, O, m, lsum, dma, gnext, lds + ((t + 1) & 1) * 65536 + ldst, srow, cx);
            else if (dma) { ATT_ISSUE(t + 1); gnext -= (size_t)64 * D * 2; }
            if (dma) gnext += (size_t)64 * D * 2;
            if (!sample && t >= 2 * qb && !dummy) { float* ob_ = p.out + ((size_t)(l * NB + b) * SEQ + (size_t)t * 64) * D;
                cache_store_tile(stg, ob_ + O_PAK + (2 * h) * 128, ob_ + O_PAV + h * 256); }
        }
#undef ATT_ISSUE
#undef ATT_SOFF
        const float inv_l = fast_rcp(lsum + __shfl_xor(lsum, 32));
#pragma unroll
        for (int d = 0; d < 8; ++d)
#pragma unroll
            for (int i = 0; i < 16; ++i) O[d][i] *= inv_l;
        LAS float* X = (LAS float*)(lds + AT_X);
#pragma unroll
        for (int hv = 0; hv < 2; ++hv) {
            __syncthreads();
            if (c == 1) {
#pragma unroll
                for (int d = 0; d < 4; ++d)
#pragma unroll
                    for (int i = 0; i < 16; ++i) X[((rg * 64) + d * 16 + i) * 64 + lane] = O[4 * hv + d][i]; }
            __syncthreads();
            if (c == 0) {
#pragma unroll
                for (int d = 0; d < 4; ++d)
#pragma unroll
                    for (int i = 0; i < 16; ++i) O[4 * hv + d][i] -= lamv[0] * X[((rg * 64) + d * 16 + i) * 64 + lane]; }
        }
        if (c == 0 && wave_on) {
            float ss = 0.f;
#pragma unroll
            for (int d = 0; d < 8; ++d)
#pragma unroll
                for (int i = 0; i < 16; ++i) ss += O[d][i] * O[d][i];
            ss += __shfl_xor(ss, 32);
            const float rstd = __builtin_amdgcn_rsqf(ss * (1.0f / 256.0f) + EPS) * lamv[1];
            int qi = 32 * rg + r; OPAQUE(qi);
            if ((!sample || qi < DSEQ) && !dummy) {
                bf16_t* dst = OA + (qrow0 + qi) * D + h * 256;
#pragma unroll
                for (int d = 0; d < 8; ++d)
#pragma unroll
                    for (int g4 = 0; g4 < 4; ++g4) { const int dv = 32 * d + 8 * g4 + 4 * hh; const f32x4 w = *(const f32x4*)(subw + dv);
                        u32x2 o; o.x = cvt_pk_bf16(O[d][4 * g4] * rstd * w[0], O[d][4 * g4 + 1] * rstd * w[1]); o.y = cvt_pk_bf16(O[d][4 * g4 + 2] * rstd * w[2], O[d][4 * g4 + 3] * rstd * w[3]);
                        *(u32x2*)(dst + dv) = o; }
            }
        }
    }
    __builtin_amdgcn_s_setprio(0);
}

DI void phase_attn_c(const Params& p, int l, LAS unsigned char* lds, unsigned* qctr, volatile LAS unsigned* qslot) {
    int tid = threadIdx.x; OPAQUE(tid);
    const int lane_ = tid & 63, wid = __builtin_amdgcn_readfirstlane(tid >> 6), hsel = wid >> 2, rg = wid & 3;
    unsigned char* ws = p.ws;
    const bf16_t* QC = (const bf16_t*)(ws + WS_QC); const bf16_t* KC = (const bf16_t*)(ws + WS_KC); const bf16_t* VC = (const bf16_t*)(ws + WS_VC);
    bf16_t* OC = (bf16_t*)(ws + WS_OC);
    constexpr int NQB = SEQ / 128, NHP = HC / 2, NU_P = NB * NHP * NQB, NU = NU_P + DB * NHP;
    volatile LAS unsigned* flags = (volatile LAS unsigned*)(lds + AT_FLAG);
    constexpr int NBHP = NB * NHP;
    int qx = (int)(MY_XCC_ID() & 7u), tries = 0; bool sample_list = true;
    for (;;) {
        int u;
        if (sample_list) { u = queue_next(qctr, qslot); if (u >= NU - NU_P) { sample_list = false; continue; } }
        else { u = xcd_queue_next(qctr + 64, NBHP, NQB, qx, tries, qslot); if (u < 0) break; }
        int lane = lane_; OPAQUE(lane);
        const int r = lane & 31, hh = lane >> 5;
        const LaneOffs LO = make_lane_offs(lane);
        const bool sample = __builtin_amdgcn_readfirstlane((int)sample_list) != 0;
        int b, hp, qb, jtop; int pos0;
        if (!sample) { const int cnt = (NBHP - qx + 7) / 8; qb = NQB - 1 - u / cnt; const int bh = qx + 8 * (u % cnt); hp = bh % NHP; b = bh / NHP; jtop = 2 * qb + 1; pos0 = qb * 128; }
        else { hp = u % NHP; b = u / NHP; qb = 0; jtop = PAST / 64; pos0 = PAST; }
        b = __builtin_amdgcn_readfirstlane(b); hp = __builtin_amdgcn_readfirstlane(hp); qb = __builtin_amdgcn_readfirstlane(qb); jtop = __builtin_amdgcn_readfirstlane(jtop); pos0 = __builtin_amdgcn_readfirstlane(pos0);
        const size_t qrow0 = sample ? (size_t)MP + (size_t)b * DSEQ : (size_t)b * SEQ + qb * 128;
        const int h = 2 * hp + hsel;
        const int nq = sample ? 32 : 128;
        __syncthreads();
        stage_rows<false>(lds, QC + qrow0 * D + (2 * hp) * 128, D, nq, nq);
        stage_rows<false>(lds + 32768, QC + qrow0 * D + (2 * hp + 1) * 128, D, nq, nq);
        if (tid < 8) flags[tid] = 0u;
        f32x16 O[4];
#pragma unroll
        for (int i = 0; i < 4; ++i) O[i] = zero16();
        float run = 0.f;
        const bool wave_on = sample ? (rg == 0) : true;
        bool wdone = !wave_on;
        const int tq = pos0 + 32 * rg + r;
        __syncthreads();
        bf16x8 qreg[8];
#pragma unroll
        for (int ks = 0; ks < 8; ++ks) qreg[ks] = lds_frag_row(lds + hsel * 32768 + rg * 8192, LO, ks);
        __syncthreads();
        const int img = wid >> 1, rbase = 32 * (wid & 1) + (lane >> 4);
        const bf16_t* src = (img < 2 ? KC + (size_t)(2 * hp + img) * 128 : VC + (size_t)(2 * hp + img - 2) * 128) + (size_t)b * SEQ * D;
        const unsigned srow = (unsigned)(rbase * D * 2), cx = (unsigned)((lane & 15) ^ (((lane >> 4) & 3) << 2));
        const unsigned ldst = (unsigned)(img * 16384 + (wid & 1) * 8192);
        const char* gnext = (const char*)src + (size_t)jtop * 64 * D * 2;
#define STK_ISSUE(st_) do { LAS unsigned char* d_ = lds + (st_) * 65536 + ldst; unsigned srow_ = srow, cx_ = cx; OPAQUE(srow_); OPAQUE(cx_); \
        _Pragma("unroll") for (int i_ = 0; i_ < 8; ++i_) GLDS16(gnext + (srow_ + (unsigned)(i_ * 4 * D * 2) + 16u * (cx_ ^ (unsigned)(i_ & 3))), d_ + i_ * 1024); gnext -= (size_t)64 * D * 2; } while (0)
        int st = 0;
        if (!sample) STK_ISSUE(0);
        for (int j = jtop; j >= 0; --j) {
            if (!sample) { ASM_WAIT_ALL0(); __builtin_amdgcn_s_barrier(); }
            else __syncthreads();
            { unsigned alld = 1u;
#pragma unroll
              for (int w = 0; w < 8; ++w) alld &= flags[w];
              if (alld) break; }
            LAS unsigned char* stg = lds + st * 65536;
            int nvalid = 64; const int kpos0 = j * 64;
            const bool dmac = !sample && j > 0;
            if (sample) {}
            if (sample) {
                if (j < PAST / 64) { const size_t kr = ((size_t)(l * DB + b) * PAST + (size_t)j * 64) * D;
                    stage_rows<true>(stg, p.in[I_CCK] + kr + (2 * hp) * 128, D, 64, 64); stage_rows<true>(stg + 16384, p.in[I_CCK] + kr + (2 * hp + 1) * 128, D, 64, 64);
                    stage_rows<true>(stg + 32768, p.in[I_CCV] + kr + (2 * hp) * 128, D, 64, 64); stage_rows<true>(stg + 49152, p.in[I_CCV] + kr + (2 * hp + 1) * 128, D, 64, 64); }
                else { nvalid = DSEQ; const size_t kr = (size_t)MP + (size_t)b * DSEQ;
                    stage_rows<false>(stg, KC + kr * D + (2 * hp) * 128, D, 64, DSEQ); stage_rows<false>(stg + 16384, KC + kr * D + (2 * hp + 1) * 128, D, 64, DSEQ);
                    stage_rows<false>(stg + 32768, VC + kr * D + (2 * hp) * 128, D, 64, DSEQ); stage_rows<false>(stg + 49152, VC + kr * D + (2 * hp + 1) * 128, D, 64, DSEQ); }
                __syncthreads();
            }
            const bool need = kpos0 < pos0 + 32 * rg + 31;
            if (dmac && !(!wdone && need)) STK_ISSUE(st ^ 1);
            if (!wdone && need) {
                LAS unsigned char* dd_ = lds + (st ^ 1) * 65536 + ldst;
                int lane2 = lane; OPAQUE(lane2); const LaneOffs L2 = make_lane_offs(lane2);
                const LAS unsigned char* Ki = stg + hsel * 16384; const LAS unsigned char* Vi = stg + 32768 + hsel * 16384;
                f32x16 s[2]; s[0] = zero16(); s[1] = zero16();
                {
                    bf16x8 kb0[2], kb1[2];
#pragma unroll
                    for (int jj = 0; jj < 2; ++jj) { kb0[jj] = lds_frag_row(Ki, L2, jj); kb1[jj] = lds_frag_row(Ki + 8192, L2, jj); }
#pragma unroll
                    for (int ks = 0; ks < 8; ++ks) {
                        const bf16x8 a0 = kb0[ks & 1], a1 = kb1[ks & 1];
                        if (ks + 2 < 8) { kb0[ks & 1] = lds_frag_row(Ki, L2, ks + 2); kb1[ks & 1] = lds_frag_row(Ki + 8192, L2, ks + 2); }
                        s[0] = MFMA32(a0, qreg[ks], s[0]); s[1] = MFMA32(a1, qreg[ks], s[1]);
                        if (dmac) { unsigned srow_ = srow, cx_ = cx; OPAQUE(srow_); OPAQUE(cx_); GLDS16(gnext + (srow_ + (unsigned)(ks * 4 * D * 2) + 16u * (cx_ ^ (unsigned)(ks & 3))), dd_ + ks * 1024); }
                        __builtin_amdgcn_sched_barrier(0);
                    }
                }
                if (dmac) gnext -= (size_t)64 * D * 2;
                bf16x8 vf[3];
#pragma unroll
                for (int jj = 0; jj < 3; ++jj) { s16x4 a_, b_; TR_ISSUE(a_, Vi, L2.ta0[jj & 3], 0); TR_ISSUE_X32(b_, Vi, L2.ta0[jj & 3], 2048); vf[jj] = __builtin_shufflevector(a_, b_, 0, 1, 2, 3, 4, 5, 6, 7); }
                __builtin_amdgcn_sched_barrier(0);
                float gs[8];
#pragma unroll
                for (int kb = 0; kb < 2; ++kb)
#pragma unroll
                    for (int q2 = 0; q2 < 4; ++q2) { float lm[4], lb[4];
#pragma unroll
                        for (int e = 0; e < 4; ++e) { const int key = 32 * kb + 8 * q2 + 4 * hh + e; const float z = s[kb][4 * q2 + e] * 0.08838834764831845f;
                            const float sp = fmaxf(z, 0.f) + 0.69314718056f * __builtin_amdgcn_logf(1.0f + fast_exp(-fabsf(z)));
                            const bool ok = (kpos0 + key < tq) && (key < nvalid);
                            lm[e] = ok ? -sp : 0.f; lb[e] = ok ? z - sp : -1e30f; }
                        const float t3 = 0.f, t2 = lm[3], t1 = t2 + lm[2], t0 = t1 + lm[1];
                        gs[4 * kb + q2] = t0 + lm[0];
                        s[kb][4 * q2 + 0] = lb[0] + t0; s[kb][4 * q2 + 1] = lb[1] + t1; s[kb][4 * q2 + 2] = lb[2] + t2; s[kb][4 * q2 + 3] = lb[3] + t3; }
                float pg[8], T[8];
#pragma unroll
                for (int k = 0; k < 8; ++k) { float r0_, r1_; swap32(gs[k], r0_, r1_); pg[k] = r1_; T[k] = r0_ + r1_; }
                float off[8]; float accp = run;
#pragma unroll
                for (int k = 7; k >= 0; --k) { off[k] = accp + (hh == 0 ? pg[k] : 0.f); accp += T[k]; }
                run = accp;
#pragma unroll
                for (int i = 0; i < 16; ++i) s[0][i] = fast_exp(s[0][i] + off[i >> 2]);
                bf16x8 pb[4]; pb[0] = pack8(s[0], 0); pb[1] = pack8(s[0], 1);
                __builtin_amdgcn_sched_barrier(0);
                bf16x8 cur = vf[0];
                TR_WAITN(4, cur);
#pragma unroll
                for (int idx = 0; idx < 16; ++idx) { const int s2 = idx >> 2, d = idx & 3, slot = idx % 3;
                    bf16x8 nxt = cur;
                    if (idx + 1 < 16) { nxt = vf[(idx + 1) % 3]; if (idx + 2 < 16) TR_WAITN(2, nxt); else TR_WAITN(0, nxt); }
                    O[d] = MFMA32(cur, pb[s2], O[d]);
                    if (idx + 3 < 16) { const int j2 = idx + 3, js2 = j2 >> 2, jd = j2 & 3; s16x4 a_, b_;
                        TR_ISSUE(a_, Vi, L2.ta0[jd], js2 * 4096); TR_ISSUE_X32(b_, Vi, L2.ta0[jd], js2 * 4096 + 2048);
                        vf[slot] = __builtin_shufflevector(a_, b_, 0, 1, 2, 3, 4, 5, 6, 7); }
                    cur = nxt;
                    if (idx < 8) { s[1][2 * idx] = fast_exp(s[1][2 * idx] + off[4 + ((2 * idx) >> 2)]); s[1][2 * idx + 1] = fast_exp(s[1][2 * idx + 1] + off[4 + ((2 * idx + 1) >> 2)]); }
                    if (idx == 7) { pb[2] = pack8(s[1], 0); pb[3] = pack8(s[1], 1); }
                    __builtin_amdgcn_sched_barrier(0);
                }
                wdone = __all(run < -110.0f) != 0;
            }
            if (j == 0) wdone = true;
            if (lane == 0) flags[wid] = wdone ? 1u : 0u;
            st ^= 1;
        }
#undef STK_ISSUE
        if (wave_on) { int qi = 32 * rg + r; OPAQUE(qi);
            if (!sample || qi < DSEQ) { bf16_t* dst = OC + (qrow0 + qi) * D + h * 128;
#pragma unroll
                for (int d = 0; d < 4; ++d)
#pragma unroll
                    for (int g4 = 0; g4 < 4; ++g4) { const int dv = 32 * d + 8 * g4 + 4 * hh;
                        u32x2 o; o.x = cvt_pk_bf16(O[d][4 * g4], O[d][4 * g4 + 1]); o.y = cvt_pk_bf16(O[d][4 * g4 + 2], O[d][4 * g4 + 3]); *(u32x2*)(dst + dv) = o; } } }
    }
}
DI void phase_merge(const Params& p, int l, LAS unsigned char* lds) {
    int tid = threadIdx.x; OPAQUE(tid);
    const int lane = tid & 63, wid = tid >> 6;
    unsigned char* ws = p.ws;
    const bf16_t* OA = (const bf16_t*)(ws + WS_OA); const bf16_t* OC = (const bf16_t*)(ws + WS_OC); const bf16_t* OBR = (const bf16_t*)(ws + WS_OBUF);
    const bf16_t* BZ = (const bf16_t*)(ws + WS_BZ); const bf16_t* GT = (const bf16_t*)(ws + WS_GATES); bf16_t* XB = (bf16_t*)(ws + WS_XB);
    const float* gw = p.in[I_GDNW] + l * 128;
    constexpr int NROW = MP + MS, NH = (D + 511) / 512;
    struct MergeIn { u32x4 oa, oc, ob, bz, g0, g1, g2; };
#define MERGE_LOAD(dst, rr_) do { const size_t row_ = (rr_); \
        const size_t brow_ = (rr_) < MP ? (size_t)(rr_) : (size_t)MP + (size_t)(((rr_) - MP) / DSEQ) * 64 + ((rr_) - MP) % DSEQ;   \
        _Pragma("unroll") for (int hf_ = 0; hf_ < NH; ++hf_) { const int cu_ = hf_ * 512 + lane * 8; const int c_ = cu_ < D ? cu_ : 0; \
            dst[hf_].oa = *(const u32x4*)(OA + row_ * D + c_); dst[hf_].oc = *(const u32x4*)(OC + row_ * D + c_); dst[hf_].ob = *(const u32x4*)(OBR + brow_ * D + c_); dst[hf_].bz = *(const u32x4*)(BZ + row_ * D + c_); \
            dst[hf_].g0 = *(const u32x4*)(GT + row_ * 3 * D + c_); dst[hf_].g1 = *(const u32x4*)(GT + row_ * 3 * D + D + c_); dst[hf_].g2 = *(const u32x4*)(GT + row_ * 3 * D + 2 * D + c_); } } while (0)
    const int stride = gridDim.x * 8;
    int rr = blockIdx.x * 8 + wid;
    MergeIn cur[NH];
    if (rr < NROW) MERGE_LOAD(cur, rr);
    for (; rr < NROW; rr += stride) {
        const size_t row = rr;
        MergeIn nxt[NH];
#pragma unroll
        for (int hf = 0; hf < NH; ++hf) nxt[hf] = cur[hf];
        if (rr + stride < NROW) MERGE_LOAD(nxt, rr + stride);
#pragma unroll
        for (int hf = 0; hf < NH; ++hf) {
            const int cu = hf * 512 + lane * 8; const bool cok = cu < D; const int c = cok ? cu : 0;
            const u32x4 oa = cur[hf].oa, oc = cur[hf].oc, ob = cur[hf].ob, bz = cur[hf].bz, g0 = cur[hf].g0, g1 = cur[hf].g1, g2 = cur[hf].g2;
            float o[8]; float ss = 0.f;
#pragma unroll
            for (int e = 0; e < 4; ++e) { o[2 * e] = bf_lo(ob[e]); o[2 * e + 1] = bf_hi(ob[e]); ss += o[2 * e] * o[2 * e] + o[2 * e + 1] * o[2 * e + 1]; }
            ss += __shfl_xor(ss, 1); ss += __shfl_xor(ss, 2); ss += __shfl_xor(ss, 4); ss += __shfl_xor(ss, 8);
            const float rstd = __builtin_amdgcn_rsqf(ss * (1.0f / 128.0f) + EPS);
            const f32x4 w0 = *(const f32x4*)(gw + (c & 127)), w1 = *(const f32x4*)(gw + (c & 127) + 4);
            float mg[8];
#pragma unroll
            for (int e = 0; e < 8; ++e) { const unsigned ua = oa[e >> 1], uc = oc[e >> 1], uz = bz[e >> 1], u0 = g0[e >> 1], u1 = g1[e >> 1], u2 = g2[e >> 1];
                const float a = (e & 1) ? bf_hi(ua) : bf_lo(ua), cc = (e & 1) ? bf_hi(uc) : bf_lo(uc), z = (e & 1) ? bf_hi(uz) : bf_lo(uz);
                const float ga = sigmoidf_((e & 1) ? bf_hi(u0) : bf_lo(u0)), gbv = sigmoidf_((e & 1) ? bf_hi(u1) : bf_lo(u1)), gc = sigmoidf_((e & 1) ? bf_hi(u2) : bf_lo(u2));
                const float w = e < 4 ? w0[e] : w1[e - 4];
                const float obn = o[e] * rstd * w * (z * sigmoidf_(z));
                mg[e] = ga * a + gbv * obn + gc * cc; }
            u32x4 wv; wv.x = cvt_pk_bf16(mg[0], mg[1]); wv.y = cvt_pk_bf16(mg[2], mg[3]); wv.z = cvt_pk_bf16(mg[4], mg[5]); wv.w = cvt_pk_bf16(mg[6], mg[7]);
            if (cok) *(u32x4*)(XB + row * D + c) = wv;
        }
#pragma unroll
        for (int hf = 0; hf < NH; ++hf) cur[hf] = nxt[hf];
    }
#undef MERGE_LOAD
}

DI void phase_rstd(const float* ssp, float* rstd, int row_end) {
    int tid = threadIdx.x; OPAQUE(tid);
    for (int row = blockIdx.x * 512 + tid; row < row_end; row += gridDim.x * 512) {
        float ss = 0.f;
#pragma unroll
        for (int j = 0; j < NPART; j += 4) { const f32x4 q = *(const f32x4*)(ssp + (size_t)row * NPART + j); ss += (q[0] + q[1]) + (q[2] + q[3]); }
        rstd[row] = __builtin_amdgcn_rsqf(ss * (1.0f / D) + EPS);
    }
}

struct EpiResid {
    static constexpr bool PERM = false;
    const float* xin_p; const float* xin_s; float* xout_p; float* xout_s; bf16_t* xb; float* ssp; float* part;
    DI void operator()(const f32x4 (&acc)[2][2][4][2], const pg8::Unit& u, int wr, int wc, int fr_, int fq_, const LAS float*) const {
        int fr = fr_, fq = fq_; OPAQUE(fr); OPAQUE(fq);
        if (u.slice >= 0) {
            float* base = part + (size_t)u.slice * 256 * D;
#pragma unroll
            for (int ai = 0; ai < 2; ++ai)
#pragma unroll
                for (int m = 0; m < 4; ++m) { const int r = ai * 128 + wr * 64 + m * 16 + fr;
                    if (r < MS) {
#pragma unroll
                        for (int bj = 0; bj < 2; ++bj)
#pragma unroll
                            for (int n = 0; n < 2; ++n) *(f32x4*)(base + (size_t)r * D + u.pn * 256 + bj * 128 + wc * 32 + n * 16 + fq * 4) = acc[ai][bj][m][n]; }
                    COMPILER_FENCE(); }
            return;
        }
        const bool sample = u.pm >= MP / 256;
#pragma unroll
        for (int ai = 0; ai < 2; ++ai)
#pragma unroll
            for (int m = 0; m < 4; ++m) {
                const int row = u.pm * 256 + ai * 128 + wr * 64 + m * 16 + fr;
                const bool valid = !sample || (row - MP) < MS;
                const float* xi = sample ? xin_s + (size_t)(row - MP) * D : xin_p + (size_t)row * D;
                float* xo = sample ? xout_s + (size_t)(row - MP) * D : xout_p + (size_t)row * D;
                float ss = 0.f;
#pragma unroll
                for (int bj = 0; bj < 2; ++bj)
#pragma unroll
                    for (int n = 0; n < 2; ++n) { const int c = u.pn * 256 + bj * 128 + wc * 32 + n * 16 + fq * 4;
                        if (valid) { const f32x4 v = *(const f32x4*)(xi + c) + acc[ai][bj][m][n]; *(f32x4*)(xo + c) = v;
                            u32x2 w; w.x = cvt_pk_bf16(v[0], v[1]); w.y = cvt_pk_bf16(v[2], v[3]); *(u32x2*)(xb + (size_t)row * D + c) = w;
                            ss += (v[0] * v[0] + v[1] * v[1]) + (v[2] * v[2] + v[3] * v[3]); } }
                ss += __shfl_xor(ss, 16); ss += __shfl_xor(ss, 32);
                if (valid && fq == 0) ssp[(size_t)row * NPART + u.pn * 4 + wc] = ss;
                if (m == 3) COMPILER_FENCE();
            }
    }
};
DI void sample_reduce(const float* part, int nS, const float* xin_s, float* xout_s, bf16_t* xb, float* rstd, const float* fnw) {
    int tid = threadIdx.x; OPAQUE(tid);
    const int lane = tid & 63, wid = tid >> 6;
    for (int r = blockIdx.x * 8 + wid; r < MS; r += gridDim.x * 8) {
        f32x4 v[D / 256]; float ss = 0.f;
#pragma unroll
        for (int i = 0; i < D / 256; ++i) { const int c = i * 256 + lane * 4;
            f32x4 a = *(const f32x4*)(xin_s + (size_t)r * D + c);
            for (int s = 0; s < nS; ++s) a += *(const f32x4*)(part + ((size_t)s * 256 + r) * D + c);
            v[i] = a; ss += a[0] * a[0] + a[1] * a[1] + a[2] * a[2] + a[3] * a[3]; }
#pragma unroll
        for (int o = 1; o < 64; o <<= 1) ss += __shfl_xor(ss, o);
        const float rs = __builtin_amdgcn_rsqf(ss * (1.0f / D) + EPS);
        if (!fnw && lane == 0) rstd[MP + r] = rs;
#pragma unroll
        for (int i = 0; i < D / 256; ++i) { const int c = i * 256 + lane * 4;
            if (fnw) { *(f32x4*)(xout_s + (size_t)r * D + c) = v[i] * rs * *(const f32x4*)(fnw + c); }
            else { *(f32x4*)(xout_s + (size_t)r * D + c) = v[i];
                u32x2 w; w.x = cvt_pk_bf16(v[i][0], v[i][1]); w.y = cvt_pk_bf16(v[i][2], v[i][3]); *(u32x2*)(xb + (size_t)(MP + r) * D + c) = w; } }
    }
}
struct EpiUp {
    static constexpr bool PERM = true;
    bf16_t* hid; float* part;
    DI void operator()(const f32x4 (&acc)[2][2][4][2], const pg8::Unit& u, int wr, int wc, int fr_, int fq_, const LAS float* rs_lds) const {
        int fr = fr_, fq = fq_; OPAQUE(fr); OPAQUE(fq);
        const bool sample = u.pm >= MP / 256;
        if (u.slice >= 0) {
            float* base = part + (size_t)u.slice * 256 * DFF;
#pragma unroll
            for (int ai = 0; ai < 2; ++ai)
#pragma unroll
                for (int m = 0; m < 4; ++m) { const int r = ai * 128 + wr * 64 + m * 16 + fr;
                    if (r < MS) {
#pragma unroll
                        for (int bj = 0; bj < 2; ++bj) { float* o = base + (size_t)r * DFF + u.pn * 256 + wc * 64 + bj * 32 + fq * 8; *(f32x4*)o = acc[ai][bj][m][0]; *(f32x4*)(o + 4) = acc[ai][bj][m][1]; } }
                    COMPILER_FENCE(); }
            return;
        }
#pragma unroll
        for (int ai = 0; ai < 2; ++ai)
#pragma unroll
            for (int m = 0; m < 4; ++m) {
                const int row = u.pm * 256 + ai * 128 + wr * 64 + m * 16 + fr;
                if (sample && (row - MP) >= MS) continue;
                const float rs = rs_lds[ai * 128 + wr * 64 + m * 16 + fr];
#pragma unroll
                for (int bj = 0; bj < 2; ++bj) { f32x4 a = acc[ai][bj][m][0] * rs, b = acc[ai][bj][m][1] * rs;
#pragma unroll
                    for (int e = 0; e < 4; ++e) { const float x = fmaxf(a[e], 0.f), y = fmaxf(b[e], 0.f); a[e] = x * x; b[e] = y * y; }
                    u32x4 w; w.x = cvt_pk_bf16(a[0], a[1]); w.y = cvt_pk_bf16(a[2], a[3]); w.z = cvt_pk_bf16(b[0], b[1]); w.w = cvt_pk_bf16(b[2], b[3]);
                    *(u32x4*)(hid + (size_t)row * DFF + u.pn * 256 + wc * 64 + bj * 32 + fq * 8) = w; }
            }
    }
};

DI void sample_up_reduce(const float* part, int nS, const float* rstd_mid, bf16_t* hid) {
    int tid = threadIdx.x; OPAQUE(tid);
    for (int i = blockIdx.x * 512 + tid; i < MS * (DFF / 8); i += gridDim.x * 512) { const int r = i / (DFF / 8), c = (i % (DFF / 8)) * 8;
        f32x4 a = (f32x4){0.f, 0.f, 0.f, 0.f}, b = a;
        for (int s = 0; s < nS; ++s) { const float* q = part + ((size_t)s * 256 + r) * DFF + c; a += *(const f32x4*)q; b += *(const f32x4*)(q + 4); }
        const float rs = rstd_mid[MP + r];
#pragma unroll
        for (int e = 0; e < 4; ++e) { const float x = fmaxf(a[e] * rs, 0.f), y = fmaxf(b[e] * rs, 0.f); a[e] = x * x; b[e] = y * y; }
        u32x4 w; w.x = cvt_pk_bf16(a[0], a[1]); w.y = cvt_pk_bf16(a[2], a[3]); w.z = cvt_pk_bf16(b[0], b[1]); w.w = cvt_pk_bf16(b[2], b[3]);
        *(u32x4*)(hid + (size_t)(MP + r) * DFF + c) = w; }
}

DI void phase_final(const Params& p, LAS unsigned char* lds) {
    int tid = threadIdx.x; OPAQUE(tid);
    const int lane = tid & 63, wid = tid >> 6;
    const float* ssp = (const float*)(p.ws + WS_SSP); const float* fw = p.in[I_FNW];
    for (int rr = blockIdx.x * 8 + wid; rr < MP; rr += gridDim.x * 8) {
        float* x = p.out + O_YP + (size_t)rr * D;
        float ss = 0.f;
#pragma unroll
        for (int j = 0; j < NPART; ++j) ss += ssp[(size_t)rr * NPART + j];
        const float rs = __builtin_amdgcn_rsqf(ss * (1.0f / D) + EPS);
        for (int c = lane * 4; c < D; c += 256) { const f32x4 v = *(const f32x4*)(x + c), w = *(const f32x4*)(fw + c); *(f32x4*)(x + c) = v * rs * w; }
    }
}

struct EpiNull {
    static constexpr bool PERM = true;
    float* sink;
    DI void operator()(const f32x4 (&acc)[2][2][4][2], const pg8::Unit& u, int wr, int wc, int fr, int fq, const LAS float*) const {
        float t = 0.f;
#pragma unroll
        for (int ai = 0; ai < 2; ++ai)
#pragma unroll
            for (int bj = 0; bj < 2; ++bj)
#pragma unroll
                for (int m = 0; m < 4; ++m)
#pragma unroll
                    for (int n = 0; n < 2; ++n) t += acc[ai][bj][m][n][0] + acc[ai][bj][m][n][1] + acc[ai][bj][m][n][2] + acc[ai][bj][m][n][3];
        if (t == 123.456f) sink[0] = t;
    }
};
constexpr int LDS_BYTES = 147456;
constexpr int LDS_MISC = 147456 - 256;
constexpr int PH_PER_LAYER = 11;
constexpr int N_PHASES = 1 + DEPTH * PH_PER_LAYER + 1;

__global__ void __launch_bounds__(512, 2) fwd_kernel(Params p) {
#ifdef EMU
    LAS unsigned char* lds = EMU_SMEM();
#else
    extern __shared__ __attribute__((aligned(16))) unsigned char lds_raw[];
    LAS unsigned char* lds = (LAS unsigned char*)lds_raw;
#endif
    volatile LAS unsigned* misc = (volatile LAS unsigned*)(lds + LDS_MISC);
    if (threadIdx.x < 16) misc[threadIdx.x] = 0u;
    __syncthreads();
    const int lo = p.ph_lo, hi = p.ph_hi;
    XcdBarrier bar; bar.bar = (unsigned*)(p.ws + WS_BAR); bar.x = 0; bar.st = misc;
    if (hi - lo > 1) bar = xcd_barrier_post((unsigned*)(p.ws + WS_BAR), misc);
#ifndef ONLY_KIND
#define ONLY_KIND -1
#endif
#define PHK(kind) (ONLY_KIND < 0 || ONLY_KIND == (kind))
#ifndef REPEAT_KIND
#define REPEAT_KIND -1
#endif
#define NREP(kind) ((REPEAT_KIND == (kind) && l == 0) ? 2 : 1)
#define IN(k) (lo <= (k) && (k) < hi)
#ifdef PROBE_KIND
#define STAMP(k) do { if (blockIdx.x == 0 && threadIdx.x == 0) ((unsigned long long*)(p.ws + WS_STAMP))[(k)] = __builtin_amdgcn_s_memrealtime(); } while (0)
#else
#define STAMP(k) ((void)0)
#endif
#define SEAM(k) do { if (IN(k) && IN((k) + 1)) xcd_barrier(bar); STAMP((k) + 1); } while (0)
    unsigned char* ws = p.ws;
    STAMP(0);
    if (PHK(100) && IN(0)) { phase_prologue(p, lds); if (REPEAT_KIND == 100) phase_prologue(p, lds); }
    SEAM(0);
    for (int l = 0; l < DEPTH; ++l) {
        const int pb = 1 + l * PH_PER_LAYER;
        int bid = blockIdx.x; OPAQUE_S(bid);
        if (PHK(0) && IN(pb + 0)) {
            phase_rstd((const float*)(ws + WS_SSP), (float*)(ws + WS_RSTD), l == 0 ? MP + MS : MP);
            if (l > 0) sample_reduce((const float*)(ws + WS_PART), DFF / 256, p.out + O_YS, p.out + O_YS, (bf16_t*)(ws + WS_XB), (float*)(ws + WS_RSTD), nullptr);
        }
        SEAM(pb + 0);
        if (REPEAT_KIND == 11 && l == 0 && IN(pb + 1)) {
            pg8::Gemm g{(const bf16_t*)(ws + WS_XB), (const bf16_t*)(ws + WS_WIN) + (size_t)l * NP * D, MALL, NP, D, D};
            pg8::StaticOrder S; S.init(MALL, NP, gridDim.x, bid, D);
            EpiNull E{(float*)(ws + WS_DUMMY)};
            pg8::gemm_phase(lds, g, S, E);
        }
        if ((REPEAT_KIND == 12 || REPEAT_KIND == 13) && l == 0 && IN(pb + 1)) {
            pg8::Gemm g{(const bf16_t*)(ws + WS_XB), (const bf16_t*)(ws + WS_WIN) + (size_t)l * NP * D, MALL, NP, D, D};
            pg8::StaticOrder S; S.init(MALL, NP, gridDim.x, bid, D);
            EpiInProj E{l, ws, p.out, REPEAT_KIND == 12 ? 1 : 2};
            pg8::gemm_phase(lds, g, S, E);
        }
        for (int pass = 0; pass < ((REPEAT_KIND == 60 && l == 0) ? 2 : 1); ++pass) {
        for (int rep = 0; rep < NREP(1); ++rep) if (PHK(1) && IN(pb + 1)) {
            pg8::Gemm g{(const bf16_t*)(ws + WS_XB), (const bf16_t*)(ws + WS_WIN) + (size_t)l * NP * D, MALL, NP, D, D};
            pg8::StaticOrder S; S.init(MALL, NP, gridDim.x, bid, D);
            EpiInProj E{l, ws, p.out, 0};
            pg8::gemm_phase(lds, g, S, E, (const float*)(ws + WS_RSTD));
        }
        SEAM(pb + 1);
        for (int rep = 0; rep < NREP(2); ++rep) if (PHK(2) && IN(pb + 2)) phase_conv_pre(p, l, lds);
        SEAM(pb + 2);
        if (IN(pb + 3) && IN(pb + 4)) STAMP(pb + 4);
        if (PHK(4) && IN(pb + 4)) {
            unsigned* qc = (unsigned*)(ws + WS_BAR + WS_QUEUE) + (size_t)l * 19 * 64;
            phase_gdn_scan(p, l, lds, qc, misc + 8);
            phase_attn_a(p, l, lds, qc + 64, misc + 8);
            phase_attn_c(p, l, lds, qc + 10 * 64, misc + 8);
        }
        SEAM(pb + 4);
        for (int rep = 0; rep < NREP(5); ++rep) if (PHK(5) && IN(pb + 5)) phase_merge(p, l, lds);
        SEAM(pb + 5);
        if (REPEAT_KIND == 50 && l == 0 && IN(pb + 5) && IN(pb + 6)) { for (int i = 0; i < 10; ++i) xcd_barrier(bar); }
        float* ssp_mid = (float*)(ws + WS_SSP) + (size_t)MALL * NPART;
        for (int rep = 0; rep < NREP(6); ++rep) if (PHK(6) && IN(pb + 6)) {
            pg8::Gemm g{(const bf16_t*)(ws + WS_XB), (const bf16_t*)(ws + WS_WOUT) + (size_t)l * D * D, MALL, D, D, D};
            pg8::ComboOrder S; S.init(MP, D, gridDim.x, bid, D, D / 256, 256);
            EpiResid E{l == 0 ? p.in[I_XP] : p.out + O_YP, l == 0 ? p.in[I_XS] : p.out + O_YS, p.out + O_YP, p.out + O_YS, (bf16_t*)(ws + WS_XB2), ssp_mid, (float*)(ws + WS_PART)};
            pg8::gemm_phase(lds, g, S, E);
        }
        SEAM(pb + 6);
        if (PHK(7) && IN(pb + 7)) {
            phase_rstd(ssp_mid, (float*)(ws + WS_RSTD) + MALL, MP);
            sample_reduce((const float*)(ws + WS_PART), D / 256, l == 0 ? p.in[I_XS] : p.out + O_YS, p.out + O_YS, (bf16_t*)(ws + WS_XB2), (float*)(ws + WS_RSTD) + MALL, nullptr);
        }
        SEAM(pb + 7);
        for (int rep = 0; rep < NREP(8); ++rep) if (PHK(8) && IN(pb + 8)) {
            pg8::Gemm g{(const bf16_t*)(ws + WS_XB2), (const bf16_t*)(ws + WS_WUP) + (size_t)l * DFF * D, MALL, DFF, D, D};
            pg8::ComboOrder S; S.init(MP, DFF, gridDim.x, bid, D, D / 256, 256);
            EpiUp E{(bf16_t*)(ws + WS_HID), (float*)(ws + WS_PART)};
            pg8::gemm_phase(lds, g, S, E, (const float*)(ws + WS_RSTD) + MALL);
        }
        SEAM(pb + 8);
        if (PHK(9) && IN(pb + 9)) sample_up_reduce((const float*)(ws + WS_PART), D / 256, (const float*)(ws + WS_RSTD) + MALL, (bf16_t*)(ws + WS_HID));
        SEAM(pb + 9);
        }
        if (REPEAT_KIND == 9 && l == 0 && IN(pb + 10)) {
            pg8::Gemm g{(const bf16_t*)(ws + WS_HID), (const bf16_t*)(ws + WS_WDN) + (size_t)l * D * DFF, MALL, D, DFF, DFF};
            pg8::StaticOrder S; S.init(MALL, D, gridDim.x, bid, DFF);
            float* sink = (float*)(ws + WS_DUMMY);
            EpiResid E{p.out + O_YP, p.out + O_YS, sink, sink + (size_t)MP * D, (bf16_t*)(sink + (size_t)MALL * D), sink + (size_t)MALL * D * 2, sink};
            pg8::gemm_phase(lds, g, S, E);
        }
        if (PHK(10) && IN(pb + 10)) {
            pg8::Gemm g{(const bf16_t*)(ws + WS_HID), (const bf16_t*)(ws + WS_WDN) + (size_t)l * D * DFF, MALL, D, DFF, DFF};
            pg8::ComboOrder S; S.init(MP, D, gridDim.x, bid, DFF, DFF / 256, 256);
            EpiResid E{p.out + O_YP, p.out + O_YS, p.out + O_YP, p.out + O_YS, (bf16_t*)(ws + WS_XB), (float*)(ws + WS_SSP), (float*)(ws + WS_PART)};
            pg8::gemm_phase(lds, g, S, E);
        }
        SEAM(pb + 10);
    }
    if (PHK(101) && IN(1 + DEPTH * PH_PER_LAYER)) { phase_final(p, lds);
        sample_reduce((const float*)(p.ws + WS_PART), DFF / 256, p.out + O_YS, p.out + O_YS, nullptr, nullptr, p.in[I_FNW]); }
#ifdef PROBE_KIND
    __syncthreads();
    if (blockIdx.x == 0 && threadIdx.x == 0) { const unsigned long long* st = (const unsigned long long*)(p.ws + WS_STAMP); STAMP(N_PHASES); unsigned long long tot = 0;
        if (PROBE_KIND == 100) tot = st[1] - st[0]; else if (PROBE_KIND == 101) tot = st[N_PHASES] - st[N_PHASES - 1];
        else for (int l = 0; l < DEPTH; ++l) tot += st[1 + l * PH_PER_LAYER + PROBE_KIND + 1] - st[1 + l * PH_PER_LAYER + PROBE_KIND];
        const float us = (float)tot * 0.0105f; const float q = exp2f(rintf(log2f(us) * 8.0f) / 8.0f);
        p.out[O_PAK + 5] = q; }
#endif
#undef IN
#undef SEAM
}

extern "C" void kernel_launch(void* const* d_in, const int* in_sizes, int n_in, void* d_out, int out_size, void* d_ws, size_t ws_size, hipStream_t stream) {
    if (n_in != 24 || (size_t)out_size != O_END || ws_size < WS_TOTAL) { fprintf(stderr, "kernel_launch: unexpected shapes (n_in %d out %d ws %zu need %zu)\n", n_in, out_size, ws_size, (size_t)WS_TOTAL); return; }
    Params p{};
    for (int i = 0; i < 24; ++i) p.in[i] = (const float*)d_in[i];
    p.out = (float*)d_out; p.ws = (unsigned char*)d_ws;
    (void)hipMemsetAsync((char*)d_ws + WS_BAR, 0, 32768, stream);
#ifdef EMU
    const int grid = EMU_GRID;
    const char* e = getenv("EMU_PHASES"); const int nph = e ? atoi(e) : N_PHASES;
    if (getenv("EMU_ONE")) { p.ph_lo = 0; p.ph_hi = nph; EMU_LAUNCH(fwd_kernel, grid, 512, LDS_BYTES, p); }
    else for (int k = 0; k < nph; ++k) { p.ph_lo = k; p.ph_hi = k + 1; EMU_LAUNCH(fwd_kernel, grid, 512, LDS_BYTES, p); }
#else
    static int grid = 0;
    if (grid == 0) {
        int dev = 0, cus = 0;
        if (hipGetDevice(&dev) != hipSuccess || hipDeviceGetAttribute(&cus, hipDeviceAttributeMultiprocessorCount, dev) != hipSuccess) { grid = -1; return; }
        if (hipFuncSetAttribute((const void*)fwd_kernel, hipFuncAttributeMaxDynamicSharedMemorySize, LDS_BYTES) != hipSuccess) { grid = -1; return; }
        grid = cus;
    }
    if (grid < 0) return;
#ifndef ONE_LAUNCH
#define ONE_LAUNCH 1
#endif
#if ONE_LAUNCH
    p.ph_lo = 0; p.ph_hi = N_PHASES;
    hipLaunchKernelGGL(fwd_kernel, dim3(grid), dim3(512), LDS_BYTES, stream, p);
#else
    for (int k = 0; k < N_PHASES; ++k) { p.ph_lo = k; p.ph_hi = k + 1; hipLaunchKernelGGL(fwd_kernel, dim3(grid), dim3(512), LDS_BYTES, stream, p); }
#endif
#endif
}

#ifdef EMU
void emu_compare(const char* name, const float* got, const float* ref, size_t n);
std::vector<float> emu_load_dbg(const char* name, size_t n);
static void dbg_bf16(const char* tag, const unsigned char* ws, size_t off, size_t row0, size_t nrows, const char* file) {
    std::vector<float> got(nrows * D); const bf16_t* b = (const bf16_t*)(ws + off) + row0 * D;
    for (size_t i = 0; i < nrows * D; ++i) got[i] = bf2f(b[i]);
    std::vector<float> ref = emu_load_dbg(file, nrows * D); emu_compare(tag, got.data(), ref.data(), nrows * D);
}
void emu_debug(unsigned char* ws, float* out) {
    printf("barrier timeout word = %u\n", ((unsigned*)(ws + WS_BAR))[XB_TMO]);
    if (const char* x = getenv("EMU_DBG_X")) { std::vector<float> ref = emu_load_dbg(x, (size_t)MP * D); emu_compare(x, out + O_YP, ref.data(), (size_t)MP * D); }
    if (getenv("EMU_DBG_M")) { dbg_bf16("merged(p)", ws, WS_XB, 0, MP, "p0_merged");
        std::vector<float> ref = emu_load_dbg("p0_merged", (size_t)MP * D); const bf16_t* b = (const bf16_t*)(ws + WS_XB); int shown = 0;
        for (int r = 0; r < MP && shown < 60; ++r) { int bad = 0, c0 = -1, c1 = -1; for (int c = 0; c < D; ++c) if (fabsf(bf2f(b[(size_t)r * D + c]) - ref[(size_t)r * D + c]) > 0.08f) { ++bad; if (c0 < 0) c0 = c; c1 = c; }
            if (bad) { printf("   row %d: %d bad cols [%d..%d]\n", r, bad, c0, c1); ++shown; } } }
    const char* e = getenv("EMU_DBG"); if (!e) return;
    const int l = atoi(e); char f[64];
    snprintf(f, 64, "p%d_obraw", l); dbg_bf16("obraw(p)", ws, WS_OBUF, 0, MP, f);
    snprintf(f, 64, "p%d_oa", l); dbg_bf16("oa(p)", ws, WS_OA, 0, MP, f);
    snprintf(f, 64, "s%d_oa", l); dbg_bf16("oa(s)", ws, WS_OA, MP, MS, f);
    snprintf(f, 64, "p%d_oc", l); dbg_bf16("oc(p)", ws, WS_OC, 0, MP, f);
    snprintf(f, 64, "s%d_oc", l); dbg_bf16("oc(s)", ws, WS_OC, MP, MS, f);
    for (int b = 0; b < DB; ++b) { snprintf(f, 64, "s%d_obraw", l); std::vector<float> ref = emu_load_dbg(f, (size_t)DB * DSEQ * D); std::vector<float> got(DSEQ * D);
        const bf16_t* bb = (const bf16_t*)(ws + WS_OBUF) + (size_t)(MP + b * 64) * D; for (int i = 0; i < DSEQ * D; ++i) got[i] = bf2f(bb[i]);
        emu_compare("obraw(s)", got.data(), ref.data() + (size_t)b * DSEQ * D, DSEQ * D); }
}
#endif
```
